# Optimizing an MI355X kernel written in HIP

```python
import math, functools
import jax, jax.numpy as jnp
from jax import lax
import numpy as np

D_MODEL = 4096
BATCH = 1
SEQ = 8192
DEPTH = 2

GRID_W = 64
CTX_LEN = 256
MIX_WIDTH = D_MODEL
N_MOD = 9
NORM_EPS = 1e-6
D_FF = 2 * D_MODEL
FFN_RES = 0.5

RW_WIDTH = MIX_WIDTH // 2
RW_HEAD = 64
RW_HEADS = RW_WIDTH // RW_HEAD
RW_DECAY_LORA = 96
RW_AAA_LORA = 96
RW_GATE_LORA = 256
RW_GN_EPS = 64e-5
RW_DECAY_SCALE = math.exp(-0.5)
RW_COLS = 3 * RW_WIDTH + RW_DECAY_LORA + RW_AAA_LORA + RW_GATE_LORA
RW_SPLITS = (RW_WIDTH, 2 * RW_WIDTH, 3 * RW_WIDTH,
             3 * RW_WIDTH + RW_DECAY_LORA, 3 * RW_WIDTH + RW_DECAY_LORA + RW_AAA_LORA)

MLA_WIDTH = MIX_WIDTH - RW_WIDTH
MLA_V_DIM = 128
MLA_HEADS = MLA_WIDTH // MLA_V_DIM
MLA_NOPE = 128
MLA_ROPE = 64
MLA_QK = MLA_NOPE + MLA_ROPE
MLA_Q_RANK = D_MODEL // 4
MLA_KV_RANK = D_MODEL // 8
MLA_COLS = MLA_Q_RANK + MLA_KV_RANK + MLA_ROPE
MLA_SPLITS = (MLA_Q_RANK, MLA_Q_RANK + MLA_KV_RANK)
ROPE_FREQ = MLA_ROPE // 4
ROPE_THETA = 10000.0
Q_BLOCK = 128

IN_COLS = RW_COLS + MLA_COLS

kernel_name = "hybrid_rwkv7_mla_macaron_dit"


def rms_norm(x, g):
    xf = x.astype(jnp.float32)
    y = xf * lax.rsqrt(jnp.mean(xf * xf, axis=-1, keepdims=True) + NORM_EPS)
    return (y * g.astype(jnp.float32)).astype(x.dtype)


def modulate(x, g, shift, scale):
    return rms_norm(x, g) * (1 + scale[..., None, :]) + shift[..., None, :]


def ffn_half_step(x, m, g, w_in, w_out):
    h = modulate(x, g, m[..., 0, :], m[..., 1, :])
    gate, up = jnp.split(h @ w_in, 2, axis=-1)
    return x + FFN_RES * m[..., 2, :][..., None, :] * ((jax.nn.silu(gate) * up) @ w_out)


def grid_shift(z, rows):
    B, T, C = z.shape
    q = C // 4
    zg = z.reshape(B, rows, GRID_W, C)
    left = jnp.pad(zg[:, :, :-1, :q], ((0, 0), (0, 0), (1, 0), (0, 0)))
    right = jnp.pad(zg[:, :, 1:, q:2 * q], ((0, 0), (0, 0), (0, 1), (0, 0)))
    up = jnp.pad(zg[:, :-1, :, 2 * q:3 * q], ((0, 0), (1, 0), (0, 0), (0, 0)))
    down = jnp.pad(zg[:, 1:, :, 3 * q:], ((0, 0), (0, 1), (0, 0), (0, 0)))
    return jnp.concatenate([left, right, up, down], axis=-1).reshape(B, T, C)


def seq_shift(z):
    h = z.shape[-1] // 2
    prev = jnp.pad(z[:, :-1, :h], ((0, 0), (1, 0), (0, 0)))
    nxt = jnp.pad(z[:, 1:, h:], ((0, 0), (0, 1), (0, 0)))
    return jnp.concatenate([prev, nxt], axis=-1)


def rwkv_streams(z, shift_fn, mu, w0, w_up, a0, a_up, g_up, k_k, k_a):
    z = z.astype(jnp.float32)
    z = z + (shift_fn(z) - z) * mu
    r, k, v, wd, ad, gd = jnp.split(z, RW_SPLITS, axis=-1)
    heads = lambda t: t.reshape(t.shape[:-1] + (RW_HEADS, RW_HEAD))
    kk = heads(k * k_k)
    kk = kk / jnp.maximum(jnp.sqrt(jnp.sum(kk * kk, axis=-1, keepdims=True)), 1e-12)
    w_logit = w0[:, None, None, :] + jnp.einsum('btl,dlc->dbtc', jnp.tanh(wd), w_up)
    w = jnp.exp(-RW_DECAY_SCALE * jax.nn.sigmoid(w_logit))
    a = jax.nn.sigmoid(a0[:, None, None, :] + jnp.einsum('btl,dlc->dbtc', ad, a_up))
    k_dir = k[None] * (1 + (a - 1) * k_a)
    g = jax.nn.sigmoid(gd) @ g_up
    return (heads(r), heads(v), kk, heads(w), heads(a), heads(k_dir), g)


def wkv_scan(r, w, k, v, kk, a, s0, reverse):
    def step(S, inp):
        r_t, w_t, k_t, v_t, kk_t, a_t = inp
        s_kk = jnp.einsum('bhvk,bhk->bhv', S, kk_t)
        S = (S * w_t[:, :, None, :] - s_kk[..., None] * (kk_t * a_t)[:, :, None, :]
             + v_t[..., None] * k_t[:, :, None, :])
        return S, jnp.einsum('bhvk,bhk->bhv', S, r_t)
    xs = tuple(jnp.swapaxes(t, 0, 1) for t in (r, w, k, v, kk, a))
    S, ys = lax.scan(step, s0, xs, reverse=reverse)
    return jnp.swapaxes(ys, 0, 1), S


def rwkv_bidirectional(st, s0_f, s0_b):
    r, v, kk, w, a, k_dir, g = st
    y_f, s_f = wkv_scan(r, w[0], k_dir[0], v, kk, a[0], s0_f, False)
    y_b, s_b = wkv_scan(r, w[1], k_dir[1], v, kk, a[1], s0_b, True)
    return y_f + y_b, s_f, s_b


def rwkv_output(y, st, r_k, ln_w, ln_b, dtype):
    r, v, kk, w, a, k_dir, g = st
    B, T = y.shape[:2]
    mean = jnp.mean(y, axis=-1, keepdims=True)
    var = jnp.mean(jnp.square(y - mean), axis=-1, keepdims=True)
    o = ((y - mean) * lax.rsqrt(var + RW_GN_EPS)).reshape(B, T, RW_WIDTH) * ln_w + ln_b
    bonus = jnp.sum(r * jnp.mean(k_dir, axis=0) * r_k, axis=-1, keepdims=True) * v
    o = o + bonus.reshape(B, T, RW_WIDTH)
    return (o * g).astype(dtype)


def axial_rope_tables(T):
    t = jnp.arange(T, dtype=jnp.int32)
    pos = jnp.stack([t // GRID_W, t % GRID_W], axis=-1).astype(jnp.float32)
    inv_freq = ROPE_THETA ** (-jnp.arange(ROPE_FREQ, dtype=jnp.float32) / ROPE_FREQ)
    ang = pos[:, :, None] * inv_freq
    return jnp.cos(ang), jnp.sin(ang)


def apply_axial_rope(x, cos, sin):
    x_nope, x_rot = x[..., :MLA_NOPE], x[..., MLA_NOPE:]
    xr = x_rot.reshape(x_rot.shape[:-1] + (2, 2, ROPE_FREQ)).astype(jnp.float32)
    x1, x2 = xr[..., 0, :], xr[..., 1, :]
    cs, sn = cos[None, :, None], sin[None, :, None]
    rot = jnp.stack([x1 * cs - x2 * sn, x1 * sn + x2 * cs], axis=-2).reshape(x_rot.shape)
    return jnp.concatenate([x_nope, rot.astype(x.dtype)], axis=-1)


def mla_qkv(z, rope, q_norm, q_up, kv_norm, kv_up, q_gain, k_gain):
    B, T, _ = z.shape
    q_lat, kv_lat, k_rope = jnp.split(z, MLA_SPLITS, axis=-1)
    q = (rms_norm(q_lat, q_norm) @ q_up).reshape(B, T, MLA_HEADS, MLA_QK)
    kv = (rms_norm(kv_lat, kv_norm) @ kv_up).reshape(B, T, MLA_HEADS, MLA_NOPE + MLA_V_DIM)
    k_nope, v = jnp.split(kv, [MLA_NOPE], axis=-1)
    k = jnp.concatenate(
        [k_nope, jnp.broadcast_to(k_rope[:, :, None, :], (B, T, MLA_HEADS, MLA_ROPE))], axis=-1)
    q = rms_norm(q, q_gain)
    k = rms_norm(k, k_gain)
    if rope is not None:
        q = apply_axial_rope(q, *rope)
        k = apply_axial_rope(k, *rope)
    return q, k, v


def latent_attention(q, k, v, k_ctx, v_ctx):
    B, S, H, Dq = q.shape
    k_all = jnp.concatenate([k, k_ctx], axis=1)
    v_all = jnp.concatenate([v, v_ctx], axis=1)
    qb = jnp.moveaxis(q.reshape(B, S // Q_BLOCK, Q_BLOCK, H, Dq), 1, 0)
    scale = 1.0 / math.sqrt(Dq)

    def block(q_blk):
        s = jnp.einsum('bqhd,bkhd->bhqk', q_blk, k_all).astype(jnp.float32) * scale
        p = jax.nn.softmax(s, axis=-1).astype(v_all.dtype)
        return jnp.einsum('bhqk,bkhd->bqhd', p, v_all)

    o = lax.map(block, qb)
    return jnp.moveaxis(o, 0, 1).reshape(B, S, H * MLA_V_DIM)


def context_attention(q, k, v):
    B, T, H, Dq = q.shape
    s = jnp.einsum('bqhd,bkhd->bhqk', q, k).astype(jnp.float32) * (1.0 / math.sqrt(Dq))
    p = jax.nn.softmax(s, axis=-1).astype(v.dtype)
    return jnp.einsum('bhqk,bkhd->bqhd', p, v).reshape(B, T, H * MLA_V_DIM)


def setup_inputs(seed: int = 0) -> dict:
    key = jax.random.key(seed)
    ks = iter(jax.random.split(key, 32))
    nrm = lambda shape, scale: jax.random.normal(next(ks), shape, jnp.float32) * scale
    L, D = DEPTH, D_MODEL
    return {
        "x": nrm((BATCH, SEQ, D), 1.0),
        "c": nrm((BATCH, D), 1.0),
        "ctx": nrm((BATCH, CTX_LEN, D), 1.0),
        "c_ctx": nrm((D,), 1.0),
        "w_mod": nrm((L, D, N_MOD * D), 0.5 * D ** -0.5),
        "b_mod": nrm((L, N_MOD * D), 0.02),
        "norm_g": 1.0 + nrm((L, 3, D), 0.05),
        "ffn_w_in": nrm((L, 2, D, 2 * D_FF), D ** -0.5),
        "ffn_w_out": nrm((L, 2, D_FF, D), D_FF ** -0.5),
        "w_in": nrm((L, D, IN_COLS), D ** -0.5),
        "w_out": nrm((L, MIX_WIDTH, D), MIX_WIDTH ** -0.5),
        "rw_mu": jax.random.uniform(next(ks), (L, RW_COLS), jnp.float32, 0.0, 1.0),
        "rw_w0": nrm((L, 2, RW_WIDTH), 1.0),
        "rw_w_up": nrm((L, 2, RW_DECAY_LORA, RW_WIDTH), RW_DECAY_LORA ** -0.5),
        "rw_a0": nrm((L, 2, RW_WIDTH), 0.5),
        "rw_a_up": nrm((L, 2, RW_AAA_LORA, RW_WIDTH), RW_AAA_LORA ** -0.5),
        "rw_g_up": nrm((L, RW_GATE_LORA, RW_WIDTH), RW_GATE_LORA ** -0.5),
        "rw_k_k": 0.85 + nrm((L, RW_WIDTH), 0.05),
        "rw_k_a": 1.0 + nrm((L, RW_WIDTH), 0.05),
        "rw_r_k": nrm((L, RW_HEADS, RW_HEAD), 0.1),
        "rw_ln_w": 1.0 + nrm((L, RW_WIDTH), 0.05),
        "rw_ln_b": nrm((L, RW_WIDTH), 0.02),
        "mla_q_norm": 1.0 + nrm((L, MLA_Q_RANK), 0.05),
        "mla_q_up": nrm((L, MLA_Q_RANK, MLA_HEADS * MLA_QK), MLA_Q_RANK ** -0.5),
        "mla_kv_norm": 1.0 + nrm((L, MLA_KV_RANK), 0.05),
        "mla_kv_up": nrm((L, MLA_KV_RANK, MLA_HEADS * (MLA_NOPE + MLA_V_DIM)), MLA_KV_RANK ** -0.5),
        "mla_q_gain": 1.0 + nrm((L, MLA_QK), 0.05),
        "mla_k_gain": 1.0 + nrm((L, MLA_QK), 0.05),
    }


def reference(x, c, ctx, c_ctx, w_mod, b_mod, norm_g, ffn_w_in, ffn_w_out, w_in, w_out,
              rw_mu, rw_w0, rw_w_up, rw_a0, rw_a_up, rw_g_up, rw_k_k, rw_k_a, rw_r_k,
              rw_ln_w, rw_ln_b, mla_q_norm, mla_q_up, mla_kv_norm, mla_kv_up,
              mla_q_gain, mla_k_gain):
    B, S, _ = x.shape
    rows = S // GRID_W
    lat_shift = functools.partial(grid_shift, rows=rows)
    rope = axial_rope_tables(S)
    s_zero = jnp.zeros((ctx.shape[0], RW_HEADS, RW_HEAD, RW_HEAD), jnp.float32)
    xc = ctx
    for l in range(DEPTH):
        last = l == DEPTH - 1
        mod_x = (jax.nn.silu(c) @ w_mod[l] + b_mod[l]).reshape(B, N_MOD, D_MODEL)
        mod_c = (jax.nn.silu(c_ctx) @ w_mod[l] + b_mod[l]).reshape(N_MOD, D_MODEL)

        x = ffn_half_step(x, mod_x[..., 0:3, :], norm_g[l, 0], ffn_w_in[l, 0], ffn_w_out[l, 0])
        xc = ffn_half_step(xc, mod_c[..., 0:3, :], norm_g[l, 0], ffn_w_in[l, 0], ffn_w_out[l, 0])

        z_x = modulate(x, norm_g[l, 1], mod_x[..., 3, :], mod_x[..., 4, :]) @ w_in[l]
        z_c = modulate(xc, norm_g[l, 1], mod_c[..., 3, :], mod_c[..., 4, :]) @ w_in[l]

        rw_p = (rw_mu[l], rw_w0[l], rw_w_up[l], rw_a0[l], rw_a_up[l], rw_g_up[l], rw_k_k[l], rw_k_a[l])
        st_c = rwkv_streams(z_c[..., :RW_COLS], seq_shift, *rw_p)
        st_x = rwkv_streams(z_x[..., :RW_COLS], lat_shift, *rw_p)
        y_c, s_f, s_b = rwkv_bidirectional(st_c, s_zero, s_zero)
        y_x, _, _ = rwkv_bidirectional(st_x, s_f, s_b)
        o_rw_x = rwkv_output(y_x, st_x, rw_r_k[l], rw_ln_w[l], rw_ln_b[l], x.dtype)

        mla_p = (mla_q_norm[l], mla_q_up[l], mla_kv_norm[l], mla_kv_up[l], mla_q_gain[l], mla_k_gain[l])
        q_c, k_c, v_c = mla_qkv(z_c[..., RW_COLS:], None, *mla_p)
        q_x, k_x, v_x = mla_qkv(z_x[..., RW_COLS:], rope, *mla_p)
        o_mla_x = latent_attention(q_x, k_x, v_x, k_c, v_c)

        x = x + mod_x[..., 5, :][..., None, :] * (
            jnp.concatenate([o_rw_x, o_mla_x], axis=-1) @ w_out[l])
        if not last:
            o_rw_c = rwkv_output(y_c, st_c, rw_r_k[l], rw_ln_w[l], rw_ln_b[l], xc.dtype)
            o_mla_c = context_attention(q_c, k_c, v_c)
            xc = xc + mod_c[..., 5, :][..., None, :] * (
                jnp.concatenate([o_rw_c, o_mla_c], axis=-1) @ w_out[l])

        x = ffn_half_step(x, mod_x[..., 6:9, :], norm_g[l, 2], ffn_w_in[l, 1], ffn_w_out[l, 1])
        if not last:
            xc = ffn_half_step(xc, mod_c[..., 6:9, :], norm_g[l, 2], ffn_w_in[l, 1], ffn_w_out[l, 1])
    return x
```

```cpp
#include <hip/hip_runtime.h>
#include <cstdio>
#include <cstdint>
#define MK_ONE_LAUNCH 0
#define DBG_STOP 1000
#ifndef MK_ONE_LAUNCH
#define MK_ONE_LAUNCH 1
#endif
namespace pg8 {
#define PG8_LAS __attribute__((address_space(3)))
typedef unsigned short bf16_t;
typedef short bf16x8 __attribute__((ext_vector_type(8)));
typedef float f32x4 __attribute__((ext_vector_type(4)));
typedef unsigned u32x4 __attribute__((ext_vector_type(4)));
constexpr int BM = 256, BK = 64, HALF = 128, HTB = HALF * BK * 2  , STAGE_BYTES = 8 * HTB, NXCD = 8, WGM = 8;

__host__ __device__ __forceinline__ int lds_byte(int r, int c) { const int st = (r >> 4) * 2 + (c >> 5), rr = r & 15, cc = c & 31, ob = rr * 64 + cc * 2; return st * 1024 + (ob ^ (((ob >> 9) & 1) << 5)); }
__host__ __device__ __forceinline__ void stage_rc(int b, int& R, int& C) { const int st = b / 1024, sb = b % 1024, swz = sb ^ (((sb >> 9) & 1) << 5); R = (st >> 1) * 16 + swz / 64; C = (st & 1) * 32 + (swz % 64) / 2; }
__host__ __device__ __forceinline__ int perm32(int rho) { const int n = rho >> 4, i = rho & 15; return 8 * (i >> 2) + 4 * n + (i & 3); }

struct Unit { int pm, pn; };
struct Gemm { const bf16_t* A; const bf16_t* Bt; int M, N, K; };

struct StaticOrder {
    int nM, nN, nwg, G, c;
    __host__ __device__ void init(int M, int N, int G_, int c_) { nM = M / BM; nN = N / BM; nwg = nM * nN; G = G_; c = c_; }
    __host__ __device__ bool next(int i, Unit& u) const {
        const long L = (long)i * G + c; if (L >= nwg) return false;
        int wgid = (int)L; { const int q = nwg / NXCD, r = nwg % NXCD, xcd = wgid % NXCD, off = wgid / NXCD; wgid = (xcd < r ? xcd * (q + 1) : r * (q + 1) + (xcd - r) * q) + off; }
        const int nig = WGM * nN, gid = wgid / nig, fm = gid * WGM, gsz = (nM - fm) < WGM ? (nM - fm) : WGM;
        u.pm = fm + ((wgid % nig) % gsz); u.pn = (wgid % nig) / gsz; return true;
    }
    __device__ __forceinline__ void a_ready(const Unit&) const {}
    __device__ __forceinline__ void done(const Unit&) const {}
};

__device__ __forceinline__ unsigned cvt_pk_bf16(float lo, float hi) { unsigned r; asm volatile("v_cvt_pk_bf16_f32 %0, %1, %2" : "=v"(r) : "v"(lo), "v"(hi)); return r; }
template <class Epi, class Sched, bool ALIGN_EPI = false, bool SP2 = false>
__device__ __forceinline__ void gemm_phase(PG8_LAS unsigned char* lds, const Gemm g, const Sched& S, const Epi& E, int wave_in) {
    int tid_o; asm volatile("v_mbcnt_lo_u32_b32 %0, -1, 0\n\tv_mbcnt_hi_u32_b32 %0, -1, %0" : "=v"(tid_o)); tid_o += wave_in * 64;
    const int tid = tid_o, wid = wave_in, lane = tid & 63, wr = wid >> 2, wc = wid & 3, fr = lane & 15, fq = lane >> 4;
    const int K = g.K, nt = K / BK;
    unsigned voffA[2], voffB[2];
#pragma unroll
    for (int i = 0; i < 2; ++i) { int R, C; stage_rc(tid * 16 + i * 8192, R, C); const int Rb = Epi::PERM ? ((R & ~31) + perm32(R & 31)) : R;
        voffA[i] = (unsigned)(R * K + C) * 2u; voffB[i] = (unsigned)(Rb * K + C) * 2u; }
    const size_t kstep = (size_t)(BK * 2);
    const size_t hstep = (size_t)HALF * K * 2;
    const size_t tstep = 2 * hstep;
    const unsigned ldsw = (unsigned)wid * 1024u;
    const int aoff = lds_byte(wr * 64 + fr, fq * 8), boff = lds_byte(wc * 32 + fr, fq * 8);
#define PG8_SA(b, h) (((b) * 2 + (h)) * HTB)
#define PG8_SB(b, h) ((4 + (b) * 2 + (h)) * HTB)
#define PG8_STAGE(bufoff, gbase, voff) do { _Pragma("unroll") for (int _i = 0; _i < 2; ++_i) \
        __builtin_amdgcn_global_load_lds((const unsigned*)((const char*)(gbase) + (voff)[_i]), (PG8_LAS unsigned*)(lds + (bufoff) + ldsw + _i * 8192), 16, 0, 0); } while (0)
#define PG8_LDA(dst, b, h) do { _Pragma("unroll") for (int m = 0; m < 4; ++m) _Pragma("unroll") for (int k = 0; k < 2; ++k) dst[m][k] = *(const PG8_LAS bf16x8*)(lds + PG8_SA(b, h) + aoff + m * 2048 + k * 1024); } while (0)
#define PG8_LDB(dst, b, h) do { _Pragma("unroll") for (int n = 0; n < 2; ++n) _Pragma("unroll") for (int k = 0; k < 2; ++k) dst[n][k] = *(const PG8_LAS bf16x8*)(lds + PG8_SB(b, h) + boff + n * 2048 + k * 1024); } while (0)
#define PG8_MMA(ai, bj, At, Bt) do { __builtin_amdgcn_s_setprio(1); _Pragma("unroll") for (int m = 0; m < 4; ++m) _Pragma("unroll") for (int n = 0; n < 2; ++n) _Pragma("unroll") for (int k = 0; k < 2; ++k) \
        acc[ai][bj][m][n] = __builtin_amdgcn_mfma_f32_16x16x32_bf16(Bt[n][k], At[m][k], acc[ai][bj][m][n], 0, 0, 0); __builtin_amdgcn_s_setprio(0); } while (0)
#define PG8_WAIT_V(n) asm volatile("s_waitcnt vmcnt(" #n ")" ::: "memory")
#define PG8_WAIT_L(n) asm volatile("s_waitcnt lgkmcnt(" #n ")" ::: "memory")
#define PG8_BAR __builtin_amdgcn_s_barrier()
#define PG8_SCHED __builtin_amdgcn_sched_barrier(0)
    Unit cur, nxt; int ui = 0;
    if (!S.next(0, cur)) return;
    f32x4 acc[2][2][4][2];
#pragma unroll
    for (int a = 0; a < 2; ++a)
#pragma unroll
        for (int b = 0; b < 2; ++b)
#pragma unroll
            for (int m = 0; m < 4; ++m)
#pragma unroll
                for (int n = 0; n < 2; ++n) acc[a][b][m][n] = (f32x4){0.f, 0.f, 0.f, 0.f};
    bf16x8 At[4][2], B0[2][2], B1[2][2];
    const char* cA = (const char*)g.A + (size_t)cur.pm * tstep; const char* cB = (const char*)g.Bt + (size_t)cur.pn * tstep;
    S.a_ready(cur);
    if constexpr (SP2) {
        PG8_STAGE(PG8_SB(0, 0), cB, voffB); PG8_STAGE(PG8_SB(0, 1), cB + hstep, voffB); PG8_STAGE(PG8_SA(0, 0), cA, voffA); PG8_STAGE(PG8_SA(0, 1), cA + hstep, voffA);
        if (wr == 1) PG8_BAR;
        PG8_WAIT_V(2); PG8_BAR;
        PG8_STAGE(PG8_SB(1, 0), cB + kstep, voffB); PG8_STAGE(PG8_SA(1, 0), cA + kstep, voffA); PG8_STAGE(PG8_SB(1, 1), cB + hstep + kstep, voffB);
        PG8_WAIT_V(6); PG8_BAR;
    } else {
        PG8_STAGE(PG8_SB(0, 0), cB, voffB); PG8_STAGE(PG8_SA(0, 0), cA, voffA); PG8_STAGE(PG8_SB(0, 1), cB + hstep, voffB); PG8_STAGE(PG8_SA(0, 1), cA + hstep, voffA);
        if (wr == 1) PG8_BAR;
        PG8_WAIT_V(4); PG8_BAR;
        PG8_STAGE(PG8_SB(1, 0), cB + kstep, voffB); PG8_STAGE(PG8_SA(1, 0), cA + kstep, voffA); PG8_STAGE(PG8_SB(1, 1), cB + hstep + kstep, voffB);
        PG8_WAIT_V(6); PG8_BAR;
    }
    for (;;) {
        const bool has_next = S.next(ui + 1, nxt);
        const char* nA = has_next ? (const char*)g.A + (size_t)nxt.pm * tstep : cA; const char* nB = has_next ? (const char*)g.Bt + (size_t)nxt.pn * tstep : cB;
        for (int t = 0; t < nt; t += 2) {
            const bool last = (t == nt - 2);
            const char* a1 = cA + (size_t)(t + 1) * kstep;
            const char* a2 = last ? nA : cA + (size_t)(t + 2) * kstep; const char* b2 = last ? nB : cB + (size_t)(t + 2) * kstep;
            const char* a3 = a2 + kstep; const char* b3 = b2 + kstep;
            if (last && has_next) S.a_ready(nxt);
            if constexpr (SP2) {
            PG8_LDB(B0, 0, 0); PG8_LDB(B1, 0, 1); PG8_SCHED; PG8_LDA(At, 0, 0); PG8_STAGE(PG8_SA(1, 1), a1 + hstep, voffA);
            PG8_WAIT_V(8); PG8_WAIT_L(0); PG8_BAR; PG8_MMA(0, 0, At, B0); PG8_MMA(0, 1, At, B1); PG8_BAR; PG8_SCHED;
            PG8_LDA(At, 0, 1); PG8_STAGE(PG8_SB(0, 0), b2, voffB); PG8_STAGE(PG8_SB(0, 1), b2 + hstep, voffB); PG8_STAGE(PG8_SA(0, 0), a2, voffA);
            PG8_WAIT_V(8); PG8_WAIT_L(0); PG8_BAR; PG8_MMA(1, 0, At, B0); PG8_MMA(1, 1, At, B1); PG8_BAR; PG8_SCHED;
            PG8_LDB(B0, 1, 0); PG8_LDB(B1, 1, 1); PG8_SCHED; PG8_LDA(At, 1, 0); PG8_STAGE(PG8_SA(0, 1), a2 + hstep, voffA);
            PG8_WAIT_V(8); PG8_WAIT_L(0); PG8_BAR; PG8_MMA(0, 0, At, B0); PG8_MMA(0, 1, At, B1); PG8_BAR; PG8_SCHED;
            PG8_LDA(At, 1, 1); PG8_STAGE(PG8_SB(1, 0), b3, voffB); PG8_STAGE(PG8_SB(1, 1), b3 + hstep, voffB); PG8_STAGE(PG8_SA(1, 0), a3, voffA);
            PG8_WAIT_V(8); PG8_WAIT_L(0); PG8_BAR; PG8_MMA(1, 0, At, B0); PG8_MMA(1, 1, At, B1); PG8_BAR; PG8_SCHED;
            } else {
            PG8_LDB(B0, 0, 0); PG8_SCHED; PG8_LDA(At, 0, 0); PG8_STAGE(PG8_SA(1, 1), a1 + hstep, voffA);
            PG8_WAIT_L(8); PG8_BAR; PG8_WAIT_L(0); PG8_MMA(0, 0, At, B0); PG8_BAR; PG8_SCHED;
            PG8_LDB(B1, 0, 1); PG8_STAGE(PG8_SB(0, 0), b2, voffB);
            PG8_BAR; PG8_WAIT_L(0); PG8_MMA(0, 1, At, B1); PG8_BAR;
            PG8_LDA(At, 0, 1); PG8_STAGE(PG8_SA(0, 0), a2, voffA);
            PG8_BAR; PG8_WAIT_L(0); PG8_MMA(1, 0, At, B0); PG8_BAR; PG8_SCHED;
            PG8_STAGE(PG8_SB(0, 1), b2 + hstep, voffB);
            PG8_WAIT_V(6); PG8_BAR; PG8_MMA(1, 1, At, B1); PG8_BAR;
            PG8_LDB(B0, 1, 0); PG8_SCHED; PG8_LDA(At, 1, 0); PG8_STAGE(PG8_SA(0, 1), a2 + hstep, voffA);
            PG8_WAIT_L(8); PG8_BAR; PG8_WAIT_L(0); PG8_MMA(0, 0, At, B0); PG8_BAR; PG8_SCHED;
            PG8_LDB(B1, 1, 1); PG8_STAGE(PG8_SB(1, 0), b3, voffB);
            PG8_BAR; PG8_WAIT_L(0); PG8_MMA(0, 1, At, B1); PG8_BAR;
            PG8_LDA(At, 1, 1); PG8_STAGE(PG8_SA(1, 0), a3, voffA);
            PG8_BAR; PG8_WAIT_L(0); PG8_MMA(1, 0, At, B0); PG8_BAR; PG8_SCHED;
            PG8_STAGE(PG8_SB(1, 1), b3 + hstep, voffB);
            PG8_WAIT_V(6); PG8_BAR; PG8_MMA(1, 1, At, B1); PG8_BAR;
            }
        }
        if constexpr (ALIGN_EPI) { if (wr == 0) PG8_BAR; }
        if constexpr (!Epi::AFTER_DRAIN) { E(acc, cur, wr, wc, fr, fq); S.done(cur); }
        if (!has_next) break;
#pragma unroll
        for (int a = 0; a < 2; ++a)
#pragma unroll
            for (int b = 0; b < 2; ++b)
#pragma unroll
                for (int m = 0; m < 4; ++m)
#pragma unroll
                    for (int n = 0; n < 2; ++n) acc[a][b][m][n] = (f32x4){0.f, 0.f, 0.f, 0.f};
        cur = nxt; cA = nA; cB = nB; ++ui;
        if constexpr (ALIGN_EPI) { if (wr == 1) PG8_BAR; }
    }
    PG8_WAIT_V(0);
    if constexpr (!ALIGN_EPI) { if (wr == 0) PG8_BAR; }
    PG8_BAR;
    if constexpr (Epi::AFTER_DRAIN) { E.fused(acc, cur, wr, wc, fr, fq, lds, wid, lane); S.done(cur); }
#undef PG8_SA
#undef PG8_SB
#undef PG8_STAGE
#undef PG8_LDA
#undef PG8_LDB
#undef PG8_MMA
#undef PG8_WAIT_V
#undef PG8_WAIT_L
#undef PG8_BAR
#undef PG8_SCHED
}
}
#define GAS __attribute__((address_space(1)))
#define LAS __attribute__((address_space(3)))
typedef unsigned short bf16;
typedef unsigned v4u __attribute__((ext_vector_type(4)));
typedef float f32x4 __attribute__((ext_vector_type(4)));
typedef short bf16x8 __attribute__((ext_vector_type(8)));
typedef GAS unsigned gu32;
typedef GAS unsigned long long gu64;
#define RLX_AGENT __ATOMIC_RELAXED, __HIP_MEMORY_SCOPE_AGENT
#define LDS_WAIT() asm volatile("s_waitcnt lgkmcnt(0)" ::: "memory")
#define VM_WAIT() asm volatile("s_waitcnt vmcnt(0)" ::: "memory")
__device__ __forceinline__ unsigned long long rt() { return __builtin_amdgcn_s_memrealtime(); }
__device__ __forceinline__ unsigned f2bf(float f) { unsigned u = __builtin_bit_cast(unsigned, f); return (u + 0x7fffu + ((u >> 16) & 1u)) >> 16; }
__device__ __forceinline__ unsigned pk2(float lo, float hi) { return f2bf(lo) | (f2bf(hi) << 16); }

#define XB_TMO      128
#define XB_XCNT(j)  (256  + 64 * (j))
#define XB_XSUB(j)  (1280 + 64 * (j))
#define XB_XGEN(j)  (2304 + 64 * (j))
#define XB_TOP      3328
#define XB_TOPGEN   3392
#define XCD_BAR_WORDS 3456
#define XB_SPIN_CAP (1u << 18)

__device__ __forceinline__ unsigned xb_ld(unsigned* p)              { return __hip_atomic_load(p, __ATOMIC_RELAXED, __HIP_MEMORY_SCOPE_AGENT); }
__device__ __forceinline__ unsigned xb_add(unsigned* p, unsigned v) { return __hip_atomic_fetch_add(p, v, __ATOMIC_RELAXED, __HIP_MEMORY_SCOPE_AGENT); }
__device__ __forceinline__ unsigned xb_xcc_id() { return (unsigned)__builtin_amdgcn_s_getreg((3 << 11) | 20) & 0xFu; }
#define XB_SPIN(cond, bar) do { unsigned _sp = 0; while (cond) { __builtin_amdgcn_s_sleep(1); \
    if ((++_sp & 255u) == 0u) { if (xb_ld(&(bar)[XB_TMO])) break; if (_sp > XB_SPIN_CAP) { atomicAdd(&(bar)[XB_TMO], 1u); break; } } } } while (0)

struct XcdBarrier {
    unsigned* bar; unsigned x;
    volatile LAS unsigned* st;
    int wave;
};
__device__ __forceinline__ int xb_lane() { int l; asm volatile("v_mbcnt_lo_u32_b32 %0, -1, 0\n\tv_mbcnt_hi_u32_b32 %0, -1, %0" : "=v"(l)); return l; }

__device__ __forceinline__ XcdBarrier xcd_barrier_post(unsigned* bar, volatile LAS unsigned* st) {
    XcdBarrier b; b.bar = bar; b.x = xb_xcc_id(); b.st = st; b.wave = 0;
    if (threadIdx.x == 0) (void)xb_add(&bar[XB_XCNT(b.x)], 1u);
    return b;
}
__device__ __forceinline__ void xcd_barrier_complete(unsigned* bar, unsigned x, unsigned& nloc, unsigned& nx) {
    const unsigned G = gridDim.x * gridDim.y * gridDim.z;
    unsigned sum, cnt, mine, sp = 0u;
    for (;;) {
        sum = 0u; cnt = 0u; mine = 0u;
#pragma unroll
        for (unsigned j = 0; j < 16; ++j) { const unsigned c = xb_ld(&bar[XB_XCNT(j)]); sum += c; cnt += (c > 0u) ? 1u : 0u; mine = (j == x) ? c : mine; }
        if (sum == G) break;
        __builtin_amdgcn_s_sleep(1);
        if ((++sp & 255u) == 0u) { if (xb_ld(&bar[XB_TMO])) break; if (sp > XB_SPIN_CAP) { atomicAdd(&bar[XB_TMO], 1u); break; } }
    }
    nloc = mine > 0u ? mine : 1u; nx = cnt > 0u ? cnt : 1u;
}

__device__ __forceinline__ void xcd_barrier(const XcdBarrier& b) {
    asm volatile("s_waitcnt vmcnt(0)" ::: "memory");
    __syncthreads();
    if (b.wave == 0 && xb_lane() == 0) {
        unsigned* bar = b.bar;
        __builtin_amdgcn_s_waitcnt(0);
        unsigned nloc = b.st[0], nx = b.st[1];
        if (nloc == 0u) { xcd_barrier_complete(bar, b.x, nloc, nx); b.st[0] = nloc; b.st[1] = nx; }
        const unsigned old = xb_add(&bar[XB_XSUB(b.x)], 1u);
        const unsigned gen = old / nloc;
        if (old + 1u == (gen + 1u) * nloc) {
            __builtin_amdgcn_fence(__ATOMIC_RELEASE, "agent");
            asm volatile("s_waitcnt vmcnt(0)" ::: "memory");
            const unsigned og = xb_add(&bar[XB_TOP], 1u);
            const unsigned tg = og / nx;
            if (og + 1u == (tg + 1u) * nx) xb_add(&bar[XB_TOPGEN], 1u);
            else XB_SPIN(xb_ld(&bar[XB_TOPGEN]) == tg, bar);
            __builtin_amdgcn_fence(__ATOMIC_ACQUIRE, "agent");
            xb_add(&bar[XB_XGEN(b.x)], 1u);
            asm volatile("s_waitcnt vmcnt(0)" ::: "memory");
        } else {
            XB_SPIN(xb_ld(&bar[XB_XGEN(b.x)]) == gen, bar);
            __builtin_amdgcn_fence(__ATOMIC_ACQUIRE, "agent");
            asm volatile("s_waitcnt vmcnt(0)" ::: "memory");
        }
    }
    __syncthreads();
}

constexpr int NWAVES = 8, NTHR = 512;
constexpr int DM = 4096, SEQ = 8192, CTXL = 256, MROWS = SEQ + CTXL, DFF = 8192, NMODC = 9 * DM;
constexpr int RWW = 2048, RWCOLS = 6592, ZC = 8192;
constexpr int LDS_BYTES = 155648;
constexpr int MISC_OFF = 151552;

constexpr size_t MiB = 1u << 20;
constexpr size_t al(size_t x) { return (x + MiB - 1) / MiB * MiB; }
constexpr size_t WS_CTL = 0, WS_MOD = 1 * MiB, ZERO_BYTES = 2 * MiB;
constexpr size_t SZ_WFI = (size_t)16384 * 4096 * 2, SZ_WFO = (size_t)4096 * 8192 * 2, SZ_WIN = (size_t)8192 * 4096 * 2, SZ_WOUT = (size_t)4096 * 4096 * 2;
constexpr size_t SZ_WQ = (size_t)3072 * 1024 * 2, SZ_WKV = (size_t)4096 * 512 * 2, SZ_WWA = (size_t)10240 * 512 * 2, SZ_WG = 0;
constexpr size_t WS_WFI = 2 * MiB, WS_WFO = WS_WFI + 4 * SZ_WFI, WS_WIN = WS_WFO + 4 * SZ_WFO, WS_WOUT = WS_WIN + 2 * SZ_WIN, WS_WQ = WS_WOUT + 2 * SZ_WOUT;
constexpr size_t WS_WKV = WS_WQ + 2 * SZ_WQ, WS_WWA = WS_WKV + 2 * SZ_WKV, WS_WG = WS_WWA + 2 * SZ_WWA, WS_ACT = WS_WG + 2 * SZ_WG;
constexpr size_t WS_X = WS_ACT;
constexpr size_t WS_XN = WS_X + al((size_t)MROWS * DM * 4);
constexpr size_t WS_H = WS_XN + al((size_t)MROWS * DM * 2);
constexpr size_t WS_Z = WS_H + al((size_t)MROWS * DFF * 2);
constexpr size_t WS_SS = WS_Z + al((size_t)MROWS * ZC * 4);
constexpr size_t WS_VV = WS_SS + al((size_t)MROWS * 4096 * 4);
constexpr size_t WS_KT = WS_VV + al((size_t)MROWS * 2048 * 4);
constexpr size_t WS_SD = WS_KT + al((size_t)MROWS * 2048 * 4);
constexpr size_t WS_LWA = WS_SD + al((size_t)2 * MROWS * 6144 * 4);
constexpr size_t WS_LG = WS_LWA + al((size_t)MROWS * 512 * 2);
constexpr size_t WS_G = WS_LG + al((size_t)MROWS * 256 * 2);
constexpr size_t WS_QL = WS_G + al((size_t)MROWS * 2048 * 4);
constexpr size_t WS_KVL = WS_QL + al((size_t)MROWS * 1024 * 2);
constexpr size_t WS_QF = WS_KVL + al((size_t)MROWS * 512 * 2);
constexpr size_t WS_KVF = WS_QF + al((size_t)MROWS * 3072 * 4);
#ifndef QB_GAP
#define QB_GAP 0
#endif
constexpr size_t WS_QB = WS_KVF + al((size_t)MROWS * 4096 * 4) + (size_t)QB_GAP * MiB;
constexpr size_t WS_KB = WS_QB + al((size_t)MROWS * 3072 * 2);
constexpr size_t WS_VB = WS_KB + al((size_t)MROWS * 3072 * 2);
constexpr size_t WS_Y = WS_VB + al((size_t)MROWS * 2048 * 2);
constexpr size_t WS_OC = WS_Y + al((size_t)2 * MROWS * 2048 * 4);
constexpr size_t WS_END = WS_OC + al((size_t)MROWS * DM * 2);
constexpr int CW_BAR = 4096;

enum { I_X = 0, I_C, I_CTX, I_CCTX, I_WMOD, I_BMOD, I_NORMG, I_FWI, I_FWO, I_WIN, I_WOUT, I_MU, I_W0, I_WUP, I_A0, I_AUP, I_GUP, I_KK, I_KA, I_RK, I_LNW, I_LNB,
       I_QNORM, I_QUP, I_KVNORM, I_KVUP, I_QGAIN, I_KGAIN, N_IN };

__device__ __forceinline__ int lane_vol() { int l; asm volatile("v_mbcnt_lo_u32_b32 %0, -1, 0\n\tv_mbcnt_hi_u32_b32 %0, -1, %0" : "=v"(l)); return l; }
__device__ __forceinline__ float wave_sum(float v) {
#pragma unroll
    for (int o = 1; o < 64; o <<= 1) v += __shfl_xor(v, o);
    return v;
}
__device__ __forceinline__ float sum16(float v) {
#pragma unroll
    for (int o = 1; o < 16; o <<= 1) v += __shfl_xor(v, o);
    return v;
}
__device__ __forceinline__ float sigm(float x) { return __builtin_amdgcn_rcpf(1.f + __builtin_amdgcn_exp2f(-1.4426950408889634f * x)); }
__device__ __forceinline__ float dot4(f32x4 a, f32x4 b) { return (a.x * b.x + a.y * b.y) + (a.z * b.z + a.w * b.w); }
typedef unsigned u32x2 __attribute__((ext_vector_type(2)));
__device__ __forceinline__ u32x2 pk4(f32x4 v) { u32x2 r; r.x = pg8::cvt_pk_bf16(v.x, v.y); r.y = pg8::cvt_pk_bf16(v.z, v.w); return r; }

struct EpiSwiGLU {
    static constexpr bool PERM = true, AFTER_DRAIN = false;
    bf16* H;
    __device__ __forceinline__ void operator()(const pg8::f32x4 (&acc)[2][2][4][2], const pg8::Unit& u, int wr, int wc, int fr, int fq) const {
        const int row0 = u.pm * 256 + wr * 64 + fr, col0 = u.pn * 128 + wc * 32 + 8 * fq;
#pragma unroll
        for (int ai = 0; ai < 2; ++ai)
#pragma unroll
            for (int m = 0; m < 4; ++m) {
                bf16* rowp = H + (size_t)(row0 + ai * 128 + m * 16) * DFF + col0;
                const pg8::f32x4 g0 = acc[ai][0][m][0], g1 = acc[ai][0][m][1], u0 = acc[ai][1][m][0], u1 = acc[ai][1][m][1];
                pg8::u32x4 w;
                w.x = pg8::cvt_pk_bf16(g0[0] * sigm(g0[0]) * u0[0], g0[1] * sigm(g0[1]) * u0[1]);
                w.y = pg8::cvt_pk_bf16(g0[2] * sigm(g0[2]) * u0[2], g0[3] * sigm(g0[3]) * u0[3]);
                w.z = pg8::cvt_pk_bf16(g1[0] * sigm(g1[0]) * u1[0], g1[1] * sigm(g1[1]) * u1[1]);
                w.w = pg8::cvt_pk_bf16(g1[2] * sigm(g1[2]) * u1[2], g1[3] * sigm(g1[3]) * u1[3]);
                *(pg8::u32x4*)rowp = w;
            }
    }
};
struct EpiRes {
    static constexpr bool PERM = false, AFTER_DRAIN = false;
    const float* inL; const float* inC; float* outL; float* outC; const float* gateL; const float* gateC; float coef;
    __device__ __forceinline__ void operator()(const pg8::f32x4 (&acc)[2][2][4][2], const pg8::Unit& u, int wr, int wc, int fr, int fq) const {
        const bool lat = u.pm < 32;
        const int rl0 = (lat ? u.pm : u.pm - 32) * 256 + wr * 64 + fr, col0 = u.pn * 256 + wc * 32 + 4 * fq;
        const float* in = lat ? inL : inC; float* out = lat ? outL : outC; const float* gate = lat ? gateL : gateC;
        pg8::f32x4 gv[2][2];
#pragma unroll
        for (int bj = 0; bj < 2; ++bj)
#pragma unroll
            for (int n = 0; n < 2; ++n) gv[bj][n] = *(const pg8::f32x4*)(gate + col0 + bj * 128 + n * 16) * coef;
#pragma unroll
        for (int ai = 0; ai < 2; ++ai)
#pragma unroll
            for (int m = 0; m < 4; ++m) {
                const size_t off = (size_t)(rl0 + ai * 128 + m * 16) * DM + col0;
#pragma unroll
                for (int bj = 0; bj < 2; ++bj)
#pragma unroll
                    for (int n = 0; n < 2; ++n) { const pg8::f32x4 xi = *(const pg8::f32x4*)(in + off + bj * 128 + n * 16);
                        *(pg8::f32x4*)(out + off + bj * 128 + n * 16) = xi + gv[bj][n] * acc[ai][bj][m][n]; }
            }
    }
};
struct EpiF32 {
    static constexpr bool PERM = false, AFTER_DRAIN = false;
    float* C; int ldc;
    __device__ __forceinline__ void operator()(const pg8::f32x4 (&acc)[2][2][4][2], const pg8::Unit& u, int wr, int wc, int fr, int fq) const {
        const int row0 = u.pm * 256 + wr * 64 + fr, col0 = u.pn * 256 + wc * 32 + 4 * fq;
#pragma unroll
        for (int ai = 0; ai < 2; ++ai)
#pragma unroll
            for (int m = 0; m < 4; ++m) { float* rowp = C + (size_t)(row0 + ai * 128 + m * 16) * ldc + col0;
#pragma unroll
                for (int bj = 0; bj < 2; ++bj)
#pragma unroll
                    for (int n = 0; n < 2; ++n) *(pg8::f32x4*)(rowp + bj * 128 + n * 16) = acc[ai][bj][m][n]; }
    }
};
struct EpiWA {
    static constexpr bool PERM = false, AFTER_DRAIN = false;
    const float* w0; const float* a0; const float* k_a; const float* KT; const float* SS; float* SD; float* Gout;
    __device__ __forceinline__ void operator()(const pg8::f32x4 (&acc)[2][2][4][2], const pg8::Unit& u, int wr, int wc, int fr, int fq) const {
        if (u.pn >= 32) {
            const int row0g = u.pm * 256 + wr * 64 + fr, col0g = (u.pn - 32) * 256 + wc * 32 + 4 * fq;
#pragma unroll
            for (int ai = 0; ai < 2; ++ai)
#pragma unroll
                for (int m = 0; m < 4; ++m) { float* rowp = Gout + (size_t)(row0g + ai * 128 + m * 16) * RWW + col0g;
#pragma unroll
                    for (int bj = 0; bj < 2; ++bj)
#pragma unroll
                        for (int n = 0; n < 2; ++n) *(pg8::f32x4*)(rowp + bj * 128 + n * 16) = acc[ai][bj][m][n]; }
            return;
        }
        const bool isA = u.pn >= 16; const int pp = u.pn & 15, d = pp >> 3, chb = (pp & 7) * 256 + wc * 32 + 4 * fq;
        const int row0 = u.pm * 256 + wr * 64 + fr;
        const float* bias = (isA ? a0 : w0) + d * RWW;
#pragma unroll
        for (int bj = 0; bj < 2; ++bj)
#pragma unroll
            for (int n = 0; n < 2; ++n) {
                const int ch = chb + bj * 128 + n * 16, h = ch >> 6, e = ch & 63;
                const pg8::f32x4 b4 = *(const pg8::f32x4*)(bias + ch);
                if (!isA) {
#pragma unroll
                    for (int ai = 0; ai < 2; ++ai)
#pragma unroll
                        for (int m = 0; m < 4; ++m) { const int row = row0 + ai * 128 + m * 16; const pg8::f32x4 x = acc[ai][bj][m][n] + b4; pg8::f32x4 w;
#pragma unroll
                            for (int j = 0; j < 4; ++j) w[j] = __builtin_amdgcn_exp2f(-0.60653065971263342f * 1.4426950408889634f * sigm(x[j]));
                            *(pg8::f32x4*)(SD + ((size_t)(d * MROWS + row) * 32 + h) * 192 + e) = w; }
                } else {
                    const pg8::f32x4 ka = *(const pg8::f32x4*)(k_a + ch);
#pragma unroll
                    for (int ai = 0; ai < 2; ++ai)
#pragma unroll
                        for (int m = 0; m < 4; ++m) { const int row = row0 + ai * 128 + m * 16; const pg8::f32x4 x = acc[ai][bj][m][n] + b4;
                            const pg8::f32x4 k4 = *(const pg8::f32x4*)(KT + (size_t)row * RWW + ch), kk4 = *(const pg8::f32x4*)(SS + ((size_t)(row * 32 + h) * 2 + 1) * 64 + e);
                            pg8::f32x4 kd, kka;
#pragma unroll
                            for (int j = 0; j < 4; ++j) { const float a = sigm(x[j]); kd[j] = k4[j] * (1.f + (a - 1.f) * ka[j]); kka[j] = kk4[j] * a; }
                            float* dst = SD + ((size_t)(d * MROWS + row) * 32 + h) * 192 + e;
                            *(pg8::f32x4*)(dst + 64) = kd; *(pg8::f32x4*)(dst + 128) = kka; asm volatile("" ::: "memory"); }
                }
            }
    }
};

template <int MAP> __device__ __forceinline__ int map_row(int n) {
    if (MAP == 1) { const int bj = n >> 13, r = n & 8191; return 256 * (r >> 7) + 128 * bj + (r & 127); }
    return n;
}
template <int MAP> __device__ __forceinline__ void transpose_item(const float* W, int K, int N, bf16* WT, LAS float* scr, int item, int lane) {
    const int nblk = N >> 6, kb = item / nblk, nb = item - kb * nblk, k0 = kb * 64, n0 = nb * 64;
    const int kr = lane >> 4, nq = lane & 15;
    f32x4 v[16];
#pragma unroll
    for (int i = 0; i < 16; ++i) v[i] = *(const f32x4*)(W + (size_t)(k0 + 4 * i + kr) * N + n0 + 4 * nq);
#pragma unroll
    for (int i = 0; i < 16; ++i) { const int k = 4 * i + kr;
        scr[(4 * nq + 0) * 65 + k] = v[i].x; scr[(4 * nq + 1) * 65 + k] = v[i].y; scr[(4 * nq + 2) * 65 + k] = v[i].z; scr[(4 * nq + 3) * 65 + k] = v[i].w; }
    LDS_WAIT(); asm volatile("" ::: "memory");
    const int c = lane & 7, nl = lane >> 3, r0 = map_row<MAP>(n0);
#pragma unroll
    for (int j = 0; j < 8; ++j) { const int n = nl + 8 * j; const LAS float* s = scr + n * 65 + 8 * c;
        v4u o; o.x = pk2(s[0], s[1]); o.y = pk2(s[2], s[3]); o.z = pk2(s[4], s[5]); o.w = pk2(s[6], s[7]);
        *(v4u*)(WT + (size_t)(r0 + n) * K + k0 + 8 * c) = o; }
    LDS_WAIT(); asm volatile("" ::: "memory");
}

struct Ptrs {
    const float* in[N_IN]; float* out; unsigned char* ws;
};
constexpr int PT_OFF = 151552 + 1024;
__device__ __forceinline__ unsigned long long ld_uptr(LAS unsigned char* lds, int i) {
    const unsigned long long v = *(const LAS unsigned long long*)(lds + PT_OFF + 8 * i);
    const unsigned lo = __builtin_amdgcn_readfirstlane((unsigned)v), hi = __builtin_amdgcn_readfirstlane((unsigned)(v >> 32));
    return ((unsigned long long)hi << 32) | lo;
}
__device__ __forceinline__ Ptrs load_ptrs(LAS unsigned char* lds) {
    asm volatile("" ::: "memory");
    Ptrs P;
#pragma unroll
    for (int i = 0; i < N_IN; ++i) P.in[i] = (const float*)(const GAS float*)ld_uptr(lds, i);
    P.out = (float*)(GAS float*)ld_uptr(lds, N_IN); P.ws = (unsigned char*)(GAS unsigned char*)ld_uptr(lds, N_IN + 1);
    return P;
}

__device__ __forceinline__ void prologue_phase(LAS unsigned char* lds, int vcu, int G, int wave) {
    const Ptrs P = load_ptrs(lds); const int lane = lane_vol(), tid = wave * 64 + lane;
    unsigned char* ws = P.ws;
    {
        LAS float* sil = (LAS float*)lds; LAS float* red = (LAS float*)(lds + 32768);
        for (int i = tid; i < DM; i += NTHR) { const float a = P.in[I_C][i], b = P.in[I_CCTX][i]; sil[i] = a * sigm(a); sil[DM + i] = b * sigm(b); }
        __syncthreads();
        float* MOD = (float*)(ws + WS_MOD);
        for (int u = vcu; u < 4608; u += G) {
            const int l = u / 2304, rem = u - l * 2304, nch = rem >> 4, ks = rem & 15;
            const float* W = P.in[I_WMOD] + (size_t)l * DM * NMODC + (size_t)(ks * 256 + wave * 32) * NMODC + nch * 256 + 4 * lane;
            f32x4 a0 = {0.f, 0.f, 0.f, 0.f}, a1 = {0.f, 0.f, 0.f, 0.f};
#pragma unroll
            for (int hb = 0; hb < 2; ++hb) {
                f32x4 wv[16];
#pragma unroll
                for (int kk = 0; kk < 16; ++kk) wv[kk] = *(const f32x4*)(W + (size_t)(hb * 16 + kk) * NMODC);
#pragma unroll
                for (int kk = 0; kk < 16; ++kk) { const int k = ks * 256 + wave * 32 + hb * 16 + kk; const float s0 = sil[k], s1 = sil[DM + k]; a0 += wv[kk] * s0; a1 += wv[kk] * s1; }
            }
            *(LAS f32x4*)(red + wave * 512 + 4 * lane) = a0; *(LAS f32x4*)(red + wave * 512 + 256 + 4 * lane) = a1;
            __syncthreads();
            { const int w = tid >> 8, col = tid & 255; float s = 0.f;
#pragma unroll
              for (int q = 0; q < 8; ++q) s += red[q * 512 + w * 256 + col];
              if (ks == 0) s += P.in[I_BMOD][l * NMODC + nch * 256 + col];
              atomicAdd(MOD + (size_t)(l * 2 + w) * NMODC + nch * 256 + col, s); }
            __syncthreads();
        }
    }
    {
        LAS float* scr = (LAS float*)(lds + wave * 16640);
        const int gw = vcu * NWAVES + wave, NGW = G * NWAVES;
        constexpr int I_FI = 64 * 256, I_FO = 128 * 64, I_IN = 64 * 128, I_OUT = 64 * 64, I_Q = 16 * 48, I_KV = 8 * 64;
        constexpr int PER_L = 2 * I_FI + 2 * I_FO + I_IN + I_OUT + I_Q + I_KV;
        for (int it = gw; it < 2 * PER_L; it += NGW) {
            const int l = it / PER_L; int r = it - l * PER_L;
            if (r < 2 * I_FI) { const int f = r / I_FI; r -= f * I_FI;
                transpose_item<1>(P.in[I_FWI] + (size_t)(l * 2 + f) * DM * 16384, DM, 16384, (bf16*)(ws + WS_WFI + (size_t)(l * 2 + f) * SZ_WFI), scr, r, lane); continue; } r -= 2 * I_FI;
            if (r < 2 * I_FO) { const int f = r / I_FO; r -= f * I_FO;
                transpose_item<0>(P.in[I_FWO] + (size_t)(l * 2 + f) * DFF * DM, DFF, DM, (bf16*)(ws + WS_WFO + (size_t)(l * 2 + f) * SZ_WFO), scr, r, lane); continue; } r -= 2 * I_FO;
            if (r < I_IN) { transpose_item<0>(P.in[I_WIN] + (size_t)l * DM * ZC, DM, ZC, (bf16*)(ws + WS_WIN + (size_t)l * SZ_WIN), scr, r, lane); continue; } r -= I_IN;
            if (r < I_OUT) { transpose_item<0>(P.in[I_WOUT] + (size_t)l * DM * DM, DM, DM, (bf16*)(ws + WS_WOUT + (size_t)l * SZ_WOUT), scr, r, lane); continue; } r -= I_OUT;
            if (r < I_Q) { transpose_item<0>(P.in[I_QUP] + (size_t)l * 1024 * 3072, 1024, 3072, (bf16*)(ws + WS_WQ + (size_t)l * SZ_WQ), scr, r, lane); continue; } r -= I_Q;
            transpose_item<0>(P.in[I_KVUP] + (size_t)l * 512 * 4096, 512, 4096, (bf16*)(ws + WS_WKV + (size_t)l * SZ_WKV), scr, r, lane);
        }
        const int gt = vcu * NTHR + tid, NGT = G * NTHR;
        for (int it = gt; it < 2 * 10240 * 64; it += NGT) {
            const int l = it / (10240 * 64), r = it - l * (10240 * 64), k8 = r / 10240, n = r - k8 * 10240;
            float v[8];
            if (n < 8192) {
                const bool isA = n >= 4096; const int d = (n >> 11) & 1, ch = n & 2047;
                const float* src = (isA ? P.in[I_AUP] : P.in[I_WUP]) + (size_t)(l * 2 + d) * 96 * RWW + ch;
#pragma unroll
                for (int j = 0; j < 8; ++j) { const int k = 8 * k8 + j - (isA ? 96 : 0); v[j] = (k >= 0 && k < 96) ? src[(size_t)k * RWW] : 0.f; }
            } else {
                const int ch = n - 8192; const float* src = P.in[I_GUP] + (size_t)l * 256 * RWW + ch;
#pragma unroll
                for (int j = 0; j < 8; ++j) { const int k = 8 * k8 + j - 256; v[j] = (k >= 0) ? src[(size_t)k * RWW] : 0.f; }
            }
            v4u o; o.x = pk2(v[0], v[1]); o.y = pk2(v[2], v[3]); o.z = pk2(v[4], v[5]); o.w = pk2(v[6], v[7]);
            *(v4u*)((bf16*)(ws + WS_WWA + (size_t)l * SZ_WWA) + (size_t)n * 512 + 8 * k8) = o;
        }
    }
}

__device__ __forceinline__ void prep_phase(LAS unsigned char* lds, const float* srcL, const float* srcC, int nrows, const float* g, const float* modL, const float* modC, int jm,
                                           bf16* XN, int gw, int NGW, int wave) {
    int lane = lane_vol(); const int tid = wave * 64 + lane;
    LAS float* gsL = (LAS float*)lds; LAS float* shL = gsL + DM; LAS float* gsC = shL + DM; LAS float* shC = gsC + DM;
    for (int i = tid; i < DM; i += NTHR) { const float gg = g[i];
        gsL[i] = gg * (1.f + modL[(jm + 1) * DM + i]); shL[i] = modL[jm * DM + i]; gsC[i] = gg * (1.f + modC[(jm + 1) * DM + i]); shC[i] = modC[jm * DM + i]; }
    __syncthreads();
    for (int row = gw; row < nrows; row += NGW) {
        asm volatile("" : "+v"(lane));
        const bool lat = row < SEQ;
        const f32x4* xr = (const f32x4*)(lat ? srcL + (size_t)row * DM : srcC + (size_t)(row - SEQ) * DM) + lane;
        const LAS float* gs = lat ? gsL : gsC; const LAS float* sh = lat ? shL : shC;
        f32x4 v[16]; float ss = 0.f;
#pragma unroll
        for (int j = 0; j < 16; ++j) { v[j] = xr[64 * j]; ss += dot4(v[j], v[j]); }
        const float rstd = 1.0f / sqrtf(wave_sum(ss) * (1.f / DM) + 1e-6f);
        u32x2* o = (u32x2*)(XN + (size_t)row * DM) + lane;
#pragma unroll
        for (int j = 0; j < 16; ++j) { const int c = 4 * (lane + 64 * j); const f32x4 g4 = *(const LAS f32x4*)(gs + c), s4 = *(const LAS f32x4*)(sh + c);
            o[64 * j] = pk4(v[j] * rstd * g4 + s4); }
    }
    __syncthreads();
}

__device__ __forceinline__ void streams_phase(const Ptrs& P, int l, int gw, int NGW) {
    int lane = lane_vol();
    unsigned char* ws = P.ws;
    const float* Z = (const float*)(ws + WS_Z); float* SS = (float*)(ws + WS_SS); float* VV = (float*)(ws + WS_VV); float* KT = (float*)(ws + WS_KT);
    bf16* LWA = (bf16*)(ws + WS_LWA); bf16* QL = (bf16*)(ws + WS_QL); bf16* KVL = (bf16*)(ws + WS_KVL);
    const float* mu = P.in[I_MU] + l * RWCOLS; const float* k_k = P.in[I_KK] + l * RWW; const float* qn = P.in[I_QNORM] + l * 1024; const float* kvn = P.in[I_KVNORM] + l * 512;
    for (int row = gw; row < MROWS; row += NGW) {
        asm volatile("" : "+v"(lane));
        int nb0, nb1, nb2, nb3; bool ok0, ok1, ok2, ok3;
        if (row < SEQ) { const int gr = row >> 6, gc = row & 63; nb0 = row - 1; ok0 = gc > 0; nb1 = row + 1; ok1 = gc < 63; nb2 = row - 64; ok2 = gr > 0; nb3 = row + 64; ok3 = gr < 127; }
        else { const int s = row - SEQ; nb0 = nb1 = row - 1; ok0 = ok1 = s > 0; nb2 = nb3 = row + 1; ok2 = ok3 = s < CTXL - 1; }
        const float* zr = Z + (size_t)row * ZC;
#pragma unroll
        for (int i = 0; i < 26; ++i) {
            const int c4 = lane + 64 * i, c = 4 * c4;
            if (i < 25 || lane < 48) {
                const int q = (c4 >= 412) + (c4 >= 824) + (c4 >= 1236);
                const int nrow = q == 0 ? nb0 : q == 1 ? nb1 : q == 2 ? nb2 : nb3; const bool nok = q == 0 ? ok0 : q == 1 ? ok1 : q == 2 ? ok2 : ok3;
                const f32x4 z = *(const f32x4*)(zr + c); f32x4 zn = {0.f, 0.f, 0.f, 0.f};
                if (nok) zn = *(const f32x4*)(Z + (size_t)nrow * ZC + c);
                const f32x4 zs = z + (zn - z) * *(const f32x4*)(mu + c);
                if (i < 8) { const int h = c >> 6, e = c & 63; *(f32x4*)(SS + ((size_t)(row * 32 + h) * 2) * 64 + e) = zs; }
                else if (i < 16) { const int ch = c - 2048, h = ch >> 6, e = ch & 63; *(f32x4*)(KT + (size_t)row * RWW + ch) = zs;
                    const f32x4 kr = zs * *(const f32x4*)(k_k + ch); const float ss = sum16(dot4(kr, kr)); const float inv = 1.f / fmaxf(sqrtf(ss), 1e-12f);
                    *(f32x4*)(SS + ((size_t)(row * 32 + h) * 2 + 1) * 64 + e) = kr * inv; }
                else if (i < 24) { *(f32x4*)(VV + (size_t)row * RWW + (c - 4096)) = zs; }
                else if (i == 24) {
                    if (lane < 24) { f32x4 t;
#pragma unroll
                        for (int j = 0; j < 4; ++j) t[j] = 1.f - 2.f * __builtin_amdgcn_rcpf(1.f + __builtin_amdgcn_exp2f(2.885390081777927f * zs[j]));
                        *(u32x2*)(LWA + (size_t)row * 512 + 4 * lane) = pk4(t); }
                    else if (lane < 48) { *(u32x2*)(LWA + (size_t)row * 512 + 96 + 4 * (lane - 24)) = pk4(zs); }
                    else { f32x4 t;
#pragma unroll
                        for (int j = 0; j < 4; ++j) t[j] = sigm(zs[j]);
                        *(u32x2*)(LWA + (size_t)row * 512 + 256 + 4 * (lane - 48)) = pk4(t); }
                } else { f32x4 t;
#pragma unroll
                    for (int j = 0; j < 4; ++j) t[j] = sigm(zs[j]);
                    *(u32x2*)(LWA + (size_t)row * 512 + 256 + 64 + 4 * lane) = pk4(t); }
            }
        }
        if (lane < 16) { unsigned z0 = 0u; asm volatile("" : "+v"(z0)); u32x2 zz; zz.x = z0; zz.y = z0; *(u32x2*)(LWA + (size_t)row * 512 + 192 + 4 * lane) = zz; }
        { f32x4 v[4]; float ss = 0.f;
#pragma unroll
          for (int j = 0; j < 4; ++j) { v[j] = *(const f32x4*)(zr + RWCOLS + 4 * (lane + 64 * j)); ss += dot4(v[j], v[j]); }
          const float rstd = 1.0f / sqrtf(wave_sum(ss) * (1.f / 1024.f) + 1e-6f);
#pragma unroll
          for (int j = 0; j < 4; ++j) { const int c = 4 * (lane + 64 * j); *(u32x2*)(QL + (size_t)row * 1024 + c) = pk4(v[j] * rstd * *(const f32x4*)(qn + c)); } }
        { f32x4 v[2]; float ss = 0.f;
#pragma unroll
          for (int j = 0; j < 2; ++j) { v[j] = *(const f32x4*)(zr + RWCOLS + 1024 + 4 * (lane + 64 * j)); ss += dot4(v[j], v[j]); }
          const float rstd = 1.0f / sqrtf(wave_sum(ss) * (1.f / 512.f) + 1e-6f);
#pragma unroll
          for (int j = 0; j < 2; ++j) { const int c = 4 * (lane + 64 * j); *(u32x2*)(KVL + (size_t)row * 512 + c) = pk4(v[j] * rstd * *(const f32x4*)(kvn + c)); } }
    }
}

#ifndef QKN_ST
#define QKN_ST 1
#endif
#ifndef QKN_VST
#define QKN_VST 1
#endif
__device__ __forceinline__ void qknorm_phase(const Ptrs& P, int l, int gw, int NGW) {
    const int lane = lane_vol();
    unsigned char* ws = P.ws;
    const float* Z = (const float*)(ws + WS_Z); const float* QF = (const float*)(ws + WS_QF); const float* KVF = (const float*)(ws + WS_KVF);
    bf16* QB = (bf16*)(ws + WS_QB); bf16* KB = (bf16*)(ws + WS_KB); bf16* VB = (bf16*)(ws + WS_VB);
    const float* qg = P.in[I_QGAIN] + l * 192; const float* kg = P.in[I_KGAIN] + l * 192;
    const int lc = lane < 48 ? lane : 47;
    const f32x4 qg4 = *(const f32x4*)(qg + 4 * lc), kg4 = *(const f32x4*)(kg + 4 * lc);
    const int rl = lane - 32, ax = (rl >> 3) & 1, hf = (rl >> 2) & 1, f0 = 4 * (lane & 3);
    const bool rot = lane >= 32 && lane < 48;
    for (int it = gw; it < MROWS * 4; it += NGW) {
        const int row = it >> 2, h0 = (it & 3) * 4; const bool lat = row < SEQ;
        f32x4 cs = {1.f, 1.f, 1.f, 1.f}, sn = {0.f, 0.f, 0.f, 0.f};
        if (lat && rot) { const float pos = (float)(ax == 0 ? (row >> 6) : (row & 63));
#pragma unroll
            for (int j = 0; j < 4; ++j) { const float inv = exp2f(-(float)(f0 + j) * (13.287712379549449f / 16.f)); const float ang = pos * inv; cs[j] = cosf(ang); sn[j] = sinf(ang); } }
        f32x4 kr4 = {0.f, 0.f, 0.f, 0.f};
        if (rot) kr4 = *(const f32x4*)(Z + (size_t)row * ZC + 8128 + 4 * rl);
        const float ssr = wave_sum(rot ? dot4(kr4, kr4) : 0.f);
#pragma unroll
        for (int hh = 0; hh < 4; ++hh) {
            const int h = h0 + hh;
            f32x4 q4 = {0.f, 0.f, 0.f, 0.f};
            if (lane < 48) q4 = *(const f32x4*)(QF + (size_t)row * 3072 + h * 192 + 4 * lane);
            { const float ss = wave_sum(dot4(q4, q4)); const float rstd = 1.0f / sqrtf(ss * (1.f / 192.f) + 1e-6f);
              f32x4 x = q4 * rstd * qg4; f32x4 o;
#pragma unroll
              for (int j = 0; j < 4; ++j) o[j] = __shfl_xor(x[j], 4);
              if (lat && rot) { if (hf == 0) x = x * cs - o * sn; else x = o * sn + x * cs; }
              if (QKN_ST && lane < 48) *(u32x2*)(QB + (size_t)row * 3072 + h * 192 + 4 * lane) = pk4(x); }
            f32x4 k4 = kr4;
            if (lane < 32) k4 = *(const f32x4*)(KVF + (size_t)row * 4096 + h * 256 + 4 * lane);
            { const float ss = wave_sum(lane < 32 ? dot4(k4, k4) : 0.f) + ssr; const float rstd = 1.0f / sqrtf(ss * (1.f / 192.f) + 1e-6f);
              f32x4 x = k4 * rstd * kg4; f32x4 o;
#pragma unroll
              for (int j = 0; j < 4; ++j) o[j] = __shfl_xor(x[j], 4);
              if (lat && rot) { if (hf == 0) x = x * cs - o * sn; else x = o * sn + x * cs; }
              if (QKN_ST && lane < 48) *(u32x2*)(KB + (size_t)row * 3072 + h * 192 + 4 * lane) = pk4(x); }
            if (QKN_VST && lane < 32) { const f32x4 v4 = *(const f32x4*)(KVF + (size_t)row * 4096 + h * 256 + 128 + 4 * lane); *(u32x2*)(VB + (size_t)row * 2048 + h * 128 + 4 * lane) = pk4(v4); }
        }
    }
}

__device__ __forceinline__ void rwkvout_phase(const Ptrs& P, int l, int nrows, int gw, int NGW) {
    int lane = lane_vol();
    unsigned char* ws = P.ws;
    const float* Y = (const float*)(ws + WS_Y); const float* SS = (const float*)(ws + WS_SS); const float* SD = (const float*)(ws + WS_SD); const float* VV = (const float*)(ws + WS_VV);
    const float* Gg = (const float*)(ws + WS_G); bf16* OC = (bf16*)(ws + WS_OC);
    const float* lnw = P.in[I_LNW] + l * RWW; const float* lnb = P.in[I_LNB] + l * RWW; const float* rk = P.in[I_RK] + l * RWW;
    for (int row = gw; row < nrows; row += NGW) {
        asm volatile("" : "+v"(lane));
#pragma unroll
        for (int i = 0; i < 8; ++i) {
            const int c = 4 * (lane + 64 * i), h = c >> 6, e = c & 63;
            const f32x4 y = *(const f32x4*)(Y + (size_t)row * RWW + c) + *(const f32x4*)(Y + (size_t)(MROWS + row) * RWW + c);
            const float mean = sum16((y.x + y.y) + (y.z + y.w)) * (1.f / 64.f);
            const f32x4 dlt = y - mean; const float var = sum16(dot4(dlt, dlt)) * (1.f / 64.f);
            const float rstd = 1.0f / sqrtf(var + 64e-5f);
            f32x4 o = dlt * rstd * *(const f32x4*)(lnw + c) + *(const f32x4*)(lnb + c);
            const f32x4 r4 = *(const f32x4*)(SS + ((size_t)(row * 32 + h) * 2) * 64 + e);
            const f32x4 kd0 = *(const f32x4*)(SD + ((size_t)row * 32 + h) * 192 + 64 + e), kd1 = *(const f32x4*)(SD + ((size_t)(MROWS + row) * 32 + h) * 192 + 64 + e);
            const float bs = sum16(dot4(r4 * (kd0 + kd1) * 0.5f, *(const f32x4*)(rk + c)));
            o = (o + *(const f32x4*)(VV + (size_t)row * RWW + c) * bs) * *(const f32x4*)(Gg + (size_t)row * RWW + c);
            *(u32x2*)(OC + (size_t)row * DM + c) = pk4(o);
        }
    }
}

template <int CTRL> __device__ __forceinline__ float dpp_add(float x) { return x + __int_as_float(__builtin_amdgcn_update_dpp(0, __float_as_int(x), CTRL, 0xf, 0xf, true)); }
__device__ __forceinline__ float red16(float x) { x = dpp_add<0xB1>(x); x = dpp_add<0x4E>(x); x = dpp_add<0x141>(x); x = dpp_add<0x140>(x); return x; }
constexpr int SCAN_TC = 32, SCAN_STEP_B = 1408, SCAN_BUF = SCAN_TC * SCAN_STEP_B;
__device__ __forceinline__ void scan_phase(const Ptrs& P, LAS unsigned char* lds, int vcu, int wave) {
    const int lane = lane_vol(), tid = wave * 64 + lane;
    if (vcu >= 128) return;
    const int h = vcu >> 2, d = (vcu >> 1) & 1, half = vcu & 1;
    unsigned char* ws = P.ws;
    const float* SD = (const float*)(ws + WS_SD); const float* SS = (const float*)(ws + WS_SS); const float* VV = (const float*)(ws + WS_VV); float* Y = (float*)(ws + WS_Y);
    LAS float* ybuf = (LAS float*)(lds + 2 * SCAN_BUF);
    const int kq = lane & 15, rl = wave * 4 + (lane >> 4);
    f32x4 st[6];
#define rowof(tau) (d == 0 ? ((tau) < CTXL ? SEQ + (tau) : (tau) - CTXL) : (MROWS - 1 - (tau)))
#define SCAN_LOAD(ci) do { _Pragma("unroll") for (int q_ = 0; q_ < 6; ++q_) { const int id = tid + q_ * NTHR; if (id < SCAN_TC * 88) { const int s_ = id / 88, p_ = id - s_ * 88; \
        const int row_ = rowof((ci) * SCAN_TC + s_); const float* src_; \
        if (p_ < 48) src_ = SD + ((size_t)(d * MROWS + row_) * 32 + h) * 192 + 4 * p_; else if (p_ < 80) src_ = SS + ((size_t)(row_ * 32 + h) * 2) * 64 + 4 * (p_ - 48); \
        else src_ = VV + (size_t)row_ * RWW + h * 64 + 32 * half + 4 * (p_ - 80); st[q_] = *(const f32x4*)src_; } } } while (0)
#define SCAN_STORE(b) do { _Pragma("unroll") for (int q_ = 0; q_ < 6; ++q_) { const int id = tid + q_ * NTHR; if (id < SCAN_TC * 88) { const int s_ = id / 88, p_ = id - s_ * 88; \
        *(LAS f32x4*)(lds + (b) * SCAN_BUF + s_ * SCAN_STEP_B + p_ * 16) = st[q_]; } } } while (0)
    float S0 = 0.f, S1 = 0.f, S2 = 0.f, S3 = 0.f;
    SCAN_LOAD(0); SCAN_STORE(0); __syncthreads();
    constexpr int NCH = MROWS / SCAN_TC;
    for (int ci = 0; ci < NCH; ++ci) {
        if (ci + 1 < NCH) SCAN_LOAD(ci + 1);
        const LAS unsigned char* buf = lds + (ci & 1) * SCAN_BUF + kq * 16;
#pragma unroll 4
        for (int s = 0; s < SCAN_TC; ++s) {
            const LAS unsigned char* sb = buf + s * SCAN_STEP_B;
            const f32x4 w4 = *(const LAS f32x4*)(sb), kd4 = *(const LAS f32x4*)(sb + 256), ka4 = *(const LAS f32x4*)(sb + 512), r4 = *(const LAS f32x4*)(sb + 768), kk4 = *(const LAS f32x4*)(sb + 1024);
            const float vv = *(const LAS float*)(lds + (ci & 1) * SCAN_BUF + s * SCAN_STEP_B + 1280 + rl * 4);
            const float sk = red16((S0 * kk4.x + S1 * kk4.y) + (S2 * kk4.z + S3 * kk4.w));
            S0 = S0 * w4.x + (vv * kd4.x - sk * ka4.x); S1 = S1 * w4.y + (vv * kd4.y - sk * ka4.y); S2 = S2 * w4.z + (vv * kd4.z - sk * ka4.z); S3 = S3 * w4.w + (vv * kd4.w - sk * ka4.w);
            const float yv = red16((S0 * r4.x + S1 * r4.y) + (S2 * r4.z + S3 * r4.w));
            if (kq == 0) ybuf[s * 32 + rl] = yv;
        }
        __syncthreads();
        if (ci + 1 < NCH) SCAN_STORE((ci + 1) & 1);
        { const int s = tid >> 4, j = tid & 15; const int row = rowof(ci * SCAN_TC + s);
          typedef float f32x2v __attribute__((ext_vector_type(2)));
          *(f32x2v*)(Y + (size_t)(d * MROWS + row) * RWW + h * 64 + 32 * half + 2 * j) = *(const LAS f32x2v*)(ybuf + s * 32 + 2 * j); }
        __syncthreads();
    }
#undef SCAN_LOAD
#undef SCAN_STORE
#undef rowof
}

namespace att {
constexpr int NW = 8, QBLK = 32, KVBLK = 64;
constexpr float SCALE = 0.07216878364870322f;
constexpr float THR = 8.f;
constexpr int LDQ = 3072, LDKK = 3072, LDVV = 2048, LDO = 4096;
constexpr int SHM_V = KVBLK * 128 * 2, SHM_K = KVBLK * 400, SHM_QP = 256 * 208, SHM_ATTN = 2 * SHM_V + 2 * SHM_K + NW * 64 * 4 + SHM_QP;
using bf16x8 = __attribute__((ext_vector_type(8))) short;
using s16x4  = __attribute__((ext_vector_type(4))) short;
using f32x16 = __attribute__((ext_vector_type(16))) float;
using u32x4  = __attribute__((ext_vector_type(4))) unsigned;
#define KSWZ(row, colB) ((row) * 400 + (colB))
#define SBAR() __builtin_amdgcn_sched_barrier(0)
__device__ __forceinline__ int crow(int r, int hi) { return (r & 3) + 8 * (r >> 2) + 4 * hi; }
__device__ __forceinline__ unsigned cvtpk(float lo, float hi) { unsigned r; asm volatile("v_cvt_pk_bf16_f32 %0, %1, %2" : "=v"(r) : "v"(lo), "v"(hi)); return r; }
__device__ __forceinline__ void partialSM(f32x16& p0, f32x16& p1, float& m_reg, float& mn, float& alpha) {
  constexpr float C = SCALE * 1.4426950408889634f;
  float pmax = p0[0];
#pragma unroll
  for (int r = 1; r < 16; ++r) pmax = fmaxf(pmax, p0[r]);
#pragma unroll
  for (int r = 0; r < 16; ++r) pmax = fmaxf(pmax, p1[r]);
  { auto rr = __builtin_amdgcn_permlane32_swap(__float_as_uint(pmax), __float_as_uint(pmax), false, false);
    pmax = fmaxf(__uint_as_float(rr[0]), __uint_as_float(rr[1])); }
  if (__builtin_expect(__all(pmax - m_reg <= THR / SCALE), 1)) { mn = m_reg; alpha = 1.f; }
  else { mn = fmaxf(m_reg, pmax); alpha = __builtin_amdgcn_exp2f((m_reg - mn) * C); m_reg = mn; }
  float mnC = -mn * C;
#pragma unroll
  for (int r = 0; r < 16; ++r) p0[r] = fmaf(p0[r], C, mnC);
#pragma unroll
  for (int r = 0; r < 16; ++r) p1[r] = fmaf(p1[r], C, mnC);
#pragma unroll
  for (int r = 0; r < 16; ++r) p0[r] = __builtin_amdgcn_exp2f(p0[r]);
}
__device__ __forceinline__ void finishSM(f32x16& p0, f32x16& p1, float alpha, float& l_reg, bf16x8& pa0, bf16x8& pa1, bf16x8& pa2, bf16x8& pa3) {
#pragma unroll
  for (int r = 0; r < 16; ++r) p1[r] = __builtin_amdgcn_exp2f(p1[r]);
  float ps = 0;
#pragma unroll
  for (int r = 0; r < 16; ++r) ps += p0[r];
#pragma unroll
  for (int r = 0; r < 16; ++r) ps += p1[r];
  { auto rr = __builtin_amdgcn_permlane32_swap(__float_as_uint(ps), __float_as_uint(ps), false, false);
    ps = __uint_as_float(rr[0]) + __uint_as_float(rr[1]); }
  l_reg = l_reg * alpha + ps;
#define PK4(P, BASE, OUT) do { unsigned a0 = cvtpk(P[BASE + 0], P[BASE + 1]), a1 = cvtpk(P[BASE + 2], P[BASE + 3]);   \
    unsigned b0 = cvtpk(P[BASE + 4], P[BASE + 5]), b1 = cvtpk(P[BASE + 6], P[BASE + 7]);                              \
    auto r0 = __builtin_amdgcn_permlane32_swap(a0, b0, false, false); auto r1 = __builtin_amdgcn_permlane32_swap(a1, b1, false, false); \
    u32x4 w = {r0[0], r1[0], r0[1], r1[1]}; OUT = *reinterpret_cast<bf16x8*>(&w); } while (0)
  PK4(p0, 0, pa0); PK4(p0, 8, pa1); PK4(p1, 0, pa2); PK4(p1, 8, pa3);
#undef PK4
}
__device__ __forceinline__ void qkt(f32x16& p0, f32x16& p1, const char* Ks, const bf16x8* qr, const char* qpark, int r32, int hi) {
  p0 = f32x16{}; p1 = f32x16{};
#pragma unroll
  for (int d0 = 0; d0 < 12; ++d0) { int cb = (d0 * 16 + hi * 8) * 2;
    bf16x8 b0 = *reinterpret_cast<const bf16x8*>(Ks + KSWZ(r32, cb));
    bf16x8 b1 = *reinterpret_cast<const bf16x8*>(Ks + KSWZ(32 + r32, cb));
    const bf16x8 q = d0 < 6 ? qr[d0 < 6 ? d0 : 0] : *reinterpret_cast<const bf16x8*>(qpark + (d0 - 6) * 32);
    p0 = __builtin_amdgcn_mfma_f32_32x32x16_bf16(b0, q, p0, 0, 0, 0);
    p1 = __builtin_amdgcn_mfma_f32_32x32x16_bf16(b1, q, p1, 0, 0, 0); }
}
__device__ __forceinline__ int v_st(int k, int c) { const int kk = (k & ~0xC) | ((k & 4) << 1) | ((k & 8) >> 1); return ((kk >> 3) * 4 + (c >> 5)) * 512 + ((kk & 7) * 32 + (c & 31)) * 2; }
__device__ __forceinline__ int v_rd_base(int lane) { return ((lane & 3) << 3) | (((lane >> 2) & 3) << 6) | (((lane >> 4) & 1) << 5) | (((lane >> 5) & 1) << 8); }
constexpr int v_rd_off(int d0, int ks, int half) { return d0 * 512 + ks * 4096 + half * 2048; }
template <int OFF> __device__ __forceinline__ s16x4 tr_read(int vb) {
  s16x4 r; asm volatile("ds_read_b64_tr_b16 %0, %1 offset:%2" : "=&v"(r) : "v"(vb), "i"(OFF) : "memory"); return r;
}
template <int D0> __device__ __forceinline__ void pv_one(f32x16& od, int vb, bf16x8 pa0, bf16x8 pa1, bf16x8 pa2, bf16x8 pa3) {
  const s16x4 l0 = tr_read<v_rd_off(D0, 0, 0)>(vb), h0 = tr_read<v_rd_off(D0, 0, 1)>(vb), l1 = tr_read<v_rd_off(D0, 1, 0)>(vb), h1 = tr_read<v_rd_off(D0, 1, 1)>(vb);
  const s16x4 l2 = tr_read<v_rd_off(D0, 2, 0)>(vb), h2 = tr_read<v_rd_off(D0, 2, 1)>(vb), l3 = tr_read<v_rd_off(D0, 3, 0)>(vb), h3 = tr_read<v_rd_off(D0, 3, 1)>(vb);
  asm volatile("s_waitcnt lgkmcnt(0)" ::: "memory"); SBAR();
#define PK(L, H) (bf16x8){L[0], L[1], L[2], L[3], H[0], H[1], H[2], H[3]}
  od = __builtin_amdgcn_mfma_f32_32x32x16_bf16(pa0, PK(l0, h0), od, 0, 0, 0);
  od = __builtin_amdgcn_mfma_f32_32x32x16_bf16(pa1, PK(l1, h1), od, 0, 0, 0);
  od = __builtin_amdgcn_mfma_f32_32x32x16_bf16(pa2, PK(l2, h2), od, 0, 0, 0);
  od = __builtin_amdgcn_mfma_f32_32x32x16_bf16(pa3, PK(l3, h3), od, 0, 0, 0);
#undef PK
}
__device__ __forceinline__ void pv_d0(f32x16* o, int vb, bf16x8 pa0, bf16x8 pa1, bf16x8 pa2, bf16x8 pa3) {
  pv_one<0>(o[0], vb, pa0, pa1, pa2, pa3); pv_one<1>(o[1], vb, pa0, pa1, pa2, pa3); pv_one<2>(o[2], vb, pa0, pa1, pa2, pa3); pv_one<3>(o[3], vb, pa0, pa1, pa2, pa3);
}
__device__ __forceinline__ void attn_body(const unsigned short* __restrict__ Qb, const unsigned short* __restrict__ Kh, const unsigned short* __restrict__ Vh,
                                          unsigned short* __restrict__ Ob, int seq, char* lds, int wave_in) {
  int tid_o; asm volatile("v_mbcnt_lo_u32_b32 %0, -1, 0\n\tv_mbcnt_hi_u32_b32 %0, -1, %0" : "=v"(tid_o)); tid_o += wave_in * 64;
  const int tid = tid_o, wid = wave_in, lane = tid & 63, r32 = lane & 31, hi = lane >> 5;
  char* V_lds = lds; char* K_lds = lds + 2 * SHM_V;
  float* wsx = (float*)(lds + 2 * SHM_V + 2 * SHM_K) + wid * 64; float* li_l = wsx; float* al_l = wsx + 32;
  float m_reg = -1e30f, l_reg = 0; f32x16 o[4] = {}; bf16x8 qr[6];
  char* qpark = lds + 2 * SHM_V + 2 * SHM_K + NW * 64 * 4 + (wid * QBLK + r32) * 208 + hi * 16;
  const unsigned short* Qw = Qb + (long)(wid * QBLK + r32) * LDQ + hi * 8;
#pragma unroll
  for (int d0 = 0; d0 < 6; ++d0) qr[d0] = *reinterpret_cast<const bf16x8*>(Qw + d0 * 16);
#pragma unroll
  for (int d0 = 6; d0 < 12; ++d0) *reinterpret_cast<bf16x8*>(qpark + (d0 - 6) * 32) = *reinterpret_cast<const bf16x8*>(Qw + d0 * 16);
  const int sr = tid >> 4, sc = (tid & 15) * 8, vst0 = v_st(sr, sc), vst1 = v_st(32 + sr, sc);
  const int kr0 = tid / 24, kc0 = (tid % 24) * 8, kr1 = (tid + 512) / 24, kc1 = ((tid + 512) % 24) * 8, kr2 = (tid + 1024) / 24, kc2 = ((tid + 1024) % 24) * 8;
  const int vb0 = (int)(uintptr_t)V_lds + v_rd_base(lane);
  const unsigned ko0 = (unsigned)(kr0 * LDKK + kc0) * 2u, ko1 = (unsigned)(kr1 * LDKK + kc1) * 2u, ko2 = (unsigned)(kr2 * LDKK + kc2) * 2u;
  const unsigned vo0 = (unsigned)(sr * LDVV + sc) * 2u, vo1 = (unsigned)((32 + sr) * LDVV + sc) * 2u;
  const int kl0 = KSWZ(kr0, kc0 * 2), kl1 = KSWZ(kr1, kc1 * 2), kl2 = KSWZ(kr2, kc2 * 2);
  bf16x8 vs0, vs1, ks0, ks1, ks2;
#define SLOAD(k0) do { const char* kb_ = (const char*)Kh + (size_t)(k0) * (LDKK * 2); const char* vb_ = (const char*)Vh + (size_t)(k0) * (LDVV * 2); \
    vs0 = *reinterpret_cast<const bf16x8*>(vb_ + vo0); vs1 = *reinterpret_cast<const bf16x8*>(vb_ + vo1); \
    ks0 = *reinterpret_cast<const bf16x8*>(kb_ + ko0); ks1 = *reinterpret_cast<const bf16x8*>(kb_ + ko1); ks2 = *reinterpret_cast<const bf16x8*>(kb_ + ko2); } while (0)
#define SWRITE(b) do { *(bf16x8*)(V_lds + (b) * SHM_V + vst0) = vs0; *(bf16x8*)(V_lds + (b) * SHM_V + vst1) = vs1; \
    *(bf16x8*)(K_lds + (b) * SHM_K + kl0) = ks0; *(bf16x8*)(K_lds + (b) * SHM_K + kl1) = ks1; *(bf16x8*)(K_lds + (b) * SHM_K + kl2) = ks2; } while (0)
#define SWAIT() asm volatile("s_waitcnt vmcnt(0)" ::: "memory")
#define RESC(a) do { if (__any((a) < 1.f)) { if (hi == 0) al_l[r32] = (a); asm volatile("s_waitcnt lgkmcnt(0)" ::: "memory"); \
    _Pragma("unroll") for (int d = 0; d < 4; ++d) _Pragma("unroll") for (int r = 0; r < 16; ++r) o[d][r] *= al_l[crow(r, hi)]; } } while (0)
  f32x16 pA0, pA1, pB0, pB1; float mnA, mnB, alA, alB; bf16x8 pa0, pa1, pa2, pa3; const int NT = seq / KVBLK;
  __syncthreads();
  SLOAD(0); SWAIT(); SWRITE(0); __syncthreads();
  qkt(pA0, pA1, K_lds, qr, qpark, r32, hi); partialSM(pA0, pA1, m_reg, mnA, alA);
  SLOAD(KVBLK);
  SWAIT(); SWRITE(1); __syncthreads();
  for (int j = 1; j + 1 < NT; j += 2) {
    SBAR(); qkt(pB0, pB1, K_lds + SHM_K, qr, qpark, r32, hi);
    finishSM(pA0, pA1, alA, l_reg, pa0, pa1, pa2, pa3); SBAR();
    SLOAD((j + 1) * KVBLK); SBAR();
    pv_d0(o, vb0, pa0, pa1, pa2, pa3); partialSM(pB0, pB1, m_reg, mnB, alB);
    __syncthreads(); SWAIT(); SWRITE(0);
    RESC(alB); __syncthreads();
    SBAR(); qkt(pA0, pA1, K_lds, qr, qpark, r32, hi);
    finishSM(pB0, pB1, alB, l_reg, pa0, pa1, pa2, pa3); SBAR();
    SLOAD((j + 2) * KVBLK); SBAR();
    pv_d0(o, vb0 + SHM_V, pa0, pa1, pa2, pa3); partialSM(pA0, pA1, m_reg, mnA, alA);
    __syncthreads(); SWAIT(); SWRITE(1);
    RESC(alA); __syncthreads();
  }
  SBAR(); qkt(pB0, pB1, K_lds + SHM_K, qr, qpark, r32, hi);
  finishSM(pA0, pA1, alA, l_reg, pa0, pa1, pa2, pa3); SBAR();
  pv_d0(o, vb0, pa0, pa1, pa2, pa3); partialSM(pB0, pB1, m_reg, mnB, alB);
  __syncthreads(); RESC(alB);
  finishSM(pB0, pB1, alB, l_reg, pa0, pa1, pa2, pa3); SBAR();
  pv_d0(o, vb0 + SHM_V, pa0, pa1, pa2, pa3);
  if (hi == 0) li_l[r32] = l_reg; asm volatile("s_waitcnt lgkmcnt(0)" ::: "memory");
  float rli[16];
#pragma unroll
  for (int r = 0; r < 16; ++r) rli[r] = __builtin_amdgcn_rcpf(li_l[crow(r, hi)]);
  unsigned short* Ow = Ob + (long)(wid * QBLK) * LDO;
#pragma unroll
  for (int r = 0; r < 16; ++r) { int orow = crow(r, hi);
#pragma unroll
    for (int d0 = 0; d0 < 4; ++d0) Ow[(long)orow * LDO + d0 * 32 + r32] = (unsigned short)f2bf(o[d0][r] * rli[r]); }
#undef SLOAD
#undef SWRITE
#undef SWAIT
#undef RESC
}
#undef KSWZ
#undef SBAR
}

#ifndef DBG_STOP
#define DBG_STOP 1000
#endif
constexpr int PH_PER_LAYER = 15, NPHASE = 1 + 2 * PH_PER_LAYER, PH_COPY = NPHASE;
struct Args { const float* in[N_IN]; float* out; unsigned char* ws; int ph_lo, ph_hi; };

template <class Epi> __device__ __forceinline__ void run_gemm(LAS unsigned char* lds, const bf16* A, const bf16* Bt, int M, int N, int K, int G, const Epi& E, int wave) {
    asm volatile("" : "+s"(K));
    pg8::Gemm g{A, Bt, M, N, K}; pg8::StaticOrder S; S.init(M, N, G, (int)blockIdx.x);
    pg8::gemm_phase<Epi, pg8::StaticOrder, true, true>(lds, g, S, E, wave);
}
#define WSP(T, off) ((T*)(ws + (off)))

template <int PHSEL> __global__ void __launch_bounds__(NTHR, 2) fwd_kernel(Args args) {
    extern __shared__ __attribute__((aligned(16))) unsigned char lds_raw[];
    LAS unsigned char* lds = (LAS unsigned char*)lds_raw;
    const int wave = __builtin_amdgcn_readfirstlane((int)(threadIdx.x >> 6));
    const int G = gridDim.x; const int bx = blockIdx.x; const int vcu = (G % 8 == 0) ? (bx % 8) * (G / 8) + bx / 8 : bx;
    const int gw = vcu * NWAVES + wave, NGW = G * NWAVES;
    const int lo = args.ph_lo, hi = args.ph_hi;
    volatile LAS unsigned* MISC = (volatile LAS unsigned*)(lds + MISC_OFF);
    if (threadIdx.x < 64) MISC[threadIdx.x] = 0u;
    if (threadIdx.x == 0) {
        LAS unsigned long long* PT = (LAS unsigned long long*)(lds + PT_OFF);
#pragma unroll
        for (int i = 0; i < N_IN; ++i) PT[i] = (unsigned long long)args.in[i];
        PT[N_IN] = (unsigned long long)args.out; PT[N_IN + 1] = (unsigned long long)args.ws;
    }
    __syncthreads();
    XcdBarrier bar; bar.bar = (unsigned*)(args.ws + WS_CTL) + CW_BAR; bar.x = 0; bar.st = nullptr;
    if (hi - lo > 1) bar = xcd_barrier_post((unsigned*)(args.ws + WS_CTL) + CW_BAR, MISC + 8);
    bar.wave = wave;
#ifndef PH_MASK
#define PH_MASK 0xFFFFF
#endif
#define EN(j) ((((PH_MASK) >> (j)) & 1) && (PHSEL < 0 || PHSEL == ((j) >= 16 ? 7 : (j))))
#define IN(k) (lo <= (k) && (k) < hi && (k) <= DBG_STOP)
#define SEAM(k) do { if (lo <= (k) && (k) + 1 < hi) { asm volatile("" ::: "memory"); XcdBarrier bb_ = bar; bb_.bar = (unsigned*)((GAS unsigned char*)ld_uptr(lds, N_IN + 1) + WS_CTL) + CW_BAR; xcd_barrier(bb_); } } while (0)
#define PHASE_PTRS() const Ptrs P = load_ptrs(lds); unsigned char* ws = P.ws; const float* MOD = WSP(const float, WS_MOD); \
        const float* modL = MOD + (size_t)(l * 2 + 0) * NMODC; const float* modC = MOD + (size_t)(l * 2 + 1) * NMODC; float* X = WSP(float, WS_X); float* XC = X + (size_t)SEQ * DM; \
        (void)modL; (void)modC; (void)X; (void)XC

    if (EN(0) && IN(0)) prologue_phase(lds, vcu, G, wave);
    SEAM(0);

    for (int l = 0; l < 2; ++l) {
        const int pb = 1 + PH_PER_LAYER * l;
        const bool last = (l == 1);
        const int nrows2 = last ? SEQ : MROWS;
        if (EN(1) && IN(pb + 0)) { PHASE_PTRS(); const float* x0L = (l == 0) ? P.in[I_X] : X; const float* x0C = (l == 0) ? P.in[I_CTX] : XC;
            prep_phase(lds, x0L, x0C, MROWS, P.in[I_NORMG] + (size_t)(l * 3 + 0) * DM, modL, modC, 0, WSP(bf16, WS_XN), gw, NGW, wave); }
        SEAM(pb + 0);
        if (EN(2) && IN(pb + 1)) { PHASE_PTRS(); EpiSwiGLU E{WSP(bf16, WS_H)}; run_gemm(lds, WSP(const bf16, WS_XN), WSP(const bf16, WS_WFI + (size_t)(l * 2 + 0) * SZ_WFI), MROWS, 16384, DM, G, E, wave); }
        SEAM(pb + 1);
        if (EN(3) && IN(pb + 2)) { PHASE_PTRS(); const float* x0L = (l == 0) ? P.in[I_X] : X; const float* x0C = (l == 0) ? P.in[I_CTX] : XC;
            EpiRes E{x0L, x0C, X, XC, modL + 2 * DM, modC + 2 * DM, 0.5f}; run_gemm(lds, WSP(const bf16, WS_H), WSP(const bf16, WS_WFO + (size_t)(l * 2 + 0) * SZ_WFO), MROWS, DM, DFF, G, E, wave); }
        SEAM(pb + 2);
        if (EN(4) && IN(pb + 3)) { PHASE_PTRS(); prep_phase(lds, X, XC, MROWS, P.in[I_NORMG] + (size_t)(l * 3 + 1) * DM, modL, modC, 3, WSP(bf16, WS_XN), gw, NGW, wave); }
        SEAM(pb + 3);
        if (EN(5) && IN(pb + 4)) { PHASE_PTRS(); EpiF32 E{WSP(float, WS_Z), ZC}; run_gemm(lds, WSP(const bf16, WS_XN), WSP(const bf16, WS_WIN + (size_t)l * SZ_WIN), MROWS, ZC, DM, G, E, wave); }
        SEAM(pb + 4);
        if (EN(6) && IN(pb + 5)) { PHASE_PTRS(); streams_phase(P, l, gw, NGW); }
        SEAM(pb + 5);
        if (EN(7) && IN(pb + 6)) {
            if (EN(16)) { PHASE_PTRS(); EpiWA E{P.in[I_W0] + (size_t)l * 2 * RWW, P.in[I_A0] + (size_t)l * 2 * RWW, P.in[I_KA] + (size_t)l * RWW, WSP(const float, WS_KT), WSP(const float, WS_SS), WSP(float, WS_SD), WSP(float, WS_G)};
              run_gemm(lds, WSP(const bf16, WS_LWA), WSP(const bf16, WS_WWA + (size_t)l * SZ_WWA), MROWS, 10240, 512, G, E, wave); }
            if (EN(18)) { PHASE_PTRS(); EpiF32 E{WSP(float, WS_QF), 3072}; run_gemm(lds, WSP(const bf16, WS_QL), WSP(const bf16, WS_WQ + (size_t)l * SZ_WQ), MROWS, 3072, 1024, G, E, wave); }
            if (EN(19)) { PHASE_PTRS(); EpiF32 E{WSP(float, WS_KVF), 4096}; run_gemm(lds, WSP(const bf16, WS_KVL), WSP(const bf16, WS_WKV + (size_t)l * SZ_WKV), MROWS, 4096, 512, G, E, wave); }
        }
        SEAM(pb + 6);
        if (EN(8) && IN(pb + 7)) { PHASE_PTRS(); qknorm_phase(P, l, gw, NGW); }
        SEAM(pb + 7);
        if (EN(9) && IN(pb + 8)) { PHASE_PTRS(); scan_phase(P, lds, vcu, wave); }
        SEAM(pb + 8);
        if (EN(10) && IN(pb + 9)) {
            PHASE_PTRS();
            const int nun = 512 + (last ? 0 : 16);
            const bf16* QB = WSP(const bf16, WS_QB); const bf16* KB = WSP(const bf16, WS_KB); const bf16* VB = WSP(const bf16, WS_VB); bf16* OC = WSP(bf16, WS_OC);
            for (int u = vcu; u < nun; u += G) {
                int h, q0, key0, nk;
                if (u < 512) { h = u >> 5; q0 = (u & 31) * 256; key0 = 0; nk = MROWS; } else { h = u - 512; q0 = SEQ; key0 = SEQ; nk = CTXL; }
                att::attn_body(QB + (size_t)q0 * 3072 + h * 192, KB + (size_t)key0 * 3072 + h * 192, VB + (size_t)key0 * 2048 + h * 128, OC + (size_t)q0 * DM + 2048 + h * 128, nk, (char*)lds_raw, wave);
            }
            __syncthreads();
        }
        SEAM(pb + 9);
        if (EN(11) && IN(pb + 10)) { PHASE_PTRS(); rwkvout_phase(P, l, nrows2, gw, NGW); }
        SEAM(pb + 10);
        if (EN(12) && IN(pb + 11)) { PHASE_PTRS(); EpiRes E{X, XC, X, XC, modL + 5 * DM, modC + 5 * DM, 1.0f}; run_gemm(lds, WSP(const bf16, WS_OC), WSP(const bf16, WS_WOUT + (size_t)l * SZ_WOUT), nrows2, DM, DM, G, E, wave); }
        SEAM(pb + 11);
        if (EN(13) && IN(pb + 12)) { PHASE_PTRS(); prep_phase(lds, X, XC, nrows2, P.in[I_NORMG] + (size_t)(l * 3 + 2) * DM, modL, modC, 6, WSP(bf16, WS_XN), gw, NGW, wave); }
        SEAM(pb + 12);
        if (EN(14) && IN(pb + 13)) { PHASE_PTRS(); EpiSwiGLU E{WSP(bf16, WS_H)}; run_gemm(lds, WSP(const bf16, WS_XN), WSP(const bf16, WS_WFI + (size_t)(l * 2 + 1) * SZ_WFI), nrows2, 16384, DM, G, E, wave); }
        SEAM(pb + 13);
        if (EN(15) && IN(pb + 14)) { PHASE_PTRS(); float* oL = last ? P.out : X;
            EpiRes E{X, XC, oL, XC, modL + 8 * DM, modC + 8 * DM, 0.5f}; run_gemm(lds, WSP(const bf16, WS_H), WSP(const bf16, WS_WFO + (size_t)(l * 2 + 1) * SZ_WFO), nrows2, DM, DFF, G, E, wave); }
        SEAM(pb + 14);
    }
    if ((PHSEL < 0 || PHSEL == 100) && DBG_STOP < NPHASE - 1 && lo <= PH_COPY && PH_COPY < hi) {
        const int l = 0; PHASE_PTRS();
        const int tid = wave * 64 + lane_vol();
#if defined(DBG_PROBE)
#define BF(buf, idx) __uint_as_float((unsigned)WSP(const unsigned short, buf)[idx] << 16)
        for (size_t i = (size_t)(bx * NTHR + tid); i < (size_t)SEQ * DM; i += (size_t)G * NTHR) {
            const int band = (int)(i >> 22); const size_t j = i & 4194303; float v = 0.f;
#if DBG_PROBE == 1
            if (band == 0) v = WSP(const float, WS_SD)[(j * 23) % ((size_t)2 * MROWS * 6144)];
            else if (band == 1) v = WSP(const float, WS_G)[(j * 3) % ((size_t)MROWS * 2048)];
            else if (band == 2) v = WSP(const float, WS_QF)[(j * 5) % ((size_t)MROWS * 3072)];
            else if (band == 3) v = WSP(const float, WS_KVF)[(j * 7) % ((size_t)MROWS * 4096)];
#elif DBG_PROBE == 7
            if (band == 0) v = WSP(const float, WS_SS)[(j * 9) % ((size_t)MROWS * 4096)];
            else if (band == 1) v = WSP(const float, WS_KT)[(j * 5) % ((size_t)MROWS * 2048)];
            else if (band == 2) v = BF(WS_LWA, (j * 3) % ((size_t)MROWS * 512));
            else if (band == 3) v = BF(WS_QL, (j * 3) % ((size_t)MROWS * 1024));
            else if (band == 4) v = BF(WS_KVL, (j * 3) % ((size_t)MROWS * 512));
            else if (band == 5) v = WSP(const float, WS_VV)[(j * 5) % ((size_t)MROWS * 2048)];
            else if (band == 6) v = WSP(const float, WS_Z)[(j * 17) % ((size_t)MROWS * 8192)];
            else v = BF(WS_XN, (j * 9) % ((size_t)MROWS * 4096));
#elif DBG_PROBE == 8
            if (band == 0) v = X[(j * 9) % ((size_t)MROWS * 4096)];
            else if (band == 1) v = BF(WS_XN, (j * 9) % ((size_t)MROWS * 4096));
#elif DBG_PROBE == 9
            if (band == 0) v = WSP(const float, WS_Z)[(j * 17) % ((size_t)MROWS * 8192)];
#elif DBG_PROBE == 10
            if (band == 0) v = WSP(const float, WS_SS)[(j * 9) % ((size_t)MROWS * 4096)];
            else if (band == 1) v = WSP(const float, WS_KT)[(j * 5) % ((size_t)MROWS * 2048)];
            else if (band == 2) v = WSP(const float, WS_VV)[(j * 5) % ((size_t)MROWS * 2048)];
#elif DBG_PROBE == 11
            if (band == 0) v = BF(WS_LWA, (j * 3) % ((size_t)MROWS * 512));
            else if (band == 1) v = BF(WS_QL, (j * 3) % ((size_t)MROWS * 1024));
            else if (band == 2) v = BF(WS_KVL, (j * 3) % ((size_t)MROWS * 512));
#elif DBG_PROBE == 5
            if (band == 0) v = WSP(const float, WS_QF)[(j * 5) % ((size_t)MROWS * 3072)];
            else if (band == 1) v = WSP(const float, WS_KVF)[(j * 7) % ((size_t)MROWS * 4096)];
#elif DBG_PROBE == 6
            if (band == 0) v = WSP(const float, WS_G)[(j * 3) % ((size_t)MROWS * 2048)];
#elif DBG_PROBE == 2
            if (band < 4) v = WSP(const float, WS_Y)[((size_t)band * 4194304 + j) * 4 + 1];
#elif DBG_PROBE == 3
            { const unsigned short b = WSP(const unsigned short, WS_OC)[((size_t)band * 4194304 + j)]; v = __uint_as_float((unsigned)b << 16); }
#elif DBG_PROBE == 4
            { const unsigned short b = WSP(const unsigned short, WS_KB)[((size_t)(band & 3) * 4194304 + j) * ((band < 4) ? 1 : 0) ]; const unsigned short b2 = WSP(const unsigned short, WS_VB)[((size_t)(band & 3) * 4194304 + j)];
              v = __uint_as_float((unsigned)(band < 4 ? b : b2) << 16); }
#endif
            P.out[i] = v;
        }
#else
        const float* src = (DBG_STOP >= 3) ? X : P.in[I_X];
        for (size_t i = (size_t)(bx * NTHR + tid); i < (size_t)SEQ * DM / 4; i += (size_t)G * NTHR) ((f32x4*)P.out)[i] = ((const f32x4*)src)[i];
#endif
    }
#undef IN
#undef SEAM
}

extern "C" void kernel_launch(void* const* d_in, const int* in_sizes, int n_in, void* d_out, int out_size, void* d_ws, size_t ws_size, hipStream_t stream) {
    static int grid = 0;
    if (grid == 0) {
        if (n_in != N_IN || out_size != SEQ * DM || ws_size < WS_END) { fprintf(stderr, "kernel_launch: unexpected shapes: n_in %d out %d ws %zu (need %zu)\n", n_in, out_size, ws_size, (size_t)WS_END); grid = -1; return; }
        int dev = 0, cus = 0;
        if (hipGetDevice(&dev) != hipSuccess || hipDeviceGetAttribute(&cus, hipDeviceAttributeMultiprocessorCount, dev) != hipSuccess) { grid = -1; return; }
        {
            hipError_t e = hipSuccess;
#if MK_ONE_LAUNCH
            e = hipFuncSetAttribute((const void*)fwd_kernel<-1>, hipFuncAttributeMaxDynamicSharedMemorySize, LDS_BYTES);
#else
#define SETA(S) if (e == hipSuccess) e = hipFuncSetAttribute((const void*)fwd_kernel<S>, hipFuncAttributeMaxDynamicSharedMemorySize, LDS_BYTES)
            SETA(0); SETA(1); SETA(2); SETA(3); SETA(4); SETA(5); SETA(6); SETA(7); SETA(8); SETA(9); SETA(10); SETA(11); SETA(12); SETA(13); SETA(14); SETA(15); SETA(100);
#undef SETA
#endif
            if (e != hipSuccess) { fprintf(stderr, "kernel_launch: hipFuncSetAttribute failed\n"); grid = -1; return; }
        }
        (void)hipGetLastError();
        grid = cus;
    }
    if (grid < 0) return;
    (void)hipMemsetAsync((char*)d_ws + WS_CTL, 0, ZERO_BYTES, stream);
    Args a{};
    for (int i = 0; i < N_IN; ++i) a.in[i] = (const float*)d_in[i];
    a.out = (float*)d_out; a.ws = (unsigned char*)d_ws;
    const int last_phase = (DBG_STOP < NPHASE - 1) ? PH_COPY : NPHASE - 1;
#if MK_ONE_LAUNCH
    a.ph_lo = 0; a.ph_hi = last_phase + 1;
    hipLaunchKernelGGL(fwd_kernel<-1>, dim3(grid), dim3(NTHR), LDS_BYTES, stream, a);
#else
    for (int p = 0; p <= last_phase; ++p) {
        if (p > DBG_STOP && p != PH_COPY) continue;
#ifdef HOST_SKIP_FROM
        if (p >= HOST_SKIP_FROM && p != PH_COPY) continue;
#endif
        a.ph_lo = p; a.ph_hi = p + 1;
        const int slot = (p == 0) ? 0 : (p == PH_COPY ? 100 : 1 + (p - 1) % PH_PER_LAYER);
#define LCH(S) case S: hipLaunchKernelGGL(fwd_kernel<S>, dim3(grid), dim3(NTHR), LDS_BYTES, stream, a); break
        switch (slot) { LCH(0); LCH(1); LCH(2); LCH(3); LCH(4); LCH(5); LCH(6); LCH(7); LCH(8); LCH(9); LCH(10); LCH(11); LCH(12); LCH(13); LCH(14); LCH(15); LCH(100); default: break; }
#undef LCH
    }
#endif
    const hipError_t le = hipPeekAtLastError();
    if (le != hipSuccess) fprintf(stderr, "kernel_launch: launch failed: %s\n", hipGetErrorName(le));
}
```

```cpp
#include <hip/hip_runtime.h>
#include <cstdio>
#include <cstdint>
#define MK_ONE_LAUNCH 1
#define DBG_STOP 1000
#ifndef MK_ONE_LAUNCH
#define MK_ONE_LAUNCH 1
#endif
namespace pg8 {
#define PG8_LAS __attribute__((address_space(3)))
typedef unsigned short bf16_t;
typedef short bf16x8 __attribute__((ext_vector_type(8)));
typedef float f32x4 __attribute__((ext_vector_type(4)));
typedef unsigned u32x4 __attribute__((ext_vector_type(4)));
constexpr int BM = 256, BK = 64, HALF = 128, HTB = HALF * BK * 2  , STAGE_BYTES = 8 * HTB, NXCD = 8, WGM = 8;

__host__ __device__ __forceinline__ int lds_byte(int r, int c) { const int st = (r >> 4) * 2 + (c >> 5), rr = r & 15, cc = c & 31, ob = rr * 64 + cc * 2; return st * 1024 + (ob ^ (((ob >> 9) & 1) << 5)); }
__host__ __device__ __forceinline__ void stage_rc(int b, int& R, int& C) { const int st = b / 1024, sb = b % 1024, swz = sb ^ (((sb >> 9) & 1) << 5); R = (st >> 1) * 16 + swz / 64; C = (st & 1) * 32 + (swz % 64) / 2; }
__host__ __device__ __forceinline__ int perm32(int rho) { const int n = rho >> 4, i = rho & 15; return 8 * (i >> 2) + 4 * n + (i & 3); }

struct Unit { int pm, pn; };
struct Gemm { const bf16_t* A; const bf16_t* Bt; int M, N, K; int ld; size_t apm, bpm; };

struct StaticOrder {
    int nM, nN, nwg, G, c;
    __host__ __device__ void init(int M, int N, int G_, int c_) { nM = M / BM; nN = N / BM; nwg = nM * nN; G = G_; c = c_; }
    __host__ __device__ bool next(int i, Unit& u) const {
        const long L = (long)i * G + c; if (L >= nwg) return false;
        int wgid = (int)L; { const int q = nwg / NXCD, r = nwg % NXCD, xcd = wgid % NXCD, off = wgid / NXCD; wgid = (xcd < r ? xcd * (q + 1) : r * (q + 1) + (xcd - r) * q) + off; }
        const int nig = WGM * nN, gid = wgid / nig, fm = gid * WGM, gsz = (nM - fm) < WGM ? (nM - fm) : WGM;
        u.pm = fm + ((wgid % nig) % gsz); u.pn = (wgid % nig) / gsz; return true;
    }
    __device__ __forceinline__ void a_ready(const Unit&) const {}
    __device__ __forceinline__ void done(const Unit&) const {}
};

__device__ __forceinline__ unsigned cvt_pk_bf16(float lo, float hi) { unsigned r; asm volatile("s_nop 0\n\tv_cvt_pk_bf16_f32 %0, %1, %2" : "=v"(r) : "v"(lo), "v"(hi)); return r; }
template <class Epi, class Sched, bool ALIGN_EPI = false, bool SP2 = false>
__device__ __forceinline__ void gemm_phase(PG8_LAS unsigned char* lds, const Gemm g, const Sched& S, const Epi& E, int wave_in) {
    int tid_o; asm volatile("v_mbcnt_lo_u32_b32 %0, -1, 0\n\tv_mbcnt_hi_u32_b32 %0, -1, %0" : "=v"(tid_o)); tid_o += wave_in * 64;
    const int tid = tid_o, wid = wave_in, lane = tid & 63, wr = wid >> 2, wc = wid & 3, fr = lane & 15, fq = lane >> 4;
    const int K = g.K, nt = K / BK, LD = g.ld;
    unsigned voffA[2], voffB[2];
#pragma unroll
    for (int i = 0; i < 2; ++i) { int R, C; stage_rc(tid * 16 + i * 8192, R, C); const int Rb = Epi::PERM ? ((R & ~31) + perm32(R & 31)) : R;
        voffA[i] = (unsigned)(R * LD + C) * 2u; voffB[i] = (unsigned)(Rb * LD + C) * 2u; }
    const size_t kstep = (size_t)(BK * 2);
    const size_t hstep = (size_t)HALF * LD * 2;
    const size_t tstep = 2 * hstep;
    const unsigned ldsw = (unsigned)wid * 1024u;
    const int aoff = lds_byte(wr * 64 + fr, fq * 8), boff = lds_byte(wc * 32 + fr, fq * 8);
#define PG8_SA(b, h) (((b) * 2 + (h)) * HTB)
#define PG8_SB(b, h) ((4 + (b) * 2 + (h)) * HTB)
#define PG8_STAGE(bufoff, gbase, voff) do { _Pragma("unroll") for (int _i = 0; _i < 2; ++_i) \
        __builtin_amdgcn_global_load_lds((const unsigned*)((const char*)(gbase) + (voff)[_i]), (PG8_LAS unsigned*)(lds + (bufoff) + ldsw + _i * 8192), 16, 0, 0); } while (0)
#define PG8_LDA(dst, b, h) do { _Pragma("unroll") for (int m = 0; m < 4; ++m) _Pragma("unroll") for (int k = 0; k < 2; ++k) dst[m][k] = *(const PG8_LAS bf16x8*)(lds + PG8_SA(b, h) + aoff + m * 2048 + k * 1024); } while (0)
#define PG8_LDB(dst, b, h) do { _Pragma("unroll") for (int n = 0; n < 2; ++n) _Pragma("unroll") for (int k = 0; k < 2; ++k) dst[n][k] = *(const PG8_LAS bf16x8*)(lds + PG8_SB(b, h) + boff + n * 2048 + k * 1024); } while (0)
#define PG8_MMA(ai, bj, At, Bt) do { __builtin_amdgcn_s_setprio(1); _Pragma("unroll") for (int m = 0; m < 4; ++m) _Pragma("unroll") for (int n = 0; n < 2; ++n) _Pragma("unroll") for (int k = 0; k < 2; ++k) \
        acc[ai][bj][m][n] = __builtin_amdgcn_mfma_f32_16x16x32_bf16(Bt[n][k], At[m][k], acc[ai][bj][m][n], 0, 0, 0); __builtin_amdgcn_s_setprio(0); } while (0)
#define PG8_WAIT_V(n) asm volatile("s_waitcnt vmcnt(" #n ")" ::: "memory")
#define PG8_WAIT_L(n) asm volatile("s_waitcnt lgkmcnt(" #n ")" ::: "memory")
#define PG8_BAR __builtin_amdgcn_s_barrier()
#define PG8_SCHED __builtin_amdgcn_sched_barrier(0)
    Unit cur, nxt; int ui = 0;
    if (!S.next(0, cur)) return;
    f32x4 acc[2][2][4][2];
#pragma unroll
    for (int a = 0; a < 2; ++a)
#pragma unroll
        for (int b = 0; b < 2; ++b)
#pragma unroll
            for (int m = 0; m < 4; ++m)
#pragma unroll
                for (int n = 0; n < 2; ++n) acc[a][b][m][n] = (f32x4){0.f, 0.f, 0.f, 0.f};
    bf16x8 At[4][2], B0[2][2], B1[2][2];
    const char* cA = (const char*)g.A + (size_t)cur.pm * g.apm; const char* cB = (const char*)g.Bt + (size_t)cur.pn * tstep + (size_t)cur.pm * g.bpm;
    S.a_ready(cur);
    if constexpr (SP2) {
        PG8_STAGE(PG8_SB(0, 0), cB, voffB); PG8_STAGE(PG8_SB(0, 1), cB + hstep, voffB); PG8_STAGE(PG8_SA(0, 0), cA, voffA); PG8_STAGE(PG8_SA(0, 1), cA + hstep, voffA);
        if (wr == 1) PG8_BAR;
        PG8_WAIT_V(2); PG8_BAR;
        PG8_STAGE(PG8_SB(1, 0), cB + kstep, voffB); PG8_STAGE(PG8_SA(1, 0), cA + kstep, voffA); PG8_STAGE(PG8_SB(1, 1), cB + hstep + kstep, voffB);
        PG8_WAIT_V(6); PG8_BAR;
    } else {
        PG8_STAGE(PG8_SB(0, 0), cB, voffB); PG8_STAGE(PG8_SA(0, 0), cA, voffA); PG8_STAGE(PG8_SB(0, 1), cB + hstep, voffB); PG8_STAGE(PG8_SA(0, 1), cA + hstep, voffA);
        if (wr == 1) PG8_BAR;
        PG8_WAIT_V(4); PG8_BAR;
        PG8_STAGE(PG8_SB(1, 0), cB + kstep, voffB); PG8_STAGE(PG8_SA(1, 0), cA + kstep, voffA); PG8_STAGE(PG8_SB(1, 1), cB + hstep + kstep, voffB);
        PG8_WAIT_V(6); PG8_BAR;
    }
    for (;;) {
        const bool has_next = S.next(ui + 1, nxt);
        const char* nA = has_next ? (const char*)g.A + (size_t)nxt.pm * g.apm : cA; const char* nB = has_next ? (const char*)g.Bt + (size_t)nxt.pn * tstep + (size_t)nxt.pm * g.bpm : cB;
        for (int t = 0; t < nt; t += 2) {
            const bool last = (t == nt - 2);
            const char* a1 = cA + (size_t)(t + 1) * kstep;
            const char* a2 = last ? nA : cA + (size_t)(t + 2) * kstep; const char* b2 = last ? nB : cB + (size_t)(t + 2) * kstep;
            const char* a3 = a2 + kstep; const char* b3 = b2 + kstep;
            if (last && has_next) S.a_ready(nxt);
            if constexpr (SP2) {
            PG8_LDB(B0, 0, 0); PG8_LDB(B1, 0, 1); PG8_SCHED; PG8_LDA(At, 0, 0); PG8_STAGE(PG8_SA(1, 1), a1 + hstep, voffA);
            PG8_WAIT_V(8); PG8_WAIT_L(0); PG8_BAR; PG8_MMA(0, 0, At, B0); PG8_MMA(0, 1, At, B1); PG8_BAR; PG8_SCHED;
            PG8_LDA(At, 0, 1); PG8_STAGE(PG8_SB(0, 0), b2, voffB); PG8_STAGE(PG8_SB(0, 1), b2 + hstep, voffB); PG8_STAGE(PG8_SA(0, 0), a2, voffA);
            PG8_WAIT_V(8); PG8_WAIT_L(0); PG8_BAR; PG8_MMA(1, 0, At, B0); PG8_MMA(1, 1, At, B1); PG8_BAR; PG8_SCHED;
            PG8_LDB(B0, 1, 0); PG8_LDB(B1, 1, 1); PG8_SCHED; PG8_LDA(At, 1, 0); PG8_STAGE(PG8_SA(0, 1), a2 + hstep, voffA);
            PG8_WAIT_V(8); PG8_WAIT_L(0); PG8_BAR; PG8_MMA(0, 0, At, B0); PG8_MMA(0, 1, At, B1); PG8_BAR; PG8_SCHED;
            PG8_LDA(At, 1, 1); PG8_STAGE(PG8_SB(1, 0), b3, voffB); PG8_STAGE(PG8_SB(1, 1), b3 + hstep, voffB); PG8_STAGE(PG8_SA(1, 0), a3, voffA);
            PG8_WAIT_V(8); PG8_WAIT_L(0); PG8_BAR; PG8_MMA(1, 0, At, B0); PG8_MMA(1, 1, At, B1); PG8_BAR; PG8_SCHED;
            } else {
            PG8_LDB(B0, 0, 0); PG8_SCHED; PG8_LDA(At, 0, 0); PG8_STAGE(PG8_SA(1, 1), a1 + hstep, voffA);
            PG8_WAIT_L(8); PG8_BAR; PG8_WAIT_L(0); PG8_MMA(0, 0, At, B0); PG8_BAR; PG8_SCHED;
            PG8_LDB(B1, 0, 1); PG8_STAGE(PG8_SB(0, 0), b2, voffB);
            PG8_BAR; PG8_WAIT_L(0); PG8_MMA(0, 1, At, B1); PG8_BAR;
            PG8_LDA(At, 0, 1); PG8_STAGE(PG8_SA(0, 0), a2, voffA);
            PG8_BAR; PG8_WAIT_L(0); PG8_MMA(1, 0, At, B0); PG8_BAR; PG8_SCHED;
            PG8_STAGE(PG8_SB(0, 1), b2 + hstep, voffB);
            PG8_WAIT_V(6); PG8_BAR; PG8_MMA(1, 1, At, B1); PG8_BAR;
            PG8_LDB(B0, 1, 0); PG8_SCHED; PG8_LDA(At, 1, 0); PG8_STAGE(PG8_SA(0, 1), a2 + hstep, voffA);
            PG8_WAIT_L(8); PG8_BAR; PG8_WAIT_L(0); PG8_MMA(0, 0, At, B0); PG8_BAR; PG8_SCHED;
            PG8_LDB(B1, 1, 1); PG8_STAGE(PG8_SB(1, 0), b3, voffB);
            PG8_BAR; PG8_WAIT_L(0); PG8_MMA(0, 1, At, B1); PG8_BAR;
            PG8_LDA(At, 1, 1); PG8_STAGE(PG8_SA(1, 0), a3, voffA);
            PG8_BAR; PG8_WAIT_L(0); PG8_MMA(1, 0, At, B0); PG8_BAR; PG8_SCHED;
            PG8_STAGE(PG8_SB(1, 1), b3 + hstep, voffB);
            PG8_WAIT_V(6); PG8_BAR; PG8_MMA(1, 1, At, B1); PG8_BAR;
            }
        }
        if constexpr (ALIGN_EPI) { if (wr == 0) PG8_BAR; }
        if constexpr (!Epi::AFTER_DRAIN) { E(acc, cur, wr, wc, fr, fq); S.done(cur); }
        if (!has_next) break;
#pragma unroll
        for (int a = 0; a < 2; ++a)
#pragma unroll
            for (int b = 0; b < 2; ++b)
#pragma unroll
                for (int m = 0; m < 4; ++m)
#pragma unroll
                    for (int n = 0; n < 2; ++n) acc[a][b][m][n] = (f32x4){0.f, 0.f, 0.f, 0.f};
        cur = nxt; cA = nA; cB = nB; ++ui;
        if constexpr (ALIGN_EPI) { if (wr == 1) PG8_BAR; }
    }
    PG8_WAIT_V(0);
    if constexpr (!ALIGN_EPI) { if (wr == 0) PG8_BAR; }
    PG8_BAR;
    if constexpr (Epi::AFTER_DRAIN) { E.fused(acc, cur, wr, wc, fr, fq, lds, wid, lane); S.done(cur); }
#undef PG8_SA
#undef PG8_SB
#undef PG8_STAGE
#undef PG8_LDA
#undef PG8_LDB
#undef PG8_MMA
#undef PG8_WAIT_V
#undef PG8_WAIT_L
#undef PG8_BAR
#undef PG8_SCHED
}
}
#define GAS __attribute__((address_space(1)))
#define LAS __attribute__((address_space(3)))
typedef unsigned short bf16;
typedef unsigned v4u __attribute__((ext_vector_type(4)));
typedef float f32x4 __attribute__((ext_vector_type(4)));
typedef short bf16x8 __attribute__((ext_vector_type(8)));
typedef GAS unsigned gu32;
typedef GAS unsigned long long gu64;
#define RLX_AGENT __ATOMIC_RELAXED, __HIP_MEMORY_SCOPE_AGENT
#define LDS_WAIT() asm volatile("s_waitcnt lgkmcnt(0)" ::: "memory")
#define VM_WAIT() asm volatile("s_waitcnt vmcnt(0)" ::: "memory")
__device__ __forceinline__ unsigned long long rt() { return __builtin_amdgcn_s_memrealtime(); }
__device__ __forceinline__ unsigned f2bf(float f) { unsigned u = __builtin_bit_cast(unsigned, f); return (u + 0x7fffu + ((u >> 16) & 1u)) >> 16; }
__device__ __forceinline__ unsigned pk2(float lo, float hi) { return f2bf(lo) | (f2bf(hi) << 16); }

#define XB_TMO      128
#define XB_XCNT(j)  (256  + 64 * (j))
#define XB_XSUB(j)  (1280 + 64 * (j))
#define XB_XGEN(j)  (2304 + 64 * (j))
#define XB_TOP      3328
#define XB_TOPGEN   3392
#define XCD_BAR_WORDS 3456
#define XB_SPIN_CAP (1u << 18)

__device__ __forceinline__ unsigned xb_ld(unsigned* p)              { return __hip_atomic_load(p, __ATOMIC_RELAXED, __HIP_MEMORY_SCOPE_AGENT); }
__device__ __forceinline__ unsigned xb_add(unsigned* p, unsigned v) { return __hip_atomic_fetch_add(p, v, __ATOMIC_RELAXED, __HIP_MEMORY_SCOPE_AGENT); }
__device__ __forceinline__ unsigned xb_xcc_id() { return (unsigned)__builtin_amdgcn_s_getreg((3 << 11) | 20) & 0xFu; }
#define XB_SPIN(cond, bar) do { unsigned _sp = 0; while (cond) { __builtin_amdgcn_s_sleep(1); \
    if ((++_sp & 255u) == 0u) { if (xb_ld(&(bar)[XB_TMO])) break; if (_sp > XB_SPIN_CAP) { atomicAdd(&(bar)[XB_TMO], 1u); break; } } } } while (0)

struct XcdBarrier {
    unsigned* bar; unsigned x;
    volatile LAS unsigned* st;
    int wave;
};
__device__ __forceinline__ int xb_lane() { int l; asm volatile("v_mbcnt_lo_u32_b32 %0, -1, 0\n\tv_mbcnt_hi_u32_b32 %0, -1, %0" : "=v"(l)); return l; }

__device__ __forceinline__ XcdBarrier xcd_barrier_post(unsigned* bar, volatile LAS unsigned* st) {
    XcdBarrier b; b.bar = bar; b.x = xb_xcc_id(); b.st = st; b.wave = 0;
    if (threadIdx.x == 0) (void)xb_add(&bar[XB_XCNT(b.x)], 1u);
    return b;
}
__device__ __forceinline__ void xcd_barrier_complete(unsigned* bar, unsigned x, unsigned& nloc, unsigned& nx) {
    const unsigned G = gridDim.x * gridDim.y * gridDim.z;
    unsigned sum, cnt, mine, sp = 0u;
    for (;;) {
        sum = 0u; cnt = 0u; mine = 0u;
#pragma unroll
        for (unsigned j = 0; j < 16; ++j) { const unsigned c = xb_ld(&bar[XB_XCNT(j)]); sum += c; cnt += (c > 0u) ? 1u : 0u; mine = (j == x) ? c : mine; }
        if (sum == G) break;
        __builtin_amdgcn_s_sleep(1);
        if ((++sp & 255u) == 0u) { if (xb_ld(&bar[XB_TMO])) break; if (sp > XB_SPIN_CAP) { atomicAdd(&bar[XB_TMO], 1u); break; } }
    }
    nloc = mine > 0u ? mine : 1u; nx = cnt > 0u ? cnt : 1u;
}

__device__ __forceinline__ void xcd_barrier(const XcdBarrier& b) {
    asm volatile("s_waitcnt vmcnt(0)" ::: "memory");
    __syncthreads();
    if (b.wave == 0 && xb_lane() == 0) {
        unsigned* bar = b.bar;
        __builtin_amdgcn_s_waitcnt(0);
        unsigned nloc = b.st[0], nx = b.st[1];
        if (nloc == 0u) { xcd_barrier_complete(bar, b.x, nloc, nx); b.st[0] = nloc; b.st[1] = nx; }
        const unsigned old = xb_add(&bar[XB_XSUB(b.x)], 1u);
        const unsigned gen = old / nloc;
        if (old + 1u == (gen + 1u) * nloc) {
            __builtin_amdgcn_fence(__ATOMIC_RELEASE, "agent");
            asm volatile("s_waitcnt vmcnt(0)" ::: "memory");
            const unsigned og = xb_add(&bar[XB_TOP], 1u);
            const unsigned tg = og / nx;
            if (og + 1u == (tg + 1u) * nx) xb_add(&bar[XB_TOPGEN], 1u);
            else XB_SPIN(xb_ld(&bar[XB_TOPGEN]) == tg, bar);
            __builtin_amdgcn_fence(__ATOMIC_ACQUIRE, "agent");
            xb_add(&bar[XB_XGEN(b.x)], 1u);
            asm volatile("s_waitcnt vmcnt(0)" ::: "memory");
        } else {
            XB_SPIN(xb_ld(&bar[XB_XGEN(b.x)]) == gen, bar);
            __builtin_amdgcn_fence(__ATOMIC_ACQUIRE, "agent");
            asm volatile("s_waitcnt vmcnt(0)" ::: "memory");
        }
    }
    __syncthreads();
}

#ifndef BG_CONV
#define BG_CONV 1
#endif
constexpr int NWAVES = 8, NTHR = 512;
constexpr int DM = 4096, SEQ = 8192, CTXL = 256, MROWS = SEQ + CTXL, DFF = 8192, NMODC = 9 * DM;
constexpr int RWW = 2048, RWCOLS = 6592, ZC = 8192;
constexpr int LDS_BYTES = 155648;
constexpr int MISC_OFF = 151552;

constexpr size_t MiB = 1u << 20;
constexpr size_t al(size_t x) { return (x + MiB - 1) / MiB * MiB; }
constexpr size_t WS_CTL = 0, WS_MOD = 1 * MiB, ZERO_BYTES = 2 * MiB;
constexpr size_t SZ_WFI = (size_t)16384 * 4096 * 2, SZ_WFO = (size_t)4096 * 8192 * 2, SZ_WIN = (size_t)8192 * 4096 * 2, SZ_WOUT = (size_t)4096 * 4096 * 2;
constexpr size_t SZ_WQ = (size_t)3072 * 1024 * 2, SZ_WKV = (size_t)4096 * 512 * 2, SZ_WWA = (size_t)10240 * 512 * 2, SZ_WG = 0;
constexpr size_t WS_WFI = 2 * MiB, WS_WFO = WS_WFI + 4 * SZ_WFI, WS_WIN = WS_WFO + 4 * SZ_WFO, WS_WOUT = WS_WIN + 2 * SZ_WIN, WS_WQ = WS_WOUT + 2 * SZ_WOUT;
constexpr size_t WS_WKV = WS_WQ + 2 * SZ_WQ, WS_WWA = WS_WKV + 2 * SZ_WKV, WS_WG = WS_WWA + 2 * SZ_WWA, WS_ACT = WS_WG + 2 * SZ_WG;
constexpr size_t WS_X = WS_ACT;
constexpr size_t WS_XN = WS_X + al((size_t)MROWS * DM * 4);
constexpr size_t WS_H = WS_XN + al((size_t)MROWS * DM * 2);
constexpr size_t WS_Z = WS_H + al((size_t)MROWS * DFF * 2);
constexpr size_t WS_SS = WS_Z + al((size_t)MROWS * ZC * 4);
constexpr size_t WS_VV = WS_SS + al((size_t)MROWS * 4096 * 4);
constexpr size_t WS_KT = WS_VV + al((size_t)MROWS * 2048 * 4);
constexpr size_t WS_LW = WS_KT + al((size_t)MROWS * 2048 * 4);
constexpr size_t WS_LWA = WS_LW + al((size_t)MROWS * 10240 * 4);
constexpr size_t WS_LG = WS_LWA + al((size_t)MROWS * 512 * 2);
constexpr size_t WS_QL = WS_LG + al((size_t)MROWS * 256 * 2);
constexpr size_t WS_KVL = WS_QL + al((size_t)MROWS * 1024 * 2);
constexpr size_t WS_QF = WS_KVL + al((size_t)MROWS * 512 * 2);
constexpr size_t WS_KVF = WS_QF + al((size_t)MROWS * 3072 * 4);
#ifndef QB_GAP
#define QB_GAP 0
#endif
constexpr size_t WS_QB = WS_KVF + al((size_t)MROWS * 4096 * 4) + (size_t)QB_GAP * MiB;
constexpr size_t WS_KB = WS_QB + al((size_t)MROWS * 3072 * 2);
constexpr size_t WS_VB = WS_KB + al((size_t)MROWS * 3072 * 2);
constexpr size_t WS_Y = WS_VB + al((size_t)MROWS * 2048 * 2);
constexpr size_t WS_OC = WS_Y + al((size_t)2 * MROWS * 2048 * 4);
constexpr int SK_NS = 8;
constexpr size_t WS_ACC = WS_OC + al((size_t)MROWS * DM * 2);
constexpr size_t SZ_ACC = (size_t)CTXL * DM * 4;
constexpr size_t WS_SLB = WS_ACC + SK_NS * SZ_ACC;
constexpr size_t WS_END = WS_SLB + 32 * MiB;
constexpr int CW_BAR = 4096, CW_MIX = 8192;

enum { I_X = 0, I_C, I_CTX, I_CCTX, I_WMOD, I_BMOD, I_NORMG, I_FWI, I_FWO, I_WIN, I_WOUT, I_MU, I_W0, I_WUP, I_A0, I_AUP, I_GUP, I_KK, I_KA, I_RK, I_LNW, I_LNB,
       I_QNORM, I_QUP, I_KVNORM, I_KVUP, I_QGAIN, I_KGAIN, N_IN };

__device__ __forceinline__ int lane_vol() { int l; asm volatile("v_mbcnt_lo_u32_b32 %0, -1, 0\n\tv_mbcnt_hi_u32_b32 %0, -1, %0" : "=v"(l)); return l; }
__device__ __forceinline__ float wave_sum(float v) {
#pragma unroll
    for (int o = 1; o < 64; o <<= 1) v += __shfl_xor(v, o);
    return v;
}
__device__ __forceinline__ float sum16(float v) {
#pragma unroll
    for (int o = 1; o < 16; o <<= 1) v += __shfl_xor(v, o);
    return v;
}
__device__ __forceinline__ float sigm(float x) { return __builtin_amdgcn_rcpf(1.f + __builtin_amdgcn_exp2f(-1.4426950408889634f * x)); }
__device__ __forceinline__ float dot4(f32x4 a, f32x4 b) { return (a.x * b.x + a.y * b.y) + (a.z * b.z + a.w * b.w); }
typedef unsigned u32x2 __attribute__((ext_vector_type(2)));
__device__ __forceinline__ f32x4 ubf4(u32x2 w) { f32x4 r; r.x = __uint_as_float(w.x << 16); r.y = __uint_as_float(w.x & 0xffff0000u); r.z = __uint_as_float(w.y << 16); r.w = __uint_as_float(w.y & 0xffff0000u); return r; }
__device__ __forceinline__ u32x2 pk4(f32x4 v) { u32x2 r; r.x = pg8::cvt_pk_bf16(v.x, v.y); r.y = pg8::cvt_pk_bf16(v.z, v.w); return r; }

struct EpiSwiGLU {
    static constexpr bool PERM = true, AFTER_DRAIN = false;
    bf16* H;
    __device__ __forceinline__ void operator()(const pg8::f32x4 (&acc)[2][2][4][2], const pg8::Unit& u, int wr, int wc, int fr, int fq) const {
        const int row0 = u.pm * 256 + wr * 64 + fr, col0 = u.pn * 128 + wc * 32 + 8 * fq;
#pragma unroll
        for (int ai = 0; ai < 2; ++ai)
#pragma unroll
            for (int m = 0; m < 4; ++m) {
                bf16* rowp = H + (size_t)(row0 + ai * 128 + m * 16) * DFF + col0;
                const pg8::f32x4 g0 = acc[ai][0][m][0], g1 = acc[ai][0][m][1], u0 = acc[ai][1][m][0], u1 = acc[ai][1][m][1];
                pg8::u32x4 w;
                w.x = pg8::cvt_pk_bf16(g0[0] * sigm(g0[0]) * u0[0], g0[1] * sigm(g0[1]) * u0[1]);
                w.y = pg8::cvt_pk_bf16(g0[2] * sigm(g0[2]) * u0[2], g0[3] * sigm(g0[3]) * u0[3]);
                w.z = pg8::cvt_pk_bf16(g1[0] * sigm(g1[0]) * u1[0], g1[1] * sigm(g1[1]) * u1[1]);
                w.w = pg8::cvt_pk_bf16(g1[2] * sigm(g1[2]) * u1[2], g1[3] * sigm(g1[3]) * u1[3]);
                *(pg8::u32x4*)rowp = w;
            }
    }
};
struct EpiRes {
    static constexpr bool PERM = false, AFTER_DRAIN = false;
    const float* inL; const float* inC; float* outL; float* outC; const float* gateL; const float* gateC; float coef;
    __device__ __forceinline__ void operator()(const pg8::f32x4 (&acc)[2][2][4][2], const pg8::Unit& u, int wr, int wc, int fr, int fq) const {
        const bool lat = u.pm < 32;
        const int rl0 = (lat ? u.pm : u.pm - 32) * 256 + wr * 64 + fr, col0 = u.pn * 256 + wc * 32 + 4 * fq;
        const float* in = lat ? inL : inC; float* out = lat ? outL : outC; const float* gate = lat ? gateL : gateC;
        pg8::f32x4 gv[2][2];
#pragma unroll
        for (int bj = 0; bj < 2; ++bj)
#pragma unroll
            for (int n = 0; n < 2; ++n) gv[bj][n] = *(const pg8::f32x4*)(gate + col0 + bj * 128 + n * 16) * coef;
#pragma unroll
        for (int ai = 0; ai < 2; ++ai)
#pragma unroll
            for (int m = 0; m < 4; ++m) {
                const size_t off = (size_t)(rl0 + ai * 128 + m * 16) * DM + col0;
#pragma unroll
                for (int bj = 0; bj < 2; ++bj)
#pragma unroll
                    for (int n = 0; n < 2; ++n) { const pg8::f32x4 xi = *(const pg8::f32x4*)(in + off + bj * 128 + n * 16);
                        *(pg8::f32x4*)(out + off + bj * 128 + n * 16) = xi + gv[bj][n] * acc[ai][bj][m][n]; }
            }
    }
};
struct EpiSlab {
    static constexpr bool PERM = false, AFTER_DRAIN = false;
    float* out; const float* gate; float coef;
    __device__ __forceinline__ void operator()(const pg8::f32x4 (&acc)[2][2][4][2], const pg8::Unit& u, int wr, int wc, int fr, int fq) const {
        const int rl0 = wr * 64 + fr, col0 = u.pn * 256 + wc * 32 + 4 * fq;
        float* o = out + (size_t)u.pm * CTXL * DM;
        pg8::f32x4 gv[2][2];
#pragma unroll
        for (int bj = 0; bj < 2; ++bj)
#pragma unroll
            for (int n = 0; n < 2; ++n) gv[bj][n] = *(const pg8::f32x4*)(gate + col0 + bj * 128 + n * 16) * coef;
#pragma unroll
        for (int ai = 0; ai < 2; ++ai)
#pragma unroll
            for (int m = 0; m < 4; ++m) {
                const size_t off = (size_t)(rl0 + ai * 128 + m * 16) * DM + col0;
#pragma unroll
                for (int bj = 0; bj < 2; ++bj)
#pragma unroll
                    for (int n = 0; n < 2; ++n) *(pg8::f32x4*)(o + off + bj * 128 + n * 16) = gv[bj][n] * acc[ai][bj][m][n];
            }
    }
};
struct EpiB16 {
    static constexpr bool PERM = true, AFTER_DRAIN = false;
    bf16* C; int ldc;
    __device__ __forceinline__ void operator()(const pg8::f32x4 (&acc)[2][2][4][2], const pg8::Unit& u, int wr, int wc, int fr, int fq) const {
        const int row0 = u.pm * 256 + wr * 64 + fr, col0 = u.pn * 256 + wc * 32 + 8 * fq;
#pragma unroll
        for (int ai = 0; ai < 2; ++ai)
#pragma unroll
            for (int m = 0; m < 4; ++m) { bf16* rowp = C + (size_t)(row0 + ai * 128 + m * 16) * ldc + col0;
#pragma unroll
                for (int bj = 0; bj < 2; ++bj) { const pg8::f32x4 v0 = acc[ai][bj][m][0], v1 = acc[ai][bj][m][1]; pg8::u32x4 w;
                    w.x = pg8::cvt_pk_bf16(v0[0], v0[1]); w.y = pg8::cvt_pk_bf16(v0[2], v0[3]); w.z = pg8::cvt_pk_bf16(v1[0], v1[1]); w.w = pg8::cvt_pk_bf16(v1[2], v1[3]);
                    *(pg8::u32x4*)(rowp + bj * 128) = w; } }
    }
};
struct EpiSlabP {
    static constexpr bool PERM = true, AFTER_DRAIN = false;
    float* out; int ldo;
    __device__ __forceinline__ void operator()(const pg8::f32x4 (&acc)[2][2][4][2], const pg8::Unit& u, int wr, int wc, int fr, int fq) const {
        const int row0 = wr * 64 + fr, col0 = u.pn * 256 + wc * 32 + 8 * fq;
        float* o = out + (size_t)u.pm * CTXL * ldo;
#pragma unroll
        for (int ai = 0; ai < 2; ++ai)
#pragma unroll
            for (int m = 0; m < 4; ++m) { float* rowp = o + (size_t)(row0 + ai * 128 + m * 16) * ldo + col0;
#pragma unroll
                for (int bj = 0; bj < 2; ++bj) { *(pg8::f32x4*)(rowp + bj * 128) = acc[ai][bj][m][0]; *(pg8::f32x4*)(rowp + bj * 128 + 4) = acc[ai][bj][m][1]; } }
    }
};
struct EpiF32 {
    static constexpr bool PERM = false, AFTER_DRAIN = false;
    float* C; int ldc;
    __device__ __forceinline__ void operator()(const pg8::f32x4 (&acc)[2][2][4][2], const pg8::Unit& u, int wr, int wc, int fr, int fq) const {
        const int row0 = u.pm * 256 + wr * 64 + fr, col0 = u.pn * 256 + wc * 32 + 4 * fq;
#pragma unroll
        for (int ai = 0; ai < 2; ++ai)
#pragma unroll
            for (int m = 0; m < 4; ++m) { float* rowp = C + (size_t)(row0 + ai * 128 + m * 16) * ldc + col0;
#pragma unroll
                for (int bj = 0; bj < 2; ++bj)
#pragma unroll
                    for (int n = 0; n < 2; ++n) *(pg8::f32x4*)(rowp + bj * 128 + n * 16) = acc[ai][bj][m][n]; }
    }
};
template <int MAP> __device__ __forceinline__ int map_row(int n) {
    if (MAP == 1) { const int bj = n >> 13, r = n & 8191; return 256 * (r >> 7) + 128 * bj + (r & 127); }
    return n;
}
template <int MAP> __device__ __forceinline__ void transpose_item(const float* W, int K, int N, bf16* WT, LAS float* scr, int item, int lane) {
    const int nblk = N >> 6, kb = item / nblk, nb = item - kb * nblk, k0 = kb * 64, n0 = nb * 64;
    const int kr = lane >> 4, nq = lane & 15;
    f32x4 v[16];
#pragma unroll
    for (int i = 0; i < 16; ++i) v[i] = *(const f32x4*)(W + (size_t)(k0 + 4 * i + kr) * N + n0 + 4 * nq);
#pragma unroll
    for (int i = 0; i < 16; ++i) { const int k = 4 * i + kr;
        scr[(4 * nq + 0) * 65 + k] = v[i].x; scr[(4 * nq + 1) * 65 + k] = v[i].y; scr[(4 * nq + 2) * 65 + k] = v[i].z; scr[(4 * nq + 3) * 65 + k] = v[i].w; }
    LDS_WAIT(); asm volatile("" ::: "memory");
    const int c = lane & 7, nl = lane >> 3, r0 = map_row<MAP>(n0);
#pragma unroll
    for (int j = 0; j < 8; ++j) { const int n = nl + 8 * j; const LAS float* s = scr + n * 65 + 8 * c;
        v4u o; o.x = pk2(s[0], s[1]); o.y = pk2(s[2], s[3]); o.z = pk2(s[4], s[5]); o.w = pk2(s[6], s[7]);
        *(v4u*)(WT + (size_t)(r0 + n) * K + k0 + 8 * c) = o; }
    LDS_WAIT(); asm volatile("" ::: "memory");
}

struct Ptrs {
    const float* in[N_IN]; float* out; unsigned char* ws;
};
constexpr int PT_OFF = 151552 + 1024;
__device__ __forceinline__ unsigned long long ld_uptr(LAS unsigned char* lds, int i) {
    const unsigned long long v = *(const LAS unsigned long long*)(lds + PT_OFF + 8 * i);
    const unsigned lo = __builtin_amdgcn_readfirstlane((unsigned)v), hi = __builtin_amdgcn_readfirstlane((unsigned)(v >> 32));
    return ((unsigned long long)hi << 32) | lo;
}
__device__ __forceinline__ Ptrs load_ptrs(LAS unsigned char* lds) {
    asm volatile("" ::: "memory");
    Ptrs P;
#pragma unroll
    for (int i = 0; i < N_IN; ++i) P.in[i] = (const float*)(const GAS float*)ld_uptr(lds, i);
    P.out = (float*)(GAS float*)ld_uptr(lds, N_IN); P.ws = (unsigned char*)(GAS unsigned char*)ld_uptr(lds, N_IN + 1);
    return P;
}

__device__ __forceinline__ void prologue_phase(LAS unsigned char* lds, int vcu, int G, int wave) {
    const Ptrs P = load_ptrs(lds); const int lane = lane_vol(), tid = wave * 64 + lane;
    unsigned char* ws = P.ws;
    {
        LAS float* sil = (LAS float*)lds; LAS float* red = (LAS float*)(lds + 32768);
        for (int i = tid; i < DM; i += NTHR) { const float a = P.in[I_C][i], b = P.in[I_CCTX][i]; sil[i] = a * sigm(a); sil[DM + i] = b * sigm(b); }
        __syncthreads();
        float* MOD = (float*)(ws + WS_MOD);
        for (int u = vcu; u < (BG_CONV ? 2304 : 4608); u += G) {
            const int l = u / 2304, rem = u - l * 2304, nch = rem >> 4, ks = rem & 15;
            const float* W = P.in[I_WMOD] + (size_t)l * DM * NMODC + (size_t)(ks * 256 + wave * 32) * NMODC + nch * 256 + 4 * lane;
            f32x4 a0 = {0.f, 0.f, 0.f, 0.f}, a1 = {0.f, 0.f, 0.f, 0.f};
#pragma unroll
            for (int hb = 0; hb < 2; ++hb) {
                f32x4 wv[16];
#pragma unroll
                for (int kk = 0; kk < 16; ++kk) wv[kk] = *(const f32x4*)(W + (size_t)(hb * 16 + kk) * NMODC);
#pragma unroll
                for (int kk = 0; kk < 16; ++kk) { const int k = ks * 256 + wave * 32 + hb * 16 + kk; const float s0 = sil[k], s1 = sil[DM + k]; a0 += wv[kk] * s0; a1 += wv[kk] * s1; }
            }
            *(LAS f32x4*)(red + wave * 512 + 4 * lane) = a0; *(LAS f32x4*)(red + wave * 512 + 256 + 4 * lane) = a1;
            __syncthreads();
            { const int w = tid >> 8, col = tid & 255; float s = 0.f;
#pragma unroll
              for (int q = 0; q < 8; ++q) s += red[q * 512 + w * 256 + col];
              if (ks == 0) s += P.in[I_BMOD][l * NMODC + nch * 256 + col];
              atomicAdd(MOD + (size_t)(l * 2 + w) * NMODC + nch * 256 + col, s); }
            __syncthreads();
        }
    }
    {
        LAS float* scr = (LAS float*)(lds + wave * 16640);
        const int gw = vcu * NWAVES + wave, NGW = G * NWAVES;
        constexpr int I_FI = 64 * 256, I_FO = 128 * 64, I_IN = 64 * 128, I_OUT = 64 * 64, I_Q = 16 * 48, I_KV = 8 * 64;
        constexpr int PER_L = 2 * I_FI + 2 * I_FO + I_IN + I_OUT + I_Q + I_KV;
        for (int it = gw; it < (BG_CONV ? 1 : 2) * PER_L; it += NGW) {
            const int l = it / PER_L; int r = it - l * PER_L;
            if (r < 2 * I_FI) { const int f = r / I_FI; r -= f * I_FI;
                transpose_item<1>(P.in[I_FWI] + (size_t)(l * 2 + f) * DM * 16384, DM, 16384, (bf16*)(ws + WS_WFI + (size_t)(l * 2 + f) * SZ_WFI), scr, r, lane); continue; } r -= 2 * I_FI;
            if (r < 2 * I_FO) { const int f = r / I_FO; r -= f * I_FO;
                transpose_item<0>(P.in[I_FWO] + (size_t)(l * 2 + f) * DFF * DM, DFF, DM, (bf16*)(ws + WS_WFO + (size_t)(l * 2 + f) * SZ_WFO), scr, r, lane); continue; } r -= 2 * I_FO;
            if (r < I_IN) { transpose_item<0>(P.in[I_WIN] + (size_t)l * DM * ZC, DM, ZC, (bf16*)(ws + WS_WIN + (size_t)l * SZ_WIN), scr, r, lane); continue; } r -= I_IN;
            if (r < I_OUT) { transpose_item<0>(P.in[I_WOUT] + (size_t)l * DM * DM, DM, DM, (bf16*)(ws + WS_WOUT + (size_t)l * SZ_WOUT), scr, r, lane); continue; } r -= I_OUT;
            if (r < I_Q) { transpose_item<0>(P.in[I_QUP] + (size_t)l * 1024 * 3072, 1024, 3072, (bf16*)(ws + WS_WQ + (size_t)l * SZ_WQ), scr, r, lane); continue; } r -= I_Q;
            transpose_item<0>(P.in[I_KVUP] + (size_t)l * 512 * 4096, 512, 4096, (bf16*)(ws + WS_WKV + (size_t)l * SZ_WKV), scr, r, lane);
        }
        const int gt = vcu * NTHR + tid, NGT = G * NTHR;
        for (int it = gt; it < 2 * 10240 * 64; it += NGT) {
            const int l = it / (10240 * 64), r = it - l * (10240 * 64), k8 = r / 10240, n = r - k8 * 10240;
            float v[8];
            if (n < 8192) {
                const bool isA = n >= 4096; const int d = (n >> 11) & 1, ch = n & 2047;
                const float* src = (isA ? P.in[I_AUP] : P.in[I_WUP]) + (size_t)(l * 2 + d) * 96 * RWW + ch;
#pragma unroll
                for (int j = 0; j < 8; ++j) { const int k = 8 * k8 + j - (isA ? 96 : 0); const bool ok_ = (k >= 0 && k < 96); const float t_ = src[(size_t)(ok_ ? k : 0) * RWW]; v[j] = ok_ ? t_ : 0.f; }
            } else {
                const int ch = n - 8192; const float* src = P.in[I_GUP] + (size_t)l * 256 * RWW + ch;
#pragma unroll
                for (int j = 0; j < 8; ++j) { const int k = 8 * k8 + j - 256; const bool ok_ = (k >= 0); const float t_ = src[(size_t)(ok_ ? k : 0) * RWW]; v[j] = ok_ ? t_ : 0.f; }
            }
            v4u o; o.x = pk2(v[0], v[1]); o.y = pk2(v[2], v[3]); o.z = pk2(v[4], v[5]); o.w = pk2(v[6], v[7]);
            *(v4u*)((bf16*)(ws + WS_WWA + (size_t)l * SZ_WWA) + (size_t)n * 512 + 8 * k8) = o;
        }
    }
}

__device__ __forceinline__ void prep_phase(LAS unsigned char* lds, const float* srcL, const float* srcC, int nrows, const float* g, const float* modL, const float* modC, int jm,
                                           bf16* XN, int gw, int NGW, int wave, const float* accC = nullptr, float* wbC = nullptr) {
    int lane = lane_vol(); const int tid = wave * 64 + lane;
    LAS float* gsL = (LAS float*)lds; LAS float* shL = gsL + DM; LAS float* gsC = shL + DM; LAS float* shC = gsC + DM;
    for (int i = tid; i < DM; i += NTHR) { const float gg = g[i];
        gsL[i] = gg * (1.f + modL[(jm + 1) * DM + i]); shL[i] = modL[jm * DM + i]; gsC[i] = gg * (1.f + modC[(jm + 1) * DM + i]); shC[i] = modC[jm * DM + i]; }
    __syncthreads();
    for (int row = gw; row < (nrows < SEQ ? nrows : SEQ); row += NGW) {
        asm volatile("" : "+v"(lane));
        const bool lat = row < SEQ;
        const f32x4* xr = (const f32x4*)(lat ? srcL + (size_t)row * DM : srcC + (size_t)(row - SEQ) * DM) + lane;
        const LAS float* gs = lat ? gsL : gsC; const LAS float* sh = lat ? shL : shC;
        f32x4 v[16]; float ss = 0.f;
#pragma unroll
        for (int j = 0; j < 16; ++j) { v[j] = xr[64 * j]; ss += dot4(v[j], v[j]); }
        const float rstd = 1.0f / sqrtf(wave_sum(ss) * (1.f / DM) + 1e-6f);
        u32x2* o = (u32x2*)(XN + (size_t)row * DM) + lane;
#pragma unroll
        for (int j = 0; j < 16; ++j) { const int c = 4 * (lane + 64 * j); const f32x4 g4 = *(const LAS f32x4*)(gs + c), s4 = *(const LAS f32x4*)(sh + c);
            o[64 * j] = pk4(v[j] * rstd * g4 + s4); }
    }
    if (nrows > SEQ) {
        LAS float* red = (LAS float*)(lds + 65536);
        for (int s = gw >> 3; s < CTXL; s += NGW >> 3) {
            asm volatile("" : "+v"(lane));
            const int c0 = wave * 512 + 4 * lane;
            const float* xr = srcC + (size_t)s * DM + c0;
            f32x4 v0 = *(const f32x4*)xr, v1 = *(const f32x4*)(xr + 256);
            if (accC != nullptr) {
#pragma unroll
                for (int sl = 0; sl < SK_NS; ++sl) { const float* a = accC + ((size_t)sl * CTXL + s) * DM + c0; v0 += *(const f32x4*)a; v1 += *(const f32x4*)(a + 256); }
                *(f32x4*)(wbC + (size_t)s * DM + c0) = v0; *(f32x4*)(wbC + (size_t)s * DM + c0 + 256) = v1;
            }
            const float ssw = wave_sum(dot4(v0, v0) + dot4(v1, v1));
            __syncthreads();
            if (lane == 0) red[wave] = ssw;
            __syncthreads();
            float tot = 0.f;
#pragma unroll
            for (int w = 0; w < NWAVES; ++w) tot += red[w];
            const float rstd = 1.0f / sqrtf(tot * (1.f / DM) + 1e-6f);
            bf16* o = XN + (size_t)(SEQ + s) * DM + c0;
            *(u32x2*)o = pk4(v0 * rstd * *(const LAS f32x4*)(gsC + c0) + *(const LAS f32x4*)(shC + c0));
            *(u32x2*)(o + 256) = pk4(v1 * rstd * *(const LAS f32x4*)(gsC + c0 + 256) + *(const LAS f32x4*)(shC + c0 + 256));
        }
    }
    __syncthreads();
}

__device__ __forceinline__ void ctx_reduce_z(const Ptrs& P, int vcu, int G, int wave) {
    int lane = lane_vol(); unsigned char* ws = P.ws;
    const float* slab = (const float*)(ws + WS_SLB); bf16* Z = (bf16*)(ws + WS_Z);
    for (int s = vcu; s < CTXL; s += G) {
        asm volatile("" : "+v"(lane));
#pragma unroll
        for (int j = 0; j < 4; ++j) { const int c = wave * 1024 + 256 * j + 4 * lane; f32x4 a = {0.f, 0.f, 0.f, 0.f};
#pragma unroll
            for (int sl = 0; sl < 4; ++sl) a += *(const f32x4*)(slab + ((size_t)sl * CTXL + s) * ZC + c);
            *(u32x2*)(Z + (size_t)(SEQ + s) * ZC + c) = pk4(a); }
    }
}

__device__ __forceinline__ void streams_phase(const Ptrs& P, int l, int gw, int NGW) {
    int lane = lane_vol();
    unsigned char* ws = P.ws;
    const bf16* Z = (const bf16*)(ws + WS_Z); bf16* SS = (bf16*)(ws + WS_SS); bf16* VV = (bf16*)(ws + WS_VV); bf16* KT = (bf16*)(ws + WS_KT);
    bf16* LWA = (bf16*)(ws + WS_LWA); bf16* QL = (bf16*)(ws + WS_QL); bf16* KVL = (bf16*)(ws + WS_KVL);
    const float* mu = P.in[I_MU] + l * RWCOLS; const float* k_k = P.in[I_KK] + l * RWW; const float* qn = P.in[I_QNORM] + l * 1024; const float* kvn = P.in[I_KVNORM] + l * 512;
    for (int row = gw; row < MROWS; row += NGW) {
        asm volatile("" : "+v"(lane));
        int nb0, nb1, nb2, nb3; bool ok0, ok1, ok2, ok3;
        if (row < SEQ) { const int gr = row >> 6, gc = row & 63; nb0 = row - 1; ok0 = gc > 0; nb1 = row + 1; ok1 = gc < 63; nb2 = row - 64; ok2 = gr > 0; nb3 = row + 64; ok3 = gr < 127; }
        else { const int s = row - SEQ; nb0 = nb1 = row - 1; ok0 = ok1 = s > 0; nb2 = nb3 = row + 1; ok2 = ok3 = s < CTXL - 1; }
        const bf16* zr = Z + (size_t)row * ZC;
#pragma unroll
        for (int i = 0; i < 26; ++i) {
            const int c4 = lane + 64 * i, c = 4 * c4;
            if (i < 25 || lane < 48) {
                const int q = (c4 >= 412) + (c4 >= 824) + (c4 >= 1236);
                const int nrow = q == 0 ? nb0 : q == 1 ? nb1 : q == 2 ? nb2 : nb3; const bool nok = q == 0 ? ok0 : q == 1 ? ok1 : q == 2 ? ok2 : ok3;
                const f32x4 z = ubf4(*(const u32x2*)(zr + c));
                u32x2 znr = *(const u32x2*)(Z + (size_t)(nok ? nrow : row) * ZC + c); if (!nok) { znr.x = 0u; znr.y = 0u; }
                const f32x4 zn = ubf4(znr);
                const f32x4 zs = z + (zn - z) * *(const f32x4*)(mu + c);
                if (i < 8) { const int h = c >> 6, e = c & 63; *(u32x2*)(SS + ((size_t)(row * 32 + h) * 2) * 64 + e) = pk4(zs); }
                else if (i < 16) { const int ch = c - 2048, h = ch >> 6, e = ch & 63; *(u32x2*)(KT + (size_t)row * RWW + ch) = pk4(zs);
                    const f32x4 kr = zs * *(const f32x4*)(k_k + ch); const float ss = sum16(dot4(kr, kr)); const float inv = 1.f / fmaxf(sqrtf(ss), 1e-12f);
                    *(u32x2*)(SS + ((size_t)(row * 32 + h) * 2 + 1) * 64 + e) = pk4(kr * inv); }
                else if (i < 24) { *(u32x2*)(VV + (size_t)row * RWW + (c - 4096)) = pk4(zs); }
                else if (i == 24) {
                    if (lane < 24) { f32x4 t;
#pragma unroll
                        for (int j = 0; j < 4; ++j) t[j] = 1.f - 2.f * __builtin_amdgcn_rcpf(1.f + __builtin_amdgcn_exp2f(2.885390081777927f * zs[j]));
                        *(u32x2*)(LWA + (size_t)row * 512 + 4 * lane) = pk4(t); }
                    else if (lane < 48) { *(u32x2*)(LWA + (size_t)row * 512 + 96 + 4 * (lane - 24)) = pk4(zs); }
                    else { f32x4 t;
#pragma unroll
                        for (int j = 0; j < 4; ++j) t[j] = sigm(zs[j]);
                        *(u32x2*)(LWA + (size_t)row * 512 + 256 + 4 * (lane - 48)) = pk4(t); }
                } else { f32x4 t;
#pragma unroll
                    for (int j = 0; j < 4; ++j) t[j] = sigm(zs[j]);
                    *(u32x2*)(LWA + (size_t)row * 512 + 256 + 64 + 4 * lane) = pk4(t); }
            }
        }
        if (lane < 16) { unsigned z0 = 0u; asm volatile("" : "+v"(z0)); u32x2 zz; zz.x = z0; zz.y = z0; *(u32x2*)(LWA + (size_t)row * 512 + 192 + 4 * lane) = zz; }
        { f32x4 v[4]; float ss = 0.f;
#pragma unroll
          for (int j = 0; j < 4; ++j) { v[j] = ubf4(*(const u32x2*)(zr + RWCOLS + 4 * (lane + 64 * j))); ss += dot4(v[j], v[j]); }
          const float rstd = 1.0f / sqrtf(wave_sum(ss) * (1.f / 1024.f) + 1e-6f);
#pragma unroll
          for (int j = 0; j < 4; ++j) { const int c = 4 * (lane + 64 * j); *(u32x2*)(QL + (size_t)row * 1024 + c) = pk4(v[j] * rstd * *(const f32x4*)(qn + c)); } }
        { f32x4 v[2]; float ss = 0.f;
#pragma unroll
          for (int j = 0; j < 2; ++j) { v[j] = ubf4(*(const u32x2*)(zr + RWCOLS + 1024 + 4 * (lane + 64 * j))); ss += dot4(v[j], v[j]); }
          const float rstd = 1.0f / sqrtf(wave_sum(ss) * (1.f / 512.f) + 1e-6f);
#pragma unroll
          for (int j = 0; j < 2; ++j) { const int c = 4 * (lane + 64 * j); *(u32x2*)(KVL + (size_t)row * 512 + c) = pk4(v[j] * rstd * *(const f32x4*)(kvn + c)); } }
    }
}

#ifndef QKN_ST
#define QKN_ST 1
#endif
#ifndef QKN_VST
#define QKN_VST 1
#endif
__device__ __forceinline__ void qknorm_phase(const Ptrs& P, int l, int gw, int NGW) {
    const int lane = lane_vol();
    unsigned char* ws = P.ws;
    const bf16* Z = (const bf16*)(ws + WS_Z); const bf16* QF = (const bf16*)(ws + WS_QF); const bf16* KVF = (const bf16*)(ws + WS_KVF);
    bf16* QB = (bf16*)(ws + WS_QB); bf16* KB = (bf16*)(ws + WS_KB); bf16* VB = (bf16*)(ws + WS_VB);
    const float* qg = P.in[I_QGAIN] + l * 192; const float* kg = P.in[I_KGAIN] + l * 192;
    const int lc = lane < 48 ? lane : 47, l32 = lane < 32 ? lane : 31;
    const f32x4 qg4 = *(const f32x4*)(qg + 4 * lc), kg4 = *(const f32x4*)(kg + 4 * lc);
    const int rl = lane - 32, ax = (rl >> 3) & 1, hf = (rl >> 2) & 1, f0 = 4 * (lane & 3);
    const bool rot = lane >= 32 && lane < 48;
    for (int it = gw; it < MROWS * 4; it += NGW) {
        const int row = it >> 2, h0 = (it & 3) * 4; const bool lat = row < SEQ;
        f32x4 cs = {1.f, 1.f, 1.f, 1.f}, sn = {0.f, 0.f, 0.f, 0.f};
        if (lat && rot) { const float pos = (float)(ax == 0 ? (row >> 6) : (row & 63));
#pragma unroll
            for (int j = 0; j < 4; ++j) { const float inv = exp2f(-(float)(f0 + j) * (13.287712379549449f / 16.f)); const float ang = pos * inv; cs[j] = cosf(ang); sn[j] = sinf(ang); } }
        u32x2 krr = *(const u32x2*)(Z + (size_t)row * ZC + 8128 + 4 * (rot ? rl : 0)); if (!rot) { krr.x = 0u; krr.y = 0u; }
        const f32x4 kr4 = ubf4(krr);
        const float ssr = wave_sum(rot ? dot4(kr4, kr4) : 0.f);
#pragma unroll
        for (int hh = 0; hh < 4; ++hh) {
            const int h = h0 + hh;
            u32x2 qq = *(const u32x2*)(QF + (size_t)row * 3072 + h * 192 + 4 * lc); if (lane >= 48) { qq.x = 0u; qq.y = 0u; }
            const f32x4 q4 = ubf4(qq);
            { const float ss = wave_sum(dot4(q4, q4)); const float rstd = 1.0f / sqrtf(ss * (1.f / 192.f) + 1e-6f);
              f32x4 x = q4 * rstd * qg4; f32x4 o;
#pragma unroll
              for (int j = 0; j < 4; ++j) o[j] = __shfl_xor(x[j], 4);
              if (lat && rot) { if (hf == 0) x = x * cs - o * sn; else x = o * sn + x * cs; }
              if (QKN_ST && lane < 48) *(u32x2*)(QB + (size_t)row * 3072 + h * 192 + 4 * lane) = pk4(x); }
            const u32x2 kq2 = *(const u32x2*)(KVF + (size_t)row * 4096 + h * 256 + 4 * l32);
            const f32x4 k4 = (lane < 32) ? ubf4(kq2) : kr4;
            { const float ss = wave_sum(lane < 32 ? dot4(k4, k4) : 0.f) + ssr; const float rstd = 1.0f / sqrtf(ss * (1.f / 192.f) + 1e-6f);
              f32x4 x = k4 * rstd * kg4; f32x4 o;
#pragma unroll
              for (int j = 0; j < 4; ++j) o[j] = __shfl_xor(x[j], 4);
              if (lat && rot) { if (hf == 0) x = x * cs - o * sn; else x = o * sn + x * cs; }
              if (QKN_ST && lane < 48) *(u32x2*)(KB + (size_t)row * 3072 + h * 192 + 4 * lane) = pk4(x); }
            { const u32x2 vv2 = *(const u32x2*)(KVF + (size_t)row * 4096 + h * 256 + 128 + 4 * l32); if (QKN_VST && lane < 32) *(u32x2*)(VB + (size_t)row * 2048 + h * 128 + 4 * lane) = vv2; }
        }
    }
}

__device__ __forceinline__ void rwkvout_phase(const Ptrs& P, int l, int row0, int nrows, int gw, int NGW) {
    int lane = lane_vol();
    unsigned char* ws = P.ws;
    const float* Y = (const float*)(ws + WS_Y); const bf16* SS = (const bf16*)(ws + WS_SS); const bf16* LW = (const bf16*)(ws + WS_LW); const bf16* VV = (const bf16*)(ws + WS_VV);
    const bf16* KT = (const bf16*)(ws + WS_KT); bf16* OC = (bf16*)(ws + WS_OC);
    const float* lnw = P.in[I_LNW] + l * RWW; const float* lnb = P.in[I_LNB] + l * RWW; const float* rk = P.in[I_RK] + l * RWW;
    const float* a0 = P.in[I_A0] + (size_t)l * 2 * RWW; const float* k_a = P.in[I_KA] + (size_t)l * RWW;
    for (int row = row0 + gw; row < nrows; row += NGW) {
        asm volatile("" : "+v"(lane));
#pragma unroll
        for (int i = 0; i < 8; ++i) {
            const int c = 4 * (lane + 64 * i), h = c >> 6, e = c & 63;
            const f32x4 y = *(const f32x4*)(Y + (size_t)row * RWW + c) + *(const f32x4*)(Y + (size_t)(MROWS + row) * RWW + c);
            const float mean = sum16((y.x + y.y) + (y.z + y.w)) * (1.f / 64.f);
            const f32x4 dlt = y - mean; const float var = sum16(dot4(dlt, dlt)) * (1.f / 64.f);
            const float rstd = 1.0f / sqrtf(var + 64e-5f);
            f32x4 o = dlt * rstd * *(const f32x4*)(lnw + c) + *(const f32x4*)(lnb + c);
            const f32x4 r4 = ubf4(*(const u32x2*)(SS + ((size_t)(row * 32 + h) * 2) * 64 + e));
            const f32x4 al0 = ubf4(*(const u32x2*)(LW + (size_t)row * 10240 + 4096 + c)) + *(const f32x4*)(a0 + c), al1 = ubf4(*(const u32x2*)(LW + (size_t)row * 10240 + 6144 + c)) + *(const f32x4*)(a0 + RWW + c);
            f32x4 am;
#pragma unroll
            for (int j = 0; j < 4; ++j) am[j] = 0.5f * (sigm(al0[j]) + sigm(al1[j]));
            const f32x4 kdm = ubf4(*(const u32x2*)(KT + (size_t)row * RWW + c)) * (1.f + (am - 1.f) * *(const f32x4*)(k_a + c));
            const float bs = sum16(dot4(r4 * kdm, *(const f32x4*)(rk + c)));
            o = (o + ubf4(*(const u32x2*)(VV + (size_t)row * RWW + c)) * bs) * ubf4(*(const u32x2*)(LW + (size_t)row * 10240 + 8192 + c));
            *(u32x2*)(OC + (size_t)row * DM + c) = pk4(o);
        }
    }
}

constexpr int BGQ_FI = 512 * 256, BGQ_FO = 1024 * 64, BGQ_IN = 512 * 128, BGQ_OUT = 512 * 64, BGQ_Q = 128 * 48, BGQ_KV = 64 * 64;
constexpr int BGQ_TOTAL = 2 * BGQ_FI + 2 * BGQ_FO + BGQ_IN + BGQ_OUT + BGQ_Q + BGQ_KV;
constexpr int BGQ_PER_WAVE = BGQ_TOTAL / 512;
static_assert(BGQ_PER_WAVE * 512 == BGQ_TOTAL && BGQ_PER_WAVE % 4 == 0 && BGQ_PER_WAVE / 4 <= MROWS / 32, "background quanta per loader wave");
struct BgQ { const float* src; bf16* dst; int N; };
__device__ __forceinline__ BgQ bg_decode(const Ptrs& P, int t, int lane) {
    unsigned char* ws = P.ws; const float* W; bf16* WT; int K, N, map = 0; constexpr int l = 1;
    if (t < 2 * BGQ_FI) { const int f = t / BGQ_FI; t -= f * BGQ_FI; W = P.in[I_FWI] + (size_t)(l * 2 + f) * DM * 16384; WT = (bf16*)(ws + WS_WFI + (size_t)(l * 2 + f) * SZ_WFI); K = DM; N = 16384; map = 1; }
    else if ((t -= 2 * BGQ_FI) < 2 * BGQ_FO) { const int f = t / BGQ_FO; t -= f * BGQ_FO; W = P.in[I_FWO] + (size_t)(l * 2 + f) * DFF * DM; WT = (bf16*)(ws + WS_WFO + (size_t)(l * 2 + f) * SZ_WFO); K = DFF; N = DM; }
    else if ((t -= 2 * BGQ_FO) < BGQ_IN) { W = P.in[I_WIN] + (size_t)l * DM * ZC; WT = (bf16*)(ws + WS_WIN + (size_t)l * SZ_WIN); K = DM; N = ZC; }
    else if ((t -= BGQ_IN) < BGQ_OUT) { W = P.in[I_WOUT] + (size_t)l * DM * DM; WT = (bf16*)(ws + WS_WOUT + (size_t)l * SZ_WOUT); K = DM; N = DM; }
    else if ((t -= BGQ_OUT) < BGQ_Q) { W = P.in[I_QUP] + (size_t)l * 1024 * 3072; WT = (bf16*)(ws + WS_WQ + (size_t)l * SZ_WQ); K = 1024; N = 3072; }
    else { t -= BGQ_Q; W = P.in[I_KVUP] + (size_t)l * 512 * 4096; WT = (bf16*)(ws + WS_WKV + (size_t)l * SZ_WKV); K = 512; N = 4096; }
    const int nk8 = K >> 3, nq = t / nk8, kq = t - nq * nk8, n = 64 * nq + lane;
    const int row = map ? map_row<1>(n) : n;
    BgQ q; q.src = W + (size_t)(8 * kq) * N + n; q.dst = WT + (size_t)row * K + 8 * kq; q.N = N; return q;
}

template <int CTRL> __device__ __forceinline__ float dpp_add(float x) { return x + __int_as_float(__builtin_amdgcn_update_dpp(0, __float_as_int(x), CTRL, 0xf, 0xf, true)); }
__device__ __forceinline__ float red16(float x) { x = dpp_add<0xB1>(x); x = dpp_add<0x4E>(x); x = dpp_add<0x141>(x); x = dpp_add<0x140>(x); return x; }
constexpr int SCAN_TC = 32, SCAN_STEP_B = 1424, SCAN_BUF = SCAN_TC * SCAN_STEP_B;
__device__ __forceinline__ void scan_phase(const Ptrs& P, int l, LAS unsigned char* lds, int vcu, int wave) {
    const int lane = lane_vol();
    if (vcu >= 128) return;
    const int h = vcu >> 2, d = (vcu >> 1) & 1, half = vcu & 1;
    unsigned char* ws = P.ws;
    const bf16* LW = (const bf16*)(ws + WS_LW); const bf16* SS = (const bf16*)(ws + WS_SS); const bf16* VV = (const bf16*)(ws + WS_VV); const bf16* KT = (const bf16*)(ws + WS_KT); float* Y = (float*)(ws + WS_Y);
    LAS float* ybuf = (LAS float*)(lds + 2 * SCAN_BUF);
    constexpr int NCH = MROWS / SCAN_TC;
    typedef float f32x2s __attribute__((ext_vector_type(2)));
#define rowof(tau) (d == 0 ? ((tau) < CTXL ? SEQ + (tau) : (tau) - CTXL) : (MROWS - 1 - (tau)))
    if (wave >= 4) {
        const int tl = (wave - 4) * 64 + lane;
        const int le = 4 * (tl & 15);
        const float* cw = P.in[I_W0] + (size_t)(l * 2 + d) * RWW + h * 64 + le; const float* ca = P.in[I_A0] + (size_t)(l * 2 + d) * RWW + h * 64 + le; const float* ck = P.in[I_KA] + (size_t)l * RWW + h * 64 + le;
        const f32x4 bw = *(const f32x4*)cw, ba = *(const f32x4*)ca, ka = *(const f32x4*)ck;
        u32x2 sr[2][5]; u32x2 svr;
#define LD_CHUNK(ci) do { _Pragma("unroll") for (int j_ = 0; j_ < 2; ++j_) { const int ls_ = (tl >> 4) + 16 * j_; const int row_ = rowof((ci) * SCAN_TC + ls_); const bf16* lw_ = LW + (size_t)row_ * 10240 + d * RWW + h * 64 + le; \
            sr[j_][0] = *(const u32x2*)(lw_); sr[j_][1] = *(const u32x2*)(lw_ + 4096); sr[j_][2] = *(const u32x2*)(KT + (size_t)row_ * RWW + h * 64 + le); \
            sr[j_][3] = *(const u32x2*)(SS + ((size_t)(row_ * 32 + h) * 2 + 1) * 64 + le); sr[j_][4] = *(const u32x2*)(SS + ((size_t)(row_ * 32 + h) * 2) * 64 + le); } \
          { const int row2_ = rowof((ci) * SCAN_TC + (tl >> 3)); svr = *(const u32x2*)(VV + (size_t)row2_ * RWW + h * 64 + 32 * half + 4 * (tl & 7)); } } while (0)
#define ST_CHUNK(b) do { _Pragma("unroll") for (int j_ = 0; j_ < 2; ++j_) { const int ls_ = (tl >> 4) + 16 * j_; LAS unsigned char* rec_ = lds + (b) * SCAN_BUF + ls_ * SCAN_STEP_B + le * 4; f32x4 w_, kd_, kka_; \
            f32x4 st[5]; _Pragma("unroll") for (int v_ = 0; v_ < 5; ++v_) st[v_] = ubf4(sr[j_][v_]); \
            _Pragma("unroll") for (int q_ = 0; q_ < 4; ++q_) { w_[q_] = __builtin_amdgcn_exp2f(-0.60653065971263342f * 1.4426950408889634f * sigm(st[0][q_] + bw[q_])); \
                const float a_ = sigm(st[1][q_] + ba[q_]); kd_[q_] = st[2][q_] * (1.f + (a_ - 1.f) * ka[q_]); kka_[q_] = st[3][q_] * a_; } \
            const float c1_ = red16(dot4(kka_, st[4])), c2_ = red16(dot4(kd_, st[4])); \
            *(LAS f32x4*)(rec_) = w_; *(LAS f32x4*)(rec_ + 256) = kd_; *(LAS f32x4*)(rec_ + 512) = kka_; *(LAS f32x4*)(rec_ + 768) = w_ * st[4]; *(LAS f32x4*)(rec_ + 1024) = st[3]; \
            if ((tl & 15) == 0) *(LAS f32x2s*)(lds + (b) * SCAN_BUF + ls_ * SCAN_STEP_B + 1408) = (f32x2s){c1_, c2_}; } \
          *(LAS f32x4*)(lds + (b) * SCAN_BUF + (tl >> 3) * SCAN_STEP_B + 1280 + 16 * (tl & 7)) = ubf4(svr); } while (0)
#define Y_OUT(ci) do { const int s_ = tl >> 3, j_ = tl & 7; const int row_ = rowof((ci) * SCAN_TC + s_); \
            *(f32x4*)(Y + (size_t)(d * MROWS + row_) * RWW + h * 64 + 32 * half + 4 * j_) = *(const LAS f32x4*)(ybuf + ((ci) & 1) * 1024 + s_ * 32 + 4 * j_); } while (0)
        const bool bg_on = BG_CONV && (l == 0);
        const int bq0 = (vcu * 4 + (wave - 4)) * BGQ_PER_WAVE;
        float bgr[4][8]; bf16* bg_dst = nullptr;
#define BG_ISSUE(g) do { if (bg_on && (g) < BGQ_PER_WAVE / 4) { const BgQ b_ = bg_decode(P, bq0 + 4 * (g), lane); bg_dst = b_.dst; \
            _Pragma("unroll") for (int q_ = 0; q_ < 4; ++q_) _Pragma("unroll") for (int j_ = 0; j_ < 8; ++j_) bgr[q_][j_] = b_.src[(size_t)(8 * q_ + j_) * b_.N]; } } while (0)
#define BG_FLUSH(g) do { if (bg_on && (g) >= 0 && (g) < BGQ_PER_WAVE / 4) { _Pragma("unroll") for (int q_ = 0; q_ < 4; ++q_) { \
            v4u o_; o_.x = pg8::cvt_pk_bf16(bgr[q_][0], bgr[q_][1]); o_.y = pg8::cvt_pk_bf16(bgr[q_][2], bgr[q_][3]); o_.z = pg8::cvt_pk_bf16(bgr[q_][4], bgr[q_][5]); o_.w = pg8::cvt_pk_bf16(bgr[q_][6], bgr[q_][7]); \
            *(v4u*)(bg_dst + 8 * q_) = o_; } } } while (0)
        const int gv_lw = vcu * 4 + (wave - 4);
        f32x4 gvr[8]; f32x4 gva0 = {0.f, 0.f, 0.f, 0.f}, gva1 = {0.f, 0.f, 0.f, 0.f};
#define GV_ISSUE(g) do { if (bg_on && (g) < 144) { const int u_ = gv_lw + 512 * ((g) >> 4), nch_ = u_ >> 5, ks_ = u_ & 31; \
            const float* w_ = P.in[I_WMOD] + (size_t)DM * NMODC + (size_t)(128 * ks_ + 8 * ((g) & 15)) * NMODC + 256 * nch_ + 4 * lane; \
            _Pragma("unroll") for (int j_ = 0; j_ < 8; ++j_) gvr[j_] = *(const f32x4*)(w_ + (size_t)j_ * NMODC); } } while (0)
#define GV_ACC(g) do { if (bg_on && (g) >= 0 && (g) < 144) { const int u_ = gv_lw + 512 * ((g) >> 4), nch_ = u_ >> 5, ks_ = u_ & 31; const int k0_ = 128 * ks_ + 8 * ((g) & 15); \
            _Pragma("unroll") for (int j_ = 0; j_ < 8; ++j_) { const float a_ = P.in[I_C][k0_ + j_], b_ = P.in[I_CCTX][k0_ + j_]; gva0 += gvr[j_] * (a_ * sigm(a_)); gva1 += gvr[j_] * (b_ * sigm(b_)); } \
            if (((g) & 15) == 15) { float* mo_ = (float*)(ws + WS_MOD) + (size_t)2 * NMODC + 256 * nch_ + 4 * lane; \
                if (ks_ == 0) { const f32x4 bb_ = *(const f32x4*)(P.in[I_BMOD] + NMODC + 256 * nch_ + 4 * lane); gva0 += bb_; gva1 += bb_; } \
                _Pragma("unroll") for (int j_ = 0; j_ < 4; ++j_) { atomicAdd(mo_ + j_, gva0[j_]); atomicAdd(mo_ + NMODC + j_, gva1[j_]); } \
                gva0 = (f32x4){0.f, 0.f, 0.f, 0.f}; gva1 = (f32x4){0.f, 0.f, 0.f, 0.f}; } } } while (0)
        LD_CHUNK(0); ST_CHUNK(0); LD_CHUNK(1);
        __syncthreads();
        for (int ci = 0; ci < NCH; ++ci) {
            if (ci > 0) Y_OUT(ci - 1);
            if (ci + 1 < NCH) ST_CHUNK((ci + 1) & 1);
            BG_FLUSH(ci - 1); GV_ACC(ci - 1);
            if (ci + 2 < NCH) LD_CHUNK(ci + 2);
            BG_ISSUE(ci); GV_ISSUE(ci);
            __syncthreads();
        }
        Y_OUT(NCH - 1);
        BG_FLUSH(NCH - 1);
#undef GV_ISSUE
#undef GV_ACC
#undef BG_ISSUE
#undef BG_FLUSH
#undef LD_CHUNK
#undef ST_CHUNK
#undef Y_OUT
    } else {
        const int kc = lane & 7, rl = wave * 8 + (lane >> 3);
        f32x2s Sa = {0.f, 0.f}, Sb = {0.f, 0.f}, Sc = {0.f, 0.f}, Sd = {0.f, 0.f};
        __syncthreads();
        for (int ci = 0; ci < NCH; ++ci) {
            const LAS unsigned char* buf = lds + (ci & 1) * SCAN_BUF + kc * 32;
            const LAS unsigned char* vbuf = lds + (ci & 1) * SCAN_BUF + 1280 + rl * 4;
            const LAS unsigned char* cbase = lds + (ci & 1) * SCAN_BUF + 1408;
            float ys0 = 0.f, ys1 = 0.f, ys2 = 0.f, ys3 = 0.f;
#define LDV(dst0, dst1, off, sb_) dst0 = *(const LAS f32x4*)((sb_) + (off)); dst1 = *(const LAS f32x4*)((sb_) + (off) + 16)
            f32x4 w0, w1, d0, d1, a0, a1, r0, r1, k0, k1; float vv; f32x2s cc;
            LDV(w0, w1, 0, buf); LDV(d0, d1, 256, buf); LDV(a0, a1, 512, buf); LDV(r0, r1, 768, buf); LDV(k0, k1, 1024, buf); vv = *(const LAS float*)(vbuf); cc = *(const LAS f32x2s*)(cbase);
#pragma unroll
            for (int s = 0; s < SCAN_TC; ++s) {
                f32x4 w0n = w0, w1n = w1, d0n = d0, d1n = d1, a0n = a0, a1n = a1, r0n = r0, r1n = r1, k0n = k0, k1n = k1; float vvn = vv; f32x2s ccn = cc;
                if (s + 1 < SCAN_TC) { const LAS unsigned char* sb = buf + (s + 1) * SCAN_STEP_B;
                    LDV(w0n, w1n, 0, sb); LDV(d0n, d1n, 256, sb); LDV(a0n, a1n, 512, sb); LDV(r0n, r1n, 768, sb); LDV(k0n, k1n, 1024, sb);
                    vvn = *(const LAS float*)(vbuf + (s + 1) * SCAN_STEP_B); ccn = *(const LAS f32x2s*)(cbase + (s + 1) * SCAN_STEP_B); }
#define LO(v) ((f32x2s){(v).x, (v).y})
#define HI(v) ((f32x2s){(v).z, (v).w})
                const f32x2s pa = (Sa * LO(k0) + Sb * HI(k0)) + (Sc * LO(k1) + Sd * HI(k1)), pb = (Sa * LO(r0) + Sb * HI(r0)) + (Sc * LO(r1) + Sd * HI(r1));
                float p1 = pa.x + pa.y, p2 = pb.x + pb.y;
                p1 = dpp_add<0xB1>(p1); p2 = dpp_add<0xB1>(p2); p1 = dpp_add<0x4E>(p1); p2 = dpp_add<0x4E>(p2); p1 = dpp_add<0x141>(p1); p2 = dpp_add<0x141>(p2);
                const float sk = p1, yv = p2 - sk * cc.x + vv * cc.y;
                Sa = Sa * LO(w0) + (LO(d0) * vv - LO(a0) * sk); Sb = Sb * HI(w0) + (HI(d0) * vv - HI(a0) * sk);
                Sc = Sc * LO(w1) + (LO(d1) * vv - LO(a1) * sk); Sd = Sd * HI(w1) + (HI(d1) * vv - HI(a1) * sk);
                if ((s >> 3) == 0) ys0 = (kc == (s & 7)) ? yv : ys0; else if ((s >> 3) == 1) ys1 = (kc == (s & 7)) ? yv : ys1; else if ((s >> 3) == 2) ys2 = (kc == (s & 7)) ? yv : ys2; else ys3 = (kc == (s & 7)) ? yv : ys3;
                w0 = w0n; w1 = w1n; d0 = d0n; d1 = d1n; a0 = a0n; a1 = a1n; r0 = r0n; r1 = r1n; k0 = k0n; k1 = k1n; vv = vvn; cc = ccn;
#undef LO
#undef HI
            }
#undef LDV
            LAS float* yb = ybuf + (ci & 1) * 1024;
            yb[kc * 32 + rl] = ys0; yb[(kc + 8) * 32 + rl] = ys1; yb[(kc + 16) * 32 + rl] = ys2; yb[(kc + 24) * 32 + rl] = ys3;
            __syncthreads();
        }
    }
#undef rowof
}

namespace att {
constexpr int NW = 8, QBLK = 32, KVBLK = 64;
constexpr float SCALE = 0.07216878364870322f;
constexpr float THR = 8.f;
constexpr int LDQ = 3072, LDKK = 3072, LDVV = 2048, LDO = 4096;
constexpr int SHM_V = KVBLK * 128 * 2, SHM_K = KVBLK * 400, SHM_QP = 256 * 208, SHM_ATTN = 2 * SHM_V + 2 * SHM_K + NW * 64 * 4 + SHM_QP;
using bf16x8 = __attribute__((ext_vector_type(8))) short;
using s16x4  = __attribute__((ext_vector_type(4))) short;
using f32x16 = __attribute__((ext_vector_type(16))) float;
using u32x4  = __attribute__((ext_vector_type(4))) unsigned;
#define KSWZ(row, colB) ((row) * 400 + (colB))
#define SBAR() __builtin_amdgcn_sched_barrier(0)
__device__ __forceinline__ int crow(int r, int hi) { return (r & 3) + 8 * (r >> 2) + 4 * hi; }
__device__ __forceinline__ unsigned cvtpk(float lo, float hi) { unsigned r; asm volatile("s_nop 0\n\tv_cvt_pk_bf16_f32 %0, %1, %2" : "=v"(r) : "v"(lo), "v"(hi)); return r; }
__device__ __forceinline__ void partialSM(f32x16& p0, f32x16& p1, float& m_reg, float& mn, float& alpha) {
  constexpr float C = SCALE * 1.4426950408889634f;
  float pmax = p0[0];
#pragma unroll
  for (int r = 1; r < 16; ++r) pmax = fmaxf(pmax, p0[r]);
#pragma unroll
  for (int r = 0; r < 16; ++r) pmax = fmaxf(pmax, p1[r]);
  { auto rr = __builtin_amdgcn_permlane32_swap(__float_as_uint(pmax), __float_as_uint(pmax), false, false);
    pmax = fmaxf(__uint_as_float(rr[0]), __uint_as_float(rr[1])); }
  if (__builtin_expect(__all(pmax - m_reg <= THR / SCALE), 1)) { mn = m_reg; alpha = 1.f; }
  else { mn = fmaxf(m_reg, pmax); alpha = __builtin_amdgcn_exp2f((m_reg - mn) * C); m_reg = mn; }
  float mnC = -mn * C;
#pragma unroll
  for (int r = 0; r < 16; ++r) p0[r] = fmaf(p0[r], C, mnC);
#pragma unroll
  for (int r = 0; r < 16; ++r) p1[r] = fmaf(p1[r], C, mnC);
#pragma unroll
  for (int r = 0; r < 16; ++r) p0[r] = __builtin_amdgcn_exp2f(p0[r]);
}
__device__ __forceinline__ void finishSM(f32x16& p0, f32x16& p1, float alpha, float& l_reg, bf16x8& pa0, bf16x8& pa1, bf16x8& pa2, bf16x8& pa3) {
#pragma unroll
  for (int r = 0; r < 16; ++r) p1[r] = __builtin_amdgcn_exp2f(p1[r]);
  float ps = 0;
#pragma unroll
  for (int r = 0; r < 16; ++r) ps += p0[r];
#pragma unroll
  for (int r = 0; r < 16; ++r) ps += p1[r];
  { auto rr = __builtin_amdgcn_permlane32_swap(__float_as_uint(ps), __float_as_uint(ps), false, false);
    ps = __uint_as_float(rr[0]) + __uint_as_float(rr[1]); }
  l_reg = l_reg * alpha + ps;
#define PK4(P, BASE, OUT) do { unsigned a0 = cvtpk(P[BASE + 0], P[BASE + 1]), a1 = cvtpk(P[BASE + 2], P[BASE + 3]);   \
    unsigned b0 = cvtpk(P[BASE + 4], P[BASE + 5]), b1 = cvtpk(P[BASE + 6], P[BASE + 7]);                              \
    auto r0 = __builtin_amdgcn_permlane32_swap(a0, b0, false, false); auto r1 = __builtin_amdgcn_permlane32_swap(a1, b1, false, false); \
    u32x4 w = {r0[0], r1[0], r0[1], r1[1]}; OUT = *reinterpret_cast<bf16x8*>(&w); } while (0)
  PK4(p0, 0, pa0); PK4(p0, 8, pa1); PK4(p1, 0, pa2); PK4(p1, 8, pa3);
#undef PK4
}
__device__ __forceinline__ void qkt(f32x16& p0, f32x16& p1, const char* Ks, const bf16x8* qr, const char* qpark, int r32, int hi) {
  p0 = f32x16{}; p1 = f32x16{};
#pragma unroll
  for (int d0 = 0; d0 < 12; ++d0) { int cb = (d0 * 16 + hi * 8) * 2;
    bf16x8 b0 = *reinterpret_cast<const bf16x8*>(Ks + KSWZ(r32, cb));
    bf16x8 b1 = *reinterpret_cast<const bf16x8*>(Ks + KSWZ(32 + r32, cb));
    const bf16x8 q = d0 < 6 ? qr[d0 < 6 ? d0 : 0] : *reinterpret_cast<const bf16x8*>(qpark + (d0 - 6) * 32);
    p0 = __builtin_amdgcn_mfma_f32_32x32x16_bf16(b0, q, p0, 0, 0, 0);
    p1 = __builtin_amdgcn_mfma_f32_32x32x16_bf16(b1, q, p1, 0, 0, 0); }
}
__device__ __forceinline__ int v_st(int k, int c) { const int kk = (k & ~0xC) | ((k & 4) << 1) | ((k & 8) >> 1); return ((kk >> 3) * 4 + (c >> 5)) * 512 + ((kk & 7) * 32 + (c & 31)) * 2; }
__device__ __forceinline__ int v_rd_base(int lane) { return ((lane & 3) << 3) | (((lane >> 2) & 3) << 6) | (((lane >> 4) & 1) << 5) | (((lane >> 5) & 1) << 8); }
constexpr int v_rd_off(int d0, int ks, int half) { return d0 * 512 + ks * 4096 + half * 2048; }
template <int OFF> __device__ __forceinline__ s16x4 tr_read(int vb) {
  s16x4 r; asm volatile("ds_read_b64_tr_b16 %0, %1 offset:%2" : "=&v"(r) : "v"(vb), "i"(OFF) : "memory"); return r;
}
template <int D0> __device__ __forceinline__ void pv_one(f32x16& od, int vb, bf16x8 pa0, bf16x8 pa1, bf16x8 pa2, bf16x8 pa3) {
  const s16x4 l0 = tr_read<v_rd_off(D0, 0, 0)>(vb), h0 = tr_read<v_rd_off(D0, 0, 1)>(vb), l1 = tr_read<v_rd_off(D0, 1, 0)>(vb), h1 = tr_read<v_rd_off(D0, 1, 1)>(vb);
  const s16x4 l2 = tr_read<v_rd_off(D0, 2, 0)>(vb), h2 = tr_read<v_rd_off(D0, 2, 1)>(vb), l3 = tr_read<v_rd_off(D0, 3, 0)>(vb), h3 = tr_read<v_rd_off(D0, 3, 1)>(vb);
  asm volatile("s_waitcnt lgkmcnt(0)" ::: "memory"); SBAR();
#define PK(L, H) (bf16x8){L[0], L[1], L[2], L[3], H[0], H[1], H[2], H[3]}
  od = __builtin_amdgcn_mfma_f32_32x32x16_bf16(pa0, PK(l0, h0), od, 0, 0, 0);
  od = __builtin_amdgcn_mfma_f32_32x32x16_bf16(pa1, PK(l1, h1), od, 0, 0, 0);
  od = __builtin_amdgcn_mfma_f32_32x32x16_bf16(pa2, PK(l2, h2), od, 0, 0, 0);
  od = __builtin_amdgcn_mfma_f32_32x32x16_bf16(pa3, PK(l3, h3), od, 0, 0, 0);
#undef PK
}
__device__ __forceinline__ void pv_d0(f32x16* o, int vb, bf16x8 pa0, bf16x8 pa1, bf16x8 pa2, bf16x8 pa3) {
  pv_one<0>(o[0], vb, pa0, pa1, pa2, pa3); pv_one<1>(o[1], vb, pa0, pa1, pa2, pa3); pv_one<2>(o[2], vb, pa0, pa1, pa2, pa3); pv_one<3>(o[3], vb, pa0, pa1, pa2, pa3);
}
__device__ __forceinline__ void attn_body(const unsigned short* __restrict__ Qb, const unsigned short* __restrict__ Kh, const unsigned short* __restrict__ Vh,
                                          unsigned short* __restrict__ Ob, int seq, char* lds, int wave_in) {
  int tid_o; asm volatile("v_mbcnt_lo_u32_b32 %0, -1, 0\n\tv_mbcnt_hi_u32_b32 %0, -1, %0" : "=v"(tid_o)); tid_o += wave_in * 64;
  const int tid = tid_o, wid = wave_in, lane = tid & 63, r32 = lane & 31, hi = lane >> 5;
  char* V_lds = lds; char* K_lds = lds + 2 * SHM_V;
  float* wsx = (float*)(lds + 2 * SHM_V + 2 * SHM_K) + wid * 64; float* li_l = wsx; float* al_l = wsx + 32;
  float m_reg = -1e30f, l_reg = 0; f32x16 o[4] = {}; bf16x8 qr[6];
  char* qpark = lds + 2 * SHM_V + 2 * SHM_K + NW * 64 * 4 + (wid * QBLK + r32) * 208 + hi * 16;
  const unsigned short* Qw = Qb + (long)(wid * QBLK + r32) * LDQ + hi * 8;
#pragma unroll
  for (int d0 = 0; d0 < 6; ++d0) qr[d0] = *reinterpret_cast<const bf16x8*>(Qw + d0 * 16);
#pragma unroll
  for (int d0 = 6; d0 < 12; ++d0) *reinterpret_cast<bf16x8*>(qpark + (d0 - 6) * 32) = *reinterpret_cast<const bf16x8*>(Qw + d0 * 16);
  const int sr = tid >> 4, sc = (tid & 15) * 8, vst0 = v_st(sr, sc), vst1 = v_st(32 + sr, sc);
  const int kr0 = tid / 24, kc0 = (tid % 24) * 8, kr1 = (tid + 512) / 24, kc1 = ((tid + 512) % 24) * 8, kr2 = (tid + 1024) / 24, kc2 = ((tid + 1024) % 24) * 8;
  const int vb0 = (int)(uintptr_t)V_lds + v_rd_base(lane);
  const unsigned ko0 = (unsigned)(kr0 * LDKK + kc0) * 2u, ko1 = (unsigned)(kr1 * LDKK + kc1) * 2u, ko2 = (unsigned)(kr2 * LDKK + kc2) * 2u;
  const unsigned vo0 = (unsigned)(sr * LDVV + sc) * 2u, vo1 = (unsigned)((32 + sr) * LDVV + sc) * 2u;
  const int kl0 = KSWZ(kr0, kc0 * 2), kl1 = KSWZ(kr1, kc1 * 2), kl2 = KSWZ(kr2, kc2 * 2);
  bf16x8 vs0, vs1, ks0, ks1, ks2;
#define SLOAD(k0) do { const char* kb_ = (const char*)Kh + (size_t)(k0) * (LDKK * 2); const char* vb_ = (const char*)Vh + (size_t)(k0) * (LDVV * 2); \
    vs0 = *reinterpret_cast<const bf16x8*>(vb_ + vo0); vs1 = *reinterpret_cast<const bf16x8*>(vb_ + vo1); \
    ks0 = *reinterpret_cast<const bf16x8*>(kb_ + ko0); ks1 = *reinterpret_cast<const bf16x8*>(kb_ + ko1); ks2 = *reinterpret_cast<const bf16x8*>(kb_ + ko2); } while (0)
#define SWRITE(b) do { *(bf16x8*)(V_lds + (b) * SHM_V + vst0) = vs0; *(bf16x8*)(V_lds + (b) * SHM_V + vst1) = vs1; \
    *(bf16x8*)(K_lds + (b) * SHM_K + kl0) = ks0; *(bf16x8*)(K_lds + (b) * SHM_K + kl1) = ks1; *(bf16x8*)(K_lds + (b) * SHM_K + kl2) = ks2; } while (0)
#define SWAIT() asm volatile("s_waitcnt vmcnt(0)" ::: "memory")
#define RESC(a) do { if (__any((a) < 1.f)) { if (hi == 0) al_l[r32] = (a); asm volatile("s_waitcnt lgkmcnt(0)" ::: "memory"); \
    _Pragma("unroll") for (int d = 0; d < 4; ++d) _Pragma("unroll") for (int r = 0; r < 16; ++r) o[d][r] *= al_l[crow(r, hi)]; } } while (0)
  f32x16 pA0, pA1, pB0, pB1; float mnA, mnB, alA, alB; bf16x8 pa0, pa1, pa2, pa3; const int NT = seq / KVBLK;
  __syncthreads();
  SLOAD(0); SWAIT(); SWRITE(0); __syncthreads();
  qkt(pA0, pA1, K_lds, qr, qpark, r32, hi); partialSM(pA0, pA1, m_reg, mnA, alA);
  SLOAD(KVBLK);
  SWAIT(); SWRITE(1); __syncthreads();
  for (int j = 1; j + 1 < NT; j += 2) {
    SBAR(); qkt(pB0, pB1, K_lds + SHM_K, qr, qpark, r32, hi);
    finishSM(pA0, pA1, alA, l_reg, pa0, pa1, pa2, pa3); SBAR();
    SLOAD((j + 1) * KVBLK); SBAR();
    pv_d0(o, vb0, pa0, pa1, pa2, pa3); partialSM(pB0, pB1, m_reg, mnB, alB);
    __syncthreads(); SWAIT(); SWRITE(0);
    RESC(alB); __syncthreads();
    SBAR(); qkt(pA0, pA1, K_lds, qr, qpark, r32, hi);
    finishSM(pB0, pB1, alB, l_reg, pa0, pa1, pa2, pa3); SBAR();
    SLOAD((j + 2) * KVBLK); SBAR();
    pv_d0(o, vb0 + SHM_V, pa0, pa1, pa2, pa3); partialSM(pA0, pA1, m_reg, mnA, alA);
    __syncthreads(); SWAIT(); SWRITE(1);
    RESC(alA); __syncthreads();
  }
  SBAR(); qkt(pB0, pB1, K_lds + SHM_K, qr, qpark, r32, hi);
  finishSM(pA0, pA1, alA, l_reg, pa0, pa1, pa2, pa3); SBAR();
  pv_d0(o, vb0, pa0, pa1, pa2, pa3); partialSM(pB0, pB1, m_reg, mnB, alB);
  __syncthreads(); RESC(alB);
  finishSM(pB0, pB1, alB, l_reg, pa0, pa1, pa2, pa3); SBAR();
  pv_d0(o, vb0 + SHM_V, pa0, pa1, pa2, pa3);
  if (hi == 0) li_l[r32] = l_reg; asm volatile("s_waitcnt lgkmcnt(0)" ::: "memory");
  float rli[16];
#pragma unroll
  for (int r = 0; r < 16; ++r) rli[r] = __builtin_amdgcn_rcpf(li_l[crow(r, hi)]);
  unsigned short* Ow = Ob + (long)(wid * QBLK) * LDO;
#pragma unroll
  for (int r = 0; r < 16; ++r) { int orow = crow(r, hi);
#pragma unroll
    for (int d0 = 0; d0 < 4; ++d0) Ow[(long)orow * LDO + d0 * 32 + r32] = (unsigned short)f2bf(o[d0][r] * rli[r]); }
#undef SLOAD
#undef SWRITE
#undef SWAIT
#undef RESC
}
#undef KSWZ
#undef SBAR
}

#ifndef DBG_STOP
#define DBG_STOP 1000
#endif
constexpr int PH_PER_LAYER = 15, NPHASE = 1 + 2 * PH_PER_LAYER, PH_COPY = NPHASE;
struct Args { const float* in[N_IN]; float* out; unsigned char* ws; int ph_lo, ph_hi; };

template <class Epi> __device__ __forceinline__ void run_gemm(LAS unsigned char* lds, const bf16* A, const bf16* Bt, int M, int N, int K, int G, const Epi& E, int wave, int cshift = 0) {
    asm volatile("" : "+s"(K));
    pg8::Gemm g{A, Bt, M, N, K, K, (size_t)256 * K * 2, (size_t)0}; pg8::StaticOrder S; S.init(M, N, G, (int)((blockIdx.x + (unsigned)cshift) % (unsigned)G));
    pg8::gemm_phase<Epi, pg8::StaticOrder, true, true>(lds, g, S, E, wave);
}

#ifndef SK_MASK
#define SK_MASK 15
#endif
#ifndef SK_DRY
#define SK_DRY 0
#endif
#ifndef PH7_BAL
#define PH7_BAL 1
#endif
#define SK_F1 ((SK_MASK) & 1)
#define SK_IN (((SK_MASK) >> 3) & 1)
#define SK_OP (((SK_MASK) >> 1) & 1)
#define SK_F2 (((SK_MASK) >> 2) & 1)
template <class Epi> __device__ __forceinline__ void run_gemm_sk(LAS unsigned char* lds, const bf16* A, const bf16* Bt, int ld, int N, int G, const Epi& E, int wave, int ns = SK_NS) {
    asm volatile("" : "+s"(ld));
    asm volatile("" : "+s"(ns)); int Ks = ld / ns; asm volatile("" : "+s"(Ks));
    pg8::Gemm g{A, Bt, ns * 256, N, Ks, ld, (size_t)Ks * 2, (size_t)Ks * 2}; pg8::StaticOrder S; S.init(ns * 256, N, G, (int)blockIdx.x);
    pg8::gemm_phase<Epi, pg8::StaticOrder, true, true>(lds, g, S, E, wave);
}
#define WSP(T, off) ((T*)(ws + (off)))

template <int PHSEL> __global__ void __launch_bounds__(NTHR, 2) fwd_kernel(Args args) {
    extern __shared__ __attribute__((aligned(16))) unsigned char lds_raw[];
    LAS unsigned char* lds = (LAS unsigned char*)lds_raw;
    const int wave = __builtin_amdgcn_readfirstlane((int)(threadIdx.x >> 6));
    const int G = gridDim.x; const int bx = blockIdx.x; const int vcu = (G % 8 == 0) ? (bx % 8) * (G / 8) + bx / 8 : bx;
    const int gw = vcu * NWAVES + wave, NGW = G * NWAVES;
    const int lo = args.ph_lo, hi = args.ph_hi;
    volatile LAS unsigned* MISC = (volatile LAS unsigned*)(lds + MISC_OFF);
    if (threadIdx.x < 64) MISC[threadIdx.x] = 0u;
    if (threadIdx.x == 0) {
        LAS unsigned long long* PT = (LAS unsigned long long*)(lds + PT_OFF);
#pragma unroll
        for (int i = 0; i < N_IN; ++i) PT[i] = (unsigned long long)args.in[i];
        PT[N_IN] = (unsigned long long)args.out; PT[N_IN + 1] = (unsigned long long)args.ws;
    }
    __syncthreads();
    XcdBarrier bar; bar.bar = (unsigned*)(args.ws + WS_CTL) + CW_BAR; bar.x = 0; bar.st = nullptr;
    if (hi - lo > 1) bar = xcd_barrier_post((unsigned*)(args.ws + WS_CTL) + CW_BAR, MISC + 8);
    bar.wave = wave;
#ifndef PH_MASK
#define PH_MASK 0xFFFFF
#endif
#ifndef DBG_REP
#define DBG_REP -1
#endif
#define REPS(j) ((DBG_REP == (j)) ? 2 : 1)
#define EN(j) ((((PH_MASK) >> (j)) & 1) && (PHSEL < 0 || PHSEL == ((j) >= 16 ? 7 : (j))))
#define IN(k) (lo <= (k) && (k) < hi && (k) <= DBG_STOP)
#define SEAM(k) do { if (lo <= (k) && (k) + 1 < hi) { asm volatile("" ::: "memory"); XcdBarrier bb_ = bar; bb_.bar = (unsigned*)((GAS unsigned char*)ld_uptr(lds, N_IN + 1) + WS_CTL) + CW_BAR; xcd_barrier(bb_); if (bx == 0) TSW(k); } } while (0)
#ifdef DBG_TS_A
#define TSW(id) do { if (wave == 0 && lane_vol() == 0) __hip_atomic_store((gu32*)((GAS unsigned char*)ld_uptr(lds, N_IN + 1) + WS_CTL) + 16384 + (id), (unsigned)__builtin_amdgcn_s_memrealtime(), RLX_AGENT); } while (0)
#else
#define TSW(id) do {} while (0)
#endif
#define PHASE_PTRS() const Ptrs P = load_ptrs(lds); unsigned char* ws = P.ws; const float* MOD = WSP(const float, WS_MOD); \
        const float* modL = MOD + (size_t)(l * 2 + 0) * NMODC; const float* modC = MOD + (size_t)(l * 2 + 1) * NMODC; float* X = WSP(float, WS_X); float* XC = X + (size_t)SEQ * DM; \
        (void)modL; (void)modC; (void)X; (void)XC

    if (bx == 0) TSW(62);
    if (EN(0) && IN(0)) for (int rp = 0; rp < REPS(0); ++rp) prologue_phase(lds, vcu, G, wave);
    SEAM(0);

    for (int l = 0; l < 2; ++l) {
        const int pb = 1 + PH_PER_LAYER * l;
        const bool last = (l == 1);
        const int nrows2 = last ? SEQ : MROWS;
        if (EN(1) && IN(pb + 0)) for (int rp = 0; rp < REPS(1); ++rp) { PHASE_PTRS(); const float* x0L = (l == 0) ? P.in[I_X] : X; const float* x0C = (l == 0) ? P.in[I_CTX] : XC;
            prep_phase(lds, x0L, x0C, MROWS, P.in[I_NORMG] + (size_t)(l * 3 + 0) * DM, modL, modC, 0, WSP(bf16, WS_XN), gw, NGW, wave, SK_F2 && l == 1 ? WSP(const float, WS_ACC) : nullptr, XC); }
        SEAM(pb + 0);
        if (EN(2) && IN(pb + 1)) for (int rp = 0; rp < REPS(2); ++rp) { PHASE_PTRS(); EpiSwiGLU E{WSP(bf16, WS_H)}; run_gemm(lds, WSP(const bf16, WS_XN), WSP(const bf16, WS_WFI + (size_t)(l * 2 + 0) * SZ_WFI), MROWS, 16384, DM, G, E, wave); }
        SEAM(pb + 1);
        if (EN(3) && IN(pb + 2)) { PHASE_PTRS(); const float* x0L = (l == 0) ? P.in[I_X] : X; const float* x0C = (l == 0) ? P.in[I_CTX] : XC;
            EpiRes E{x0L, x0C, X, XC, modL + 2 * DM, modC + 2 * DM, 0.5f}; run_gemm(lds, WSP(const bf16, WS_H), WSP(const bf16, WS_WFO + (size_t)(l * 2 + 0) * SZ_WFO), (SK_F1 && !SK_DRY) ? SEQ : MROWS, DM, DFF, G, E, wave);
            if (SK_F1) { EpiSlab EA{WSP(float, WS_ACC), modC + 2 * DM, 0.5f};
#if SK_DRY == 2
            run_gemm(lds, WSP(const bf16, WS_H) + (size_t)SEQ * DFF, WSP(const bf16, WS_WFO + (size_t)(l * 2 + 0) * SZ_WFO), 256, DM, DFF, G, EA, wave); } }
#else
            run_gemm_sk(lds, WSP(const bf16, WS_H) + (size_t)SEQ * DFF, WSP(const bf16, WS_WFO + (size_t)(l * 2 + 0) * SZ_WFO), DFF, DM, G, EA, wave); } }
#endif
        SEAM(pb + 2);
        if (EN(4) && IN(pb + 3)) for (int rp = 0; rp < REPS(4); ++rp) { PHASE_PTRS(); prep_phase(lds, X, (SK_F1 && !SK_DRY && l == 0) ? P.in[I_CTX] : XC, MROWS, P.in[I_NORMG] + (size_t)(l * 3 + 1) * DM, modL, modC, 3, WSP(bf16, WS_XN), gw, NGW, wave, (SK_F1 && !SK_DRY) ? WSP(const float, WS_ACC) : nullptr, XC); }
        SEAM(pb + 3);
        if (EN(5) && IN(pb + 4)) for (int rp = 0; rp < REPS(5); ++rp) { PHASE_PTRS();
            EpiB16 E{WSP(bf16, WS_Z), ZC}; run_gemm(lds, WSP(const bf16, WS_XN), WSP(const bf16, WS_WIN + (size_t)l * SZ_WIN), SK_IN ? SEQ : MROWS, ZC, DM, G, E, wave);
            if (SK_IN) { EpiSlabP ES{WSP(float, WS_SLB), ZC}; run_gemm_sk(lds, WSP(const bf16, WS_XN) + (size_t)SEQ * DM, WSP(const bf16, WS_WIN + (size_t)l * SZ_WIN), DM, ZC, G, ES, wave, 4); } }
        SEAM(pb + 4);
        if (EN(6) && IN(pb + 5)) { if (SK_IN) { { PHASE_PTRS(); ctx_reduce_z(P, vcu, G, wave); } SEAM(pb + 4); } PHASE_PTRS(); streams_phase(P, l, gw, NGW); }
        SEAM(pb + 5);
        if (EN(7) && IN(pb + 6)) {
#if PH7_BAL
            if (EN(16)) { PHASE_PTRS(); EpiB16 E{WSP(bf16, WS_LW), 10240}; run_gemm(lds, WSP(const bf16, WS_LWA), WSP(const bf16, WS_WWA + (size_t)l * SZ_WWA), SEQ, 10240, 512, G, E, wave); }
            if (EN(19)) { PHASE_PTRS(); EpiB16 E{WSP(bf16, WS_KVF), 4096}; run_gemm(lds, WSP(const bf16, WS_KVL), WSP(const bf16, WS_WKV + (size_t)l * SZ_WKV), SEQ, 4096, 512, G, E, wave); }
            if (EN(18)) { PHASE_PTRS(); EpiB16 E{WSP(bf16, WS_QF), 3072}; run_gemm(lds, WSP(const bf16, WS_QL), WSP(const bf16, WS_WQ + (size_t)l * SZ_WQ), SEQ, 3072, 1024, G, E, wave); }
            if (EN(16)) { PHASE_PTRS(); EpiB16 E{WSP(bf16, WS_LW) + (size_t)SEQ * 10240, 10240}; run_gemm(lds, WSP(const bf16, WS_LWA) + (size_t)SEQ * 512, WSP(const bf16, WS_WWA + (size_t)l * SZ_WWA), CTXL, 10240, 512, G, E, wave, 128); }
            if (EN(18)) { PHASE_PTRS(); EpiB16 E{WSP(bf16, WS_QF) + (size_t)SEQ * 3072, 3072}; run_gemm(lds, WSP(const bf16, WS_QL) + (size_t)SEQ * 1024, WSP(const bf16, WS_WQ + (size_t)l * SZ_WQ), CTXL, 3072, 1024, G, E, wave, 88); }
            if (EN(19)) { PHASE_PTRS(); EpiB16 E{WSP(bf16, WS_KVF) + (size_t)SEQ * 4096, 4096}; run_gemm(lds, WSP(const bf16, WS_KVL) + (size_t)SEQ * 512, WSP(const bf16, WS_WKV + (size_t)l * SZ_WKV), CTXL, 4096, 512, G, E, wave, 72); }
#else
            if (EN(16)) { PHASE_PTRS(); EpiB16 E{WSP(bf16, WS_LW), 10240}; run_gemm(lds, WSP(const bf16, WS_LWA), WSP(const bf16, WS_WWA + (size_t)l * SZ_WWA), MROWS, 10240, 512, G, E, wave); }
            if (EN(18)) { PHASE_PTRS(); EpiB16 E{WSP(bf16, WS_QF), 3072}; run_gemm(lds, WSP(const bf16, WS_QL), WSP(const bf16, WS_WQ + (size_t)l * SZ_WQ), MROWS, 3072, 1024, G, E, wave); }
            if (EN(19)) { PHASE_PTRS(); EpiB16 E{WSP(bf16, WS_KVF), 4096}; run_gemm(lds, WSP(const bf16, WS_KVL), WSP(const bf16, WS_WKV + (size_t)l * SZ_WKV), MROWS, 4096, 512, G, E, wave); }
#endif
        }
        SEAM(pb + 6);
        if (EN(9) && IN(pb + 8)) {
            PHASE_PTRS();
            gu32* ctlw = (gu32*)(ws + WS_CTL);
            gu32* qk_done = ctlw + CW_MIX + 64 * l; gu32* q_head = ctlw + CW_MIX + 64 * (2 + l); gu32* tmo = ctlw + CW_MIX + 64 * 4;
            gu32* scan_done = ctlw + CW_MIX + 64 * (5 + l);
            if (vcu < 128) {
                scan_phase(P, l, lds, vcu, wave);
                if (bx == 0) TSW(40 + l);
                asm volatile("s_waitcnt vmcnt(0)" ::: "memory"); __syncthreads();
                if (wave == 0 && lane_vol() == 0) { __builtin_amdgcn_fence(__ATOMIC_RELEASE, "agent"); asm volatile("s_waitcnt vmcnt(0)" ::: "memory"); __hip_atomic_fetch_add(scan_done, 1u, RLX_AGENT); }
            } else {
                qknorm_phase(P, l, (vcu - 128) * NWAVES + wave, 128 * NWAVES);
                if (vcu == 200) TSW(46 + l);
                asm volatile("s_waitcnt vmcnt(0)" ::: "memory"); __syncthreads();
                if (wave == 0 && lane_vol() == 0) { __builtin_amdgcn_fence(__ATOMIC_RELEASE, "agent"); asm volatile("s_waitcnt vmcnt(0)" ::: "memory"); __hip_atomic_fetch_add(qk_done, 1u, RLX_AGENT); }
            }
            if (wave == 0 && lane_vol() == 0) {
                unsigned sp = 0;
                while (__hip_atomic_load(qk_done, RLX_AGENT) < 128u) { __builtin_amdgcn_s_sleep(2); if (++sp > (1u << 22)) { __hip_atomic_store(tmo, 1u, RLX_AGENT); break; } }
                __builtin_amdgcn_fence(__ATOMIC_ACQUIRE, "agent"); asm volatile("s_waitcnt vmcnt(0)" ::: "memory");
            }
            __syncthreads();
            if (bx == 0) TSW(50 + l);
            const int nun = 512 + (last ? 0 : 16);
            const bf16* QB = WSP(const bf16, WS_QB); const bf16* KB = WSP(const bf16, WS_KB); const bf16* VB = WSP(const bf16, WS_VB); bf16* OC = WSP(bf16, WS_OC);
            bool scan_ok = false;
            for (;;) {
                if (wave == 0 && lane_vol() == 0) MISC[16] = __hip_atomic_fetch_add(q_head, 1u, RLX_AGENT);
                __syncthreads();
                const int u = (int)MISC[16];
                if (u >= nun) {
                    const int v = u - nun; if (v * 32 >= nrows2) break;
                    if (!scan_ok) {
                        if (wave == 0 && lane_vol() == 0) { unsigned sp = 0;
                            while (__hip_atomic_load(scan_done, RLX_AGENT) < 128u) { __builtin_amdgcn_s_sleep(2); if (++sp > (1u << 22)) { __hip_atomic_store(tmo, 1u, RLX_AGENT); break; } }
                            __builtin_amdgcn_fence(__ATOMIC_ACQUIRE, "agent"); asm volatile("s_waitcnt vmcnt(0)" ::: "memory"); }
                        __syncthreads(); scan_ok = true;
                    }
                    rwkvout_phase(P, l, v * 32, v * 32 + 32, wave, NWAVES);
                    __syncthreads();
                    continue;
                }
                int h, q0, key0, nk;
                if (u < 512) { h = u >> 5; q0 = (u & 31) * 256; key0 = 0; nk = MROWS; } else { h = u - 512; q0 = SEQ; key0 = SEQ; nk = CTXL; }
                att::attn_body(QB + (size_t)q0 * 3072 + h * 192, KB + (size_t)key0 * 3072 + h * 192, VB + (size_t)key0 * 2048 + h * 128, OC + (size_t)q0 * DM + 2048 + h * 128, nk, (char*)lds_raw, wave);
                __syncthreads();
            }
            __syncthreads();
            if (bx == 0) TSW(44 + l); if (vcu == 200) TSW(48 + l);
        }
        SEAM(pb + 8);
        if (EN(12) && IN(pb + 11)) { PHASE_PTRS(); EpiRes E{X, XC, X, XC, modL + 5 * DM, modC + 5 * DM, 1.0f}; run_gemm(lds, WSP(const bf16, WS_OC), WSP(const bf16, WS_WOUT + (size_t)l * SZ_WOUT), SK_OP ? SEQ : nrows2, DM, DM, G, E, wave);
            if (SK_OP && !last) { EpiSlab EA{WSP(float, WS_ACC), modC + 5 * DM, 1.0f}; run_gemm_sk(lds, WSP(const bf16, WS_OC) + (size_t)SEQ * DM, WSP(const bf16, WS_WOUT + (size_t)l * SZ_WOUT), DM, DM, G, EA, wave); } }
        SEAM(pb + 11);
        if (EN(13) && IN(pb + 12)) for (int rp = 0; rp < REPS(13); ++rp) { PHASE_PTRS(); prep_phase(lds, X, XC, nrows2, P.in[I_NORMG] + (size_t)(l * 3 + 2) * DM, modL, modC, 6, WSP(bf16, WS_XN), gw, NGW, wave, (SK_OP && !last) ? WSP(const float, WS_ACC) : nullptr, XC); }
        SEAM(pb + 12);
        if (EN(14) && IN(pb + 13)) for (int rp = 0; rp < REPS(14); ++rp) { PHASE_PTRS(); EpiSwiGLU E{WSP(bf16, WS_H)}; run_gemm(lds, WSP(const bf16, WS_XN), WSP(const bf16, WS_WFI + (size_t)(l * 2 + 1) * SZ_WFI), nrows2, 16384, DM, G, E, wave); }
        SEAM(pb + 13);
        if (EN(15) && IN(pb + 14)) { PHASE_PTRS(); float* oL = last ? P.out : X;
            EpiRes E{X, XC, oL, XC, modL + 8 * DM, modC + 8 * DM, 0.5f}; run_gemm(lds, WSP(const bf16, WS_H), WSP(const bf16, WS_WFO + (size_t)(l * 2 + 1) * SZ_WFO), SK_F2 ? SEQ : nrows2, DM, DFF, G, E, wave);
            if (SK_F2 && !last) { EpiSlab EA{WSP(float, WS_ACC), modC + 8 * DM, 0.5f}; run_gemm_sk(lds, WSP(const bf16, WS_H) + (size_t)SEQ * DFF, WSP(const bf16, WS_WFO + (size_t)(l * 2 + 1) * SZ_WFO), DFF, DM, G, EA, wave); } }
        SEAM(pb + 14);
    }
    if ((PHSEL < 0 || PHSEL == 100) && DBG_STOP < NPHASE - 1 && lo <= PH_COPY && PH_COPY < hi) {
        const int l = 0; PHASE_PTRS();
        const int tid = wave * 64 + lane_vol();
#if 0
#else
        const float* src = (DBG_STOP >= 3) ? X : P.in[I_X];
        for (size_t i = (size_t)(bx * NTHR + tid); i < (size_t)SEQ * DM / 4; i += (size_t)G * NTHR) ((f32x4*)P.out)[i] = ((const f32x4*)src)[i];
#endif
    }
#ifdef DBG_TS_A
    if (bx == 0 && wave == 0 && lane_vol() == 0) {
        gu32* tsp = (gu32*)((GAS unsigned char*)ld_uptr(lds, N_IN + 1) + WS_CTL) + 16384;
        const unsigned tb = (DBG_TS_B == 99) ? (unsigned)__builtin_amdgcn_s_memrealtime() : __hip_atomic_load(tsp + DBG_TS_B, RLX_AGENT);
        const unsigned ta = __hip_atomic_load(tsp + DBG_TS_A, RLX_AGENT);
        const unsigned long long dt = (unsigned long long)(tb - ta) * (unsigned long long)(DBG_TS_MULT);
        const unsigned long long t0_ = __builtin_amdgcn_s_memrealtime();
        while (__builtin_amdgcn_s_memrealtime() - t0_ < dt) __builtin_amdgcn_s_sleep(64);
    }
#endif
#undef IN
#undef SEAM
}

extern "C" void kernel_launch(void* const* d_in, const int* in_sizes, int n_in, void* d_out, int out_size, void* d_ws, size_t ws_size, hipStream_t stream) {
    static int grid = 0;
    if (grid == 0) {
        if (n_in != N_IN || out_size != SEQ * DM || ws_size < WS_END) { fprintf(stderr, "kernel_launch: unexpected shapes: n_in %d out %d ws %zu (need %zu)\n", n_in, out_size, ws_size, (size_t)WS_END); grid = -1; return; }
        int dev = 0, cus = 0;
        if (hipGetDevice(&dev) != hipSuccess || hipDeviceGetAttribute(&cus, hipDeviceAttributeMultiprocessorCount, dev) != hipSuccess) { grid = -1; return; }
        {
            hipError_t e = hipSuccess;
#if MK_ONE_LAUNCH
            e = hipFuncSetAttribute((const void*)fwd_kernel<-1>, hipFuncAttributeMaxDynamicSharedMemorySize, LDS_BYTES);
#else
#define SETA(S) if (e == hipSuccess) e = hipFuncSetAttribute((const void*)fwd_kernel<S>, hipFuncAttributeMaxDynamicSharedMemorySize, LDS_BYTES)
            SETA(0); SETA(1); SETA(2); SETA(3); SETA(4); SETA(5); SETA(6); SETA(7); SETA(8); SETA(9); SETA(10); SETA(11); SETA(12); SETA(13); SETA(14); SETA(15); SETA(100);
#undef SETA
#endif
            if (e != hipSuccess) { fprintf(stderr, "kernel_launch: hipFuncSetAttribute failed\n"); grid = -1; return; }
        }
        (void)hipGetLastError();
        grid = cus;
    }
    if (grid < 0) return;
    (void)hipMemsetAsync((char*)d_ws + WS_CTL, 0, ZERO_BYTES, stream);
    Args a{};
    for (int i = 0; i < N_IN; ++i) a.in[i] = (const float*)d_in[i];
    a.out = (float*)d_out; a.ws = (unsigned char*)d_ws;
    const int last_phase = (DBG_STOP < NPHASE - 1) ? PH_COPY : NPHASE - 1;
#if MK_ONE_LAUNCH
    a.ph_lo = 0; a.ph_hi = last_phase + 1;
    hipLaunchKernelGGL(fwd_kernel<-1>, dim3(grid), dim3(NTHR), LDS_BYTES, stream, a);
#else
    for (int p = 0; p <= last_phase; ++p) {
        if (p > DBG_STOP && p != PH_COPY) continue;
#ifdef HOST_SKIP_FROM
        if (p >= HOST_SKIP_FROM && p != PH_COPY) continue;
#endif
        a.ph_lo = p; a.ph_hi = p + 1;
        const int slot = (p == 0) ? 0 : (p == PH_COPY ? 100 : 1 + (p - 1) % PH_PER_LAYER);
#define LCH(S) case S: hipLaunchKernelGGL(fwd_kernel<S>, dim3(grid), dim3(NTHR), LDS_BYTES, stream, a); break
        switch (slot) { LCH(0); LCH(1); LCH(2); LCH(3); LCH(4); LCH(5); LCH(6); LCH(7); LCH(8); LCH(9); LCH(10); LCH(11); LCH(12); LCH(13); LCH(14); LCH(15); LCH(100); default: break; }
#undef LCH
    }
#endif
    const hipError_t le = hipPeekAtLastError();
    if (le != hipSuccess) fprintf(stderr, "kernel_launch: launch failed: %s\n", hipGetErrorName(le));
}
```

```cpp
#include <hip/hip_runtime.h>
#include <cstdio>
#include <cstdint>
#define MK_ONE_LAUNCH 1
#define DBG_STOP 1000
#ifndef MK_ONE_LAUNCH
#define MK_ONE_LAUNCH 1
#endif
namespace pg8 {
#define PG8_LAS __attribute__((address_space(3)))
typedef unsigned short bf16_t;
typedef short bf16x8 __attribute__((ext_vector_type(8)));
typedef float f32x4 __attribute__((ext_vector_type(4)));
typedef unsigned u32x4 __attribute__((ext_vector_type(4)));
constexpr int BM = 256, BK = 64, HALF = 128, HTB = HALF * BK * 2  , STAGE_BYTES = 8 * HTB, NXCD = 8, WGM = 8;

__host__ __device__ __forceinline__ int lds_byte(int r, int c) { const int st = (r >> 4) * 2 + (c >> 5), rr = r & 15, cc = c & 31, ob = rr * 64 + cc * 2; return st * 1024 + (ob ^ (((ob >> 9) & 1) << 5)); }
__host__ __device__ __forceinline__ void stage_rc(int b, int& R, int& C) { const int st = b / 1024, sb = b % 1024, swz = sb ^ (((sb >> 9) & 1) << 5); R = (st >> 1) * 16 + swz / 64; C = (st & 1) * 32 + (swz % 64) / 2; }
__host__ __device__ __forceinline__ int perm32(int rho) { const int n = rho >> 4, i = rho & 15; return 8 * (i >> 2) + 4 * n + (i & 3); }

struct Unit { int pm, pn; };
struct Gemm { const bf16_t* A; const bf16_t* Bt; int M, N, K; int ld; size_t apm, bpm; };

struct StaticOrder {
    int nM, nN, nwg, G, c;
    __host__ __device__ void init(int M, int N, int G_, int c_) { nM = M / BM; nN = N / BM; nwg = nM * nN; G = G_; c = c_; }
    __host__ __device__ bool next(int i, Unit& u) const {
        const long L = (long)i * G + c; if (L >= nwg) return false;
        int wgid = (int)L; { const int q = nwg / NXCD, r = nwg % NXCD, xcd = wgid % NXCD, off = wgid / NXCD; wgid = (xcd < r ? xcd * (q + 1) : r * (q + 1) + (xcd - r) * q) + off; }
        const int nig = WGM * nN, gid = wgid / nig, fm = gid * WGM, gsz = (nM - fm) < WGM ? (nM - fm) : WGM;
        u.pm = fm + ((wgid % nig) % gsz); u.pn = (wgid % nig) / gsz; return true;
    }
    __device__ __forceinline__ void a_ready(const Unit&) const {}
    __device__ __forceinline__ void done(const Unit&) const {}
};

__device__ __forceinline__ unsigned cvt_pk_bf16(float lo, float hi) { unsigned r; asm volatile("s_nop 0\n\tv_cvt_pk_bf16_f32 %0, %1, %2" : "=v"(r) : "v"(lo), "v"(hi)); return r; }
template <class Epi, class Sched, bool ALIGN_EPI = false, bool SP2 = false>
__device__ __forceinline__ void gemm_phase(PG8_LAS unsigned char* lds, const Gemm g, const Sched& S, const Epi& E, int wave_in) {
    int tid_o; asm volatile("v_mbcnt_lo_u32_b32 %0, -1, 0\n\tv_mbcnt_hi_u32_b32 %0, -1, %0" : "=v"(tid_o)); tid_o += wave_in * 64;
    const int tid = tid_o, wid = wave_in, lane = tid & 63, wr = wid >> 2, wc = wid & 3, fr = lane & 15, fq = lane >> 4;
    const int K = g.K, nt = K / BK, LD = g.ld;
    unsigned voffA[2], voffB[2];
#pragma unroll
    for (int i = 0; i < 2; ++i) { int R, C; stage_rc(tid * 16 + i * 8192, R, C); const int Rb = Epi::PERM ? ((R & ~31) + perm32(R & 31)) : R;
        voffA[i] = (unsigned)(R * LD + C) * 2u; voffB[i] = (unsigned)(Rb * LD + C) * 2u; }
    const size_t kstep = (size_t)(BK * 2);
    const size_t hstep = (size_t)HALF * LD * 2;
    const size_t tstep = 2 * hstep;
    const unsigned ldsw = (unsigned)wid * 1024u;
    const int aoff = lds_byte(wr * 64 + fr, fq * 8), boff = lds_byte(wc * 32 + fr, fq * 8);
#define PG8_SA(b, h) (((b) * 2 + (h)) * HTB)
#define PG8_SB(b, h) ((4 + (b) * 2 + (h)) * HTB)
#define PG8_STAGE(bufoff, gbase, voff) do { _Pragma("unroll") for (int _i = 0; _i < 2; ++_i) \
        __builtin_amdgcn_global_load_lds((const unsigned*)((const char*)(gbase) + (voff)[_i]), (PG8_LAS unsigned*)(lds + (bufoff) + ldsw + _i * 8192), 16, 0, 0); } while (0)
#define PG8_LDA(dst, b, h) do { _Pragma("unroll") for (int m = 0; m < 4; ++m) _Pragma("unroll") for (int k = 0; k < 2; ++k) dst[m][k] = *(const PG8_LAS bf16x8*)(lds + PG8_SA(b, h) + aoff + m * 2048 + k * 1024); } while (0)
#define PG8_LDB(dst, b, h) do { _Pragma("unroll") for (int n = 0; n < 2; ++n) _Pragma("unroll") for (int k = 0; k < 2; ++k) dst[n][k] = *(const PG8_LAS bf16x8*)(lds + PG8_SB(b, h) + boff + n * 2048 + k * 1024); } while (0)
#define PG8_MMA(ai, bj, At, Bt) do { __builtin_amdgcn_s_setprio(1); _Pragma("unroll") for (int m = 0; m < 4; ++m) _Pragma("unroll") for (int n = 0; n < 2; ++n) _Pragma("unroll") for (int k = 0; k < 2; ++k) \
        acc[ai][bj][m][n] = __builtin_amdgcn_mfma_f32_16x16x32_bf16(Bt[n][k], At[m][k], acc[ai][bj][m][n], 0, 0, 0); __builtin_amdgcn_s_setprio(0); } while (0)
#define PG8_WAIT_V(n) asm volatile("s_waitcnt vmcnt(" #n ")" ::: "memory")
#define PG8_WAIT_L(n) asm volatile("s_waitcnt lgkmcnt(" #n ")" ::: "memory")
#define PG8_BAR __builtin_amdgcn_s_barrier()
#define PG8_SCHED __builtin_amdgcn_sched_barrier(0)
    Unit cur, nxt; int ui = 0;
    if (!S.next(0, cur)) return;
    f32x4 acc[2][2][4][2];
#pragma unroll
    for (int a = 0; a < 2; ++a)
#pragma unroll
        for (int b = 0; b < 2; ++b)
#pragma unroll
            for (int m = 0; m < 4; ++m)
#pragma unroll
                for (int n = 0; n < 2; ++n) acc[a][b][m][n] = (f32x4){0.f, 0.f, 0.f, 0.f};
    bf16x8 At[4][2], B0[2][2], B1[2][2];
    const char* cA = (const char*)g.A + (size_t)cur.pm * g.apm; const char* cB = (const char*)g.Bt + (size_t)cur.pn * tstep + (size_t)cur.pm * g.bpm;
    S.a_ready(cur);
    if constexpr (SP2) {
        PG8_STAGE(PG8_SB(0, 0), cB, voffB); PG8_STAGE(PG8_SB(0, 1), cB + hstep, voffB); PG8_STAGE(PG8_SA(0, 0), cA, voffA); PG8_STAGE(PG8_SA(0, 1), cA + hstep, voffA);
        if (wr == 1) PG8_BAR;
        PG8_WAIT_V(2); PG8_BAR;
        PG8_STAGE(PG8_SB(1, 0), cB + kstep, voffB); PG8_STAGE(PG8_SA(1, 0), cA + kstep, voffA); PG8_STAGE(PG8_SB(1, 1), cB + hstep + kstep, voffB);
        PG8_WAIT_V(6); PG8_BAR;
    } else {
        PG8_STAGE(PG8_SB(0, 0), cB, voffB); PG8_STAGE(PG8_SA(0, 0), cA, voffA); PG8_STAGE(PG8_SB(0, 1), cB + hstep, voffB); PG8_STAGE(PG8_SA(0, 1), cA + hstep, voffA);
        if (wr == 1) PG8_BAR;
        PG8_WAIT_V(4); PG8_BAR;
        PG8_STAGE(PG8_SB(1, 0), cB + kstep, voffB); PG8_STAGE(PG8_SA(1, 0), cA + kstep, voffA); PG8_STAGE(PG8_SB(1, 1), cB + hstep + kstep, voffB);
        PG8_WAIT_V(6); PG8_BAR;
    }
    for (;;) {
        const bool has_next = S.next(ui + 1, nxt);
        const char* nA = has_next ? (const char*)g.A + (size_t)nxt.pm * g.apm : cA; const char* nB = has_next ? (const char*)g.Bt + (size_t)nxt.pn * tstep + (size_t)nxt.pm * g.bpm : cB;
        for (int t = 0; t < nt; t += 2) {
            const bool last = (t == nt - 2);
            const char* a1 = cA + (size_t)(t + 1) * kstep;
            const char* a2 = last ? nA : cA + (size_t)(t + 2) * kstep; const char* b2 = last ? nB : cB + (size_t)(t + 2) * kstep;
            const char* a3 = a2 + kstep; const char* b3 = b2 + kstep;
            if (last && has_next) S.a_ready(nxt);
            if constexpr (SP2) {
            PG8_LDB(B0, 0, 0); PG8_LDB(B1, 0, 1); PG8_SCHED; PG8_LDA(At, 0, 0); PG8_STAGE(PG8_SA(1, 1), a1 + hstep, voffA);
            PG8_WAIT_V(8); PG8_WAIT_L(0); PG8_BAR; PG8_MMA(0, 0, At, B0); PG8_MMA(0, 1, At, B1); PG8_BAR; PG8_SCHED;
            PG8_LDA(At, 0, 1); PG8_STAGE(PG8_SB(0, 0), b2, voffB); PG8_STAGE(PG8_SB(0, 1), b2 + hstep, voffB); PG8_STAGE(PG8_SA(0, 0), a2, voffA);
            PG8_WAIT_V(8); PG8_WAIT_L(0); PG8_BAR; PG8_MMA(1, 0, At, B0); PG8_MMA(1, 1, At, B1); PG8_BAR; PG8_SCHED;
            PG8_LDB(B0, 1, 0); PG8_LDB(B1, 1, 1); PG8_SCHED; PG8_LDA(At, 1, 0); PG8_STAGE(PG8_SA(0, 1), a2 + hstep, voffA);
            PG8_WAIT_V(8); PG8_WAIT_L(0); PG8_BAR; PG8_MMA(0, 0, At, B0); PG8_MMA(0, 1, At, B1); PG8_BAR; PG8_SCHED;
            PG8_LDA(At, 1, 1); PG8_STAGE(PG8_SB(1, 0), b3, voffB); PG8_STAGE(PG8_SB(1, 1), b3 + hstep, voffB); PG8_STAGE(PG8_SA(1, 0), a3, voffA);
            PG8_WAIT_V(8); PG8_WAIT_L(0); PG8_BAR; PG8_MMA(1, 0, At, B0); PG8_MMA(1, 1, At, B1); PG8_BAR; PG8_SCHED;
            } else {
            PG8_LDB(B0, 0, 0); PG8_SCHED; PG8_LDA(At, 0, 0); PG8_STAGE(PG8_SA(1, 1), a1 + hstep, voffA);
            PG8_WAIT_L(8); PG8_BAR; PG8_WAIT_L(0); PG8_MMA(0, 0, At, B0); PG8_BAR; PG8_SCHED;
            PG8_LDB(B1, 0, 1); PG8_STAGE(PG8_SB(0, 0), b2, voffB);
            PG8_BAR; PG8_WAIT_L(0); PG8_MMA(0, 1, At, B1); PG8_BAR;
            PG8_LDA(At, 0, 1); PG8_STAGE(PG8_SA(0, 0), a2, voffA);
            PG8_BAR; PG8_WAIT_L(0); PG8_MMA(1, 0, At, B0); PG8_BAR; PG8_SCHED;
            PG8_STAGE(PG8_SB(0, 1), b2 + hstep, voffB);
            PG8_WAIT_V(6); PG8_BAR; PG8_MMA(1, 1, At, B1); PG8_BAR;
            PG8_LDB(B0, 1, 0); PG8_SCHED; PG8_LDA(At, 1, 0); PG8_STAGE(PG8_SA(0, 1), a2 + hstep, voffA);
            PG8_WAIT_L(8); PG8_BAR; PG8_WAIT_L(0); PG8_MMA(0, 0, At, B0); PG8_BAR; PG8_SCHED;
            PG8_LDB(B1, 1, 1); PG8_STAGE(PG8_SB(1, 0), b3, voffB);
            PG8_BAR; PG8_WAIT_L(0); PG8_MMA(0, 1, At, B1); PG8_BAR;
            PG8_LDA(At, 1, 1); PG8_STAGE(PG8_SA(1, 0), a3, voffA);
            PG8_BAR; PG8_WAIT_L(0); PG8_MMA(1, 0, At, B0); PG8_BAR; PG8_SCHED;
            PG8_STAGE(PG8_SB(1, 1), b3 + hstep, voffB);
            PG8_WAIT_V(6); PG8_BAR; PG8_MMA(1, 1, At, B1); PG8_BAR;
            }
        }
        if constexpr (ALIGN_EPI) { if (wr == 0) PG8_BAR; }
        if constexpr (!Epi::AFTER_DRAIN) { E(acc, cur, wr, wc, fr, fq); S.done(cur); }
        if (!has_next) break;
#pragma unroll
        for (int a = 0; a < 2; ++a)
#pragma unroll
            for (int b = 0; b < 2; ++b)
#pragma unroll
                for (int m = 0; m < 4; ++m)
#pragma unroll
                    for (int n = 0; n < 2; ++n) acc[a][b][m][n] = (f32x4){0.f, 0.f, 0.f, 0.f};
        cur = nxt; cA = nA; cB = nB; ++ui;
        if constexpr (ALIGN_EPI) { if (wr == 1) PG8_BAR; }
    }
    PG8_WAIT_V(0);
    if constexpr (!ALIGN_EPI) { if (wr == 0) PG8_BAR; }
    PG8_BAR;
    if constexpr (Epi::AFTER_DRAIN) { E.fused(acc, cur, wr, wc, fr, fq, lds, wid, lane); S.done(cur); }
#undef PG8_SA
#undef PG8_SB
#undef PG8_STAGE
#undef PG8_LDA
#undef PG8_LDB
#undef PG8_MMA
#undef PG8_WAIT_V
#undef PG8_WAIT_L
#undef PG8_BAR
#undef PG8_SCHED
}
}
#define GAS __attribute__((address_space(1)))
#define LAS __attribute__((address_space(3)))
typedef unsigned short bf16;
typedef unsigned v4u __attribute__((ext_vector_type(4)));
typedef float f32x4 __attribute__((ext_vector_type(4)));
typedef short bf16x8 __attribute__((ext_vector_type(8)));
typedef GAS unsigned gu32;
typedef GAS unsigned long long gu64;
#define RLX_AGENT __ATOMIC_RELAXED, __HIP_MEMORY_SCOPE_AGENT
#define LDS_WAIT() asm volatile("s_waitcnt lgkmcnt(0)" ::: "memory")
#define VM_WAIT() asm volatile("s_waitcnt vmcnt(0)" ::: "memory")
__device__ __forceinline__ unsigned long long rt() { return __builtin_amdgcn_s_memrealtime(); }
__device__ __forceinline__ unsigned f2bf(float f) { unsigned u = __builtin_bit_cast(unsigned, f); return (u + 0x7fffu + ((u >> 16) & 1u)) >> 16; }
__device__ __forceinline__ unsigned pk2(float lo, float hi) { return f2bf(lo) | (f2bf(hi) << 16); }

#define XB_TMO      128
#define XB_XCNT(j)  (256  + 64 * (j))
#define XB_XSUB(j)  (1280 + 64 * (j))
#define XB_XGEN(j)  (2304 + 64 * (j))
#define XB_TOP      3328
#define XB_TOPGEN   3392
#define XCD_BAR_WORDS 3456
#define XB_SPIN_CAP (1u << 18)

__device__ __forceinline__ unsigned xb_ld(unsigned* p)              { return __hip_atomic_load(p, __ATOMIC_RELAXED, __HIP_MEMORY_SCOPE_AGENT); }
__device__ __forceinline__ unsigned xb_add(unsigned* p, unsigned v) { return __hip_atomic_fetch_add(p, v, __ATOMIC_RELAXED, __HIP_MEMORY_SCOPE_AGENT); }
__device__ __forceinline__ unsigned xb_xcc_id() { return (unsigned)__builtin_amdgcn_s_getreg((3 << 11) | 20) & 0xFu; }
#define XB_SPIN(cond, bar) do { unsigned _sp = 0; while (cond) { __builtin_amdgcn_s_sleep(1); \
    if ((++_sp & 255u) == 0u) { if (xb_ld(&(bar)[XB_TMO])) break; if (_sp > XB_SPIN_CAP) { atomicAdd(&(bar)[XB_TMO], 1u); break; } } } } while (0)

struct XcdBarrier {
    unsigned* bar; unsigned x;
    volatile LAS unsigned* st;
    int wave;
};
__device__ __forceinline__ int xb_lane() { int l; asm volatile("v_mbcnt_lo_u32_b32 %0, -1, 0\n\tv_mbcnt_hi_u32_b32 %0, -1, %0" : "=v"(l)); return l; }

__device__ __forceinline__ XcdBarrier xcd_barrier_post(unsigned* bar, volatile LAS unsigned* st) {
    XcdBarrier b; b.bar = bar; b.x = xb_xcc_id(); b.st = st; b.wave = 0;
    if (threadIdx.x == 0) (void)xb_add(&bar[XB_XCNT(b.x)], 1u);
    return b;
}
__device__ __forceinline__ void xcd_barrier_complete(unsigned* bar, unsigned x, unsigned& nloc, unsigned& nx) {
    const unsigned G = gridDim.x * gridDim.y * gridDim.z;
    unsigned sum, cnt, mine, sp = 0u;
    for (;;) {
        sum = 0u; cnt = 0u; mine = 0u;
#pragma unroll
        for (unsigned j = 0; j < 16; ++j) { const unsigned c = xb_ld(&bar[XB_XCNT(j)]); sum += c; cnt += (c > 0u) ? 1u : 0u; mine = (j == x) ? c : mine; }
        if (sum == G) break;
        __builtin_amdgcn_s_sleep(1);
        if ((++sp & 255u) == 0u) { if (xb_ld(&bar[XB_TMO])) break; if (sp > XB_SPIN_CAP) { atomicAdd(&bar[XB_TMO], 1u); break; } }
    }
    nloc = mine > 0u ? mine : 1u; nx = cnt > 0u ? cnt : 1u;
}

__device__ __forceinline__ void xcd_barrier(const XcdBarrier& b) {
    asm volatile("s_waitcnt vmcnt(0)" ::: "memory");
    __syncthreads();
    if (b.wave == 0 && xb_lane() == 0) {
        unsigned* bar = b.bar;
        __builtin_amdgcn_s_waitcnt(0);
        unsigned nloc = b.st[0], nx = b.st[1];
        if (nloc == 0u) { xcd_barrier_complete(bar, b.x, nloc, nx); b.st[0] = nloc; b.st[1] = nx; }
        const unsigned old = xb_add(&bar[XB_XSUB(b.x)], 1u);
        const unsigned gen = old / nloc;
        if (old + 1u == (gen + 1u) * nloc) {
            __builtin_amdgcn_fence(__ATOMIC_RELEASE, "agent");
            asm volatile("s_waitcnt vmcnt(0)" ::: "memory");
            const unsigned og = xb_add(&bar[XB_TOP], 1u);
            const unsigned tg = og / nx;
            if (og + 1u == (tg + 1u) * nx) xb_add(&bar[XB_TOPGEN], 1u);
            else XB_SPIN(xb_ld(&bar[XB_TOPGEN]) == tg, bar);
            __builtin_amdgcn_fence(__ATOMIC_ACQUIRE, "agent");
            xb_add(&bar[XB_XGEN(b.x)], 1u);
            asm volatile("s_waitcnt vmcnt(0)" ::: "memory");
        } else {
            XB_SPIN(xb_ld(&bar[XB_XGEN(b.x)]) == gen, bar);
            __builtin_amdgcn_fence(__ATOMIC_ACQUIRE, "agent");
            asm volatile("s_waitcnt vmcnt(0)" ::: "memory");
        }
    }
    __syncthreads();
}

#ifndef BG_CONV
#define BG_CONV 1
#endif
constexpr int NWAVES = 8, NTHR = 512;
constexpr int DM = 4096, SEQ = 8192, CTXL = 256, MROWS = SEQ + CTXL, DFF = 8192, NMODC = 9 * DM;
constexpr int RWW = 2048, RWCOLS = 6592, ZC = 8192;
constexpr int LDS_BYTES = 155648;
constexpr int MISC_OFF = 151552;

constexpr size_t MiB = 1u << 20;
constexpr size_t al(size_t x) { return (x + MiB - 1) / MiB * MiB; }
constexpr size_t WS_CTL = 0, WS_MOD = 1 * MiB, ZERO_BYTES = 2 * MiB;
constexpr size_t SZ_WFI = (size_t)16384 * 4096 * 2, SZ_WFO = (size_t)4096 * 8192 * 2, SZ_WIN = (size_t)8192 * 4096 * 2, SZ_WOUT = (size_t)4096 * 4096 * 2;
constexpr size_t SZ_WQ = (size_t)3072 * 1024 * 2, SZ_WKV = (size_t)4096 * 512 * 2, SZ_WWA = (size_t)10240 * 512 * 2, SZ_WG = 0;
constexpr size_t WS_WFI = 2 * MiB, WS_WFO = WS_WFI + 4 * SZ_WFI, WS_WIN = WS_WFO + 4 * SZ_WFO, WS_WOUT = WS_WIN + 2 * SZ_WIN, WS_WQ = WS_WOUT + 2 * SZ_WOUT;
constexpr size_t WS_WKV = WS_WQ + 2 * SZ_WQ, WS_WWA = WS_WKV + 2 * SZ_WKV, WS_WG = WS_WWA + 2 * SZ_WWA, WS_ACT = WS_WG + 2 * SZ_WG;
constexpr size_t WS_X = WS_ACT;
constexpr size_t WS_XN = WS_X + al((size_t)MROWS * DM * 4);
constexpr size_t WS_H = WS_XN + al((size_t)MROWS * DM * 2);
constexpr size_t WS_Z = WS_H + al((size_t)MROWS * DFF * 2);
constexpr size_t WS_SS = WS_Z + al((size_t)MROWS * ZC * 4);
constexpr size_t WS_VV = WS_SS + al((size_t)MROWS * 4096 * 4);
constexpr size_t WS_KT = WS_VV + al((size_t)MROWS * 2048 * 4);
constexpr size_t WS_LW = WS_KT + al((size_t)MROWS * 2048 * 4);
constexpr size_t WS_LWA = WS_LW + al((size_t)MROWS * 10240 * 4);
constexpr size_t WS_LG = WS_LWA + al((size_t)MROWS * 512 * 2);
constexpr size_t WS_QL = WS_LG + al((size_t)MROWS * 256 * 2);
constexpr size_t WS_KVL = WS_QL + al((size_t)MROWS * 1024 * 2);
constexpr size_t WS_QF = WS_KVL + al((size_t)MROWS * 512 * 2);
constexpr size_t WS_KVF = WS_QF + al((size_t)MROWS * 3072 * 4);
#ifndef QB_GAP
#define QB_GAP 0
#endif
constexpr size_t WS_QB = WS_KVF + al((size_t)MROWS * 4096 * 4) + (size_t)QB_GAP * MiB;
constexpr size_t WS_KB = WS_QB + al((size_t)MROWS * 3072 * 2);
constexpr size_t WS_VB = WS_KB + al((size_t)MROWS * 3072 * 2);
constexpr size_t WS_Y = WS_VB + al((size_t)MROWS * 2048 * 2);
constexpr size_t WS_OC = WS_Y + al((size_t)2 * MROWS * 2048 * 4);
constexpr int SK_NS = 8;
constexpr size_t WS_ACC = WS_OC + al((size_t)MROWS * DM * 2);
constexpr size_t SZ_ACC = (size_t)CTXL * DM * 4;
constexpr size_t WS_SLB = WS_ACC + SK_NS * SZ_ACC;
constexpr size_t WS_END = WS_SLB + 32 * MiB;
constexpr int CW_BAR = 4096, CW_MIX = 8192;

enum { I_X = 0, I_C, I_CTX, I_CCTX, I_WMOD, I_BMOD, I_NORMG, I_FWI, I_FWO, I_WIN, I_WOUT, I_MU, I_W0, I_WUP, I_A0, I_AUP, I_GUP, I_KK, I_KA, I_RK, I_LNW, I_LNB,
       I_QNORM, I_QUP, I_KVNORM, I_KVUP, I_QGAIN, I_KGAIN, N_IN };

__device__ __forceinline__ int lane_vol() { int l; asm volatile("v_mbcnt_lo_u32_b32 %0, -1, 0\n\tv_mbcnt_hi_u32_b32 %0, -1, %0" : "=v"(l)); return l; }
__device__ __forceinline__ float wave_sum(float v) {
#pragma unroll
    for (int o = 1; o < 64; o <<= 1) v += __shfl_xor(v, o);
    return v;
}
__device__ __forceinline__ float sum16(float v) {
#pragma unroll
    for (int o = 1; o < 16; o <<= 1) v += __shfl_xor(v, o);
    return v;
}
__device__ __forceinline__ float sigm(float x) { return __builtin_amdgcn_rcpf(1.f + __builtin_amdgcn_exp2f(-1.4426950408889634f * x)); }
__device__ __forceinline__ float dot4(f32x4 a, f32x4 b) { return (a.x * b.x + a.y * b.y) + (a.z * b.z + a.w * b.w); }
typedef unsigned u32x2 __attribute__((ext_vector_type(2)));
__device__ __forceinline__ f32x4 ubf4(u32x2 w) { f32x4 r; r.x = __uint_as_float(w.x << 16); r.y = __uint_as_float(w.x & 0xffff0000u); r.z = __uint_as_float(w.y << 16); r.w = __uint_as_float(w.y & 0xffff0000u); return r; }
__device__ __forceinline__ u32x2 pk4(f32x4 v) { u32x2 r; r.x = pg8::cvt_pk_bf16(v.x, v.y); r.y = pg8::cvt_pk_bf16(v.z, v.w); return r; }

struct EpiSwiGLU {
    static constexpr bool PERM = true, AFTER_DRAIN = false;
    bf16* H;
    __device__ __forceinline__ void operator()(const pg8::f32x4 (&acc)[2][2][4][2], const pg8::Unit& u, int wr, int wc, int fr, int fq) const {
        const int row0 = u.pm * 256 + wr * 64 + fr, col0 = u.pn * 128 + wc * 32 + 8 * fq;
#pragma unroll
        for (int ai = 0; ai < 2; ++ai)
#pragma unroll
            for (int m = 0; m < 4; ++m) {
                bf16* rowp = H + (size_t)(row0 + ai * 128 + m * 16) * DFF + col0;
                const pg8::f32x4 g0 = acc[ai][0][m][0], g1 = acc[ai][0][m][1], u0 = acc[ai][1][m][0], u1 = acc[ai][1][m][1];
                pg8::u32x4 w;
                w.x = pg8::cvt_pk_bf16(g0[0] * sigm(g0[0]) * u0[0], g0[1] * sigm(g0[1]) * u0[1]);
                w.y = pg8::cvt_pk_bf16(g0[2] * sigm(g0[2]) * u0[2], g0[3] * sigm(g0[3]) * u0[3]);
                w.z = pg8::cvt_pk_bf16(g1[0] * sigm(g1[0]) * u1[0], g1[1] * sigm(g1[1]) * u1[1]);
                w.w = pg8::cvt_pk_bf16(g1[2] * sigm(g1[2]) * u1[2], g1[3] * sigm(g1[3]) * u1[3]);
                *(pg8::u32x4*)rowp = w;
            }
    }
};
struct EpiRes {
    static constexpr bool PERM = false, AFTER_DRAIN = false;
    const float* inL; const float* inC; float* outL; float* outC; const float* gateL; const float* gateC; float coef;
    __device__ __forceinline__ void operator()(const pg8::f32x4 (&acc)[2][2][4][2], const pg8::Unit& u, int wr, int wc, int fr, int fq) const {
        const bool lat = u.pm < 32;
        const int rl0 = (lat ? u.pm : u.pm - 32) * 256 + wr * 64 + fr, col0 = u.pn * 256 + wc * 32 + 4 * fq;
        const float* in = lat ? inL : inC; float* out = lat ? outL : outC; const float* gate = lat ? gateL : gateC;
        pg8::f32x4 gv[2][2];
#pragma unroll
        for (int bj = 0; bj < 2; ++bj)
#pragma unroll
            for (int n = 0; n < 2; ++n) gv[bj][n] = *(const pg8::f32x4*)(gate + col0 + bj * 128 + n * 16) * coef;
#pragma unroll
        for (int ai = 0; ai < 2; ++ai)
#pragma unroll
            for (int m = 0; m < 4; ++m) {
                const size_t off = (size_t)(rl0 + ai * 128 + m * 16) * DM + col0;
#pragma unroll
                for (int bj = 0; bj < 2; ++bj)
#pragma unroll
                    for (int n = 0; n < 2; ++n) { const pg8::f32x4 xi = *(const pg8::f32x4*)(in + off + bj * 128 + n * 16);
                        *(pg8::f32x4*)(out + off + bj * 128 + n * 16) = xi + gv[bj][n] * acc[ai][bj][m][n]; }
            }
    }
};
struct EpiSlab {
    static constexpr bool PERM = false, AFTER_DRAIN = false;
    float* out; const float* gate; float coef;
    __device__ __forceinline__ void operator()(const pg8::f32x4 (&acc)[2][2][4][2], const pg8::Unit& u, int wr, int wc, int fr, int fq) const {
        const int rl0 = wr * 64 + fr, col0 = u.pn * 256 + wc * 32 + 4 * fq;
        float* o = out + (size_t)u.pm * CTXL * DM;
        pg8::f32x4 gv[2][2];
#pragma unroll
        for (int bj = 0; bj < 2; ++bj)
#pragma unroll
            for (int n = 0; n < 2; ++n) gv[bj][n] = *(const pg8::f32x4*)(gate + col0 + bj * 128 + n * 16) * coef;
#pragma unroll
        for (int ai = 0; ai < 2; ++ai)
#pragma unroll
            for (int m = 0; m < 4; ++m) {
                const size_t off = (size_t)(rl0 + ai * 128 + m * 16) * DM + col0;
#pragma unroll
                for (int bj = 0; bj < 2; ++bj)
#pragma unroll
                    for (int n = 0; n < 2; ++n) *(pg8::f32x4*)(o + off + bj * 128 + n * 16) = gv[bj][n] * acc[ai][bj][m][n];
            }
    }
};
struct EpiB16 {
    static constexpr bool PERM = true, AFTER_DRAIN = false;
    bf16* C; int ldc;
    __device__ __forceinline__ void operator()(const pg8::f32x4 (&acc)[2][2][4][2], const pg8::Unit& u, int wr, int wc, int fr, int fq) const {
        const int row0 = u.pm * 256 + wr * 64 + fr, col0 = u.pn * 256 + wc * 32 + 8 * fq;
#pragma unroll
        for (int ai = 0; ai < 2; ++ai)
#pragma unroll
            for (int m = 0; m < 4; ++m) { bf16* rowp = C + (size_t)(row0 + ai * 128 + m * 16) * ldc + col0;
#pragma unroll
                for (int bj = 0; bj < 2; ++bj) { const pg8::f32x4 v0 = acc[ai][bj][m][0], v1 = acc[ai][bj][m][1]; pg8::u32x4 w;
                    w.x = pg8::cvt_pk_bf16(v0[0], v0[1]); w.y = pg8::cvt_pk_bf16(v0[2], v0[3]); w.z = pg8::cvt_pk_bf16(v1[0], v1[1]); w.w = pg8::cvt_pk_bf16(v1[2], v1[3]);
                    *(pg8::u32x4*)(rowp + bj * 128) = w; } }
    }
};
struct EpiSlabP {
    static constexpr bool PERM = true, AFTER_DRAIN = false;
    float* out; int ldo;
    __device__ __forceinline__ void operator()(const pg8::f32x4 (&acc)[2][2][4][2], const pg8::Unit& u, int wr, int wc, int fr, int fq) const {
        const int row0 = wr * 64 + fr, col0 = u.pn * 256 + wc * 32 + 8 * fq;
        float* o = out + (size_t)u.pm * CTXL * ldo;
#pragma unroll
        for (int ai = 0; ai < 2; ++ai)
#pragma unroll
            for (int m = 0; m < 4; ++m) { float* rowp = o + (size_t)(row0 + ai * 128 + m * 16) * ldo + col0;
#pragma unroll
                for (int bj = 0; bj < 2; ++bj) { *(pg8::f32x4*)(rowp + bj * 128) = acc[ai][bj][m][0]; *(pg8::f32x4*)(rowp + bj * 128 + 4) = acc[ai][bj][m][1]; } }
    }
};
struct EpiF32 {
    static constexpr bool PERM = false, AFTER_DRAIN = false;
    float* C; int ldc;
    __device__ __forceinline__ void operator()(const pg8::f32x4 (&acc)[2][2][4][2], const pg8::Unit& u, int wr, int wc, int fr, int fq) const {
        const int row0 = u.pm * 256 + wr * 64 + fr, col0 = u.pn * 256 + wc * 32 + 4 * fq;
#pragma unroll
        for (int ai = 0; ai < 2; ++ai)
#pragma unroll
            for (int m = 0; m < 4; ++m) { float* rowp = C + (size_t)(row0 + ai * 128 + m * 16) * ldc + col0;
#pragma unroll
                for (int bj = 0; bj < 2; ++bj)
#pragma unroll
                    for (int n = 0; n < 2; ++n) *(pg8::f32x4*)(rowp + bj * 128 + n * 16) = acc[ai][bj][m][n]; }
    }
};
template <int MAP> __device__ __forceinline__ int map_row(int n) {
    if (MAP == 1) { const int bj = n >> 13, r = n & 8191; return 256 * (r >> 7) + 128 * bj + (r & 127); }
    return n;
}
template <int MAP> __device__ __forceinline__ void transpose_item(const float* W, int K, int N, bf16* WT, LAS float* scr, int item, int lane) {
    const int nblk = N >> 6, kb = item / nblk, nb = item - kb * nblk, k0 = kb * 64, n0 = nb * 64;
    const int kr = lane >> 4, nq = lane & 15;
    f32x4 v[16];
#pragma unroll
    for (int i = 0; i < 16; ++i) v[i] = *(const f32x4*)(W + (size_t)(k0 + 4 * i + kr) * N + n0 + 4 * nq);
#pragma unroll
    for (int i = 0; i < 16; ++i) { const int k = 4 * i + kr;
        scr[(4 * nq + 0) * 65 + k] = v[i].x; scr[(4 * nq + 1) * 65 + k] = v[i].y; scr[(4 * nq + 2) * 65 + k] = v[i].z; scr[(4 * nq + 3) * 65 + k] = v[i].w; }
    LDS_WAIT(); asm volatile("" ::: "memory");
    const int c = lane & 7, nl = lane >> 3, r0 = map_row<MAP>(n0);
#pragma unroll
    for (int j = 0; j < 8; ++j) { const int n = nl + 8 * j; const LAS float* s = scr + n * 65 + 8 * c;
        v4u o; o.x = pk2(s[0], s[1]); o.y = pk2(s[2], s[3]); o.z = pk2(s[4], s[5]); o.w = pk2(s[6], s[7]);
        *(v4u*)(WT + (size_t)(r0 + n) * K + k0 + 8 * c) = o; }
    LDS_WAIT(); asm volatile("" ::: "memory");
}

struct Ptrs {
    const float* in[N_IN]; float* out; unsigned char* ws;
};
constexpr int PT_OFF = 151552 + 1024;
__device__ __forceinline__ unsigned long long ld_uptr(LAS unsigned char* lds, int i) {
    const unsigned long long v = *(const LAS unsigned long long*)(lds + PT_OFF + 8 * i);
    const unsigned lo = __builtin_amdgcn_readfirstlane((unsigned)v), hi = __builtin_amdgcn_readfirstlane((unsigned)(v >> 32));
    return ((unsigned long long)hi << 32) | lo;
}
__device__ __forceinline__ Ptrs load_ptrs(LAS unsigned char* lds) {
    asm volatile("" ::: "memory");
    Ptrs P;
#pragma unroll
    for (int i = 0; i < N_IN; ++i) P.in[i] = (const float*)(const GAS float*)ld_uptr(lds, i);
    P.out = (float*)(GAS float*)ld_uptr(lds, N_IN); P.ws = (unsigned char*)(GAS unsigned char*)ld_uptr(lds, N_IN + 1);
    return P;
}

__device__ __forceinline__ void prologue_phase(LAS unsigned char* lds, int vcu, int G, int wave) {
    const Ptrs P = load_ptrs(lds); const int lane = lane_vol(), tid = wave * 64 + lane;
    unsigned char* ws = P.ws;
    {
        LAS float* sil = (LAS float*)lds; LAS float* red = (LAS float*)(lds + 32768);
        for (int i = tid; i < DM; i += NTHR) { const float a = P.in[I_C][i], b = P.in[I_CCTX][i]; sil[i] = a * sigm(a); sil[DM + i] = b * sigm(b); }
        __syncthreads();
        float* MOD = (float*)(ws + WS_MOD);
        for (int u = vcu; u < (BG_CONV ? 2304 : 4608); u += G) {
            const int l = u / 2304, rem = u - l * 2304, nch = rem >> 4, ks = rem & 15;
            const float* W = P.in[I_WMOD] + (size_t)l * DM * NMODC + (size_t)(ks * 256 + wave * 32) * NMODC + nch * 256 + 4 * lane;
            f32x4 a0 = {0.f, 0.f, 0.f, 0.f}, a1 = {0.f, 0.f, 0.f, 0.f};
#pragma unroll
            for (int hb = 0; hb < 2; ++hb) {
                f32x4 wv[16];
#pragma unroll
                for (int kk = 0; kk < 16; ++kk) wv[kk] = *(const f32x4*)(W + (size_t)(hb * 16 + kk) * NMODC);
#pragma unroll
                for (int kk = 0; kk < 16; ++kk) { const int k = ks * 256 + wave * 32 + hb * 16 + kk; const float s0 = sil[k], s1 = sil[DM + k]; a0 += wv[kk] * s0; a1 += wv[kk] * s1; }
            }
            *(LAS f32x4*)(red + wave * 512 + 4 * lane) = a0; *(LAS f32x4*)(red + wave * 512 + 256 + 4 * lane) = a1;
            __syncthreads();
            { const int w = tid >> 8, col = tid & 255; float s = 0.f;
#pragma unroll
              for (int q = 0; q < 8; ++q) s += red[q * 512 + w * 256 + col];
              if (ks == 0) s += P.in[I_BMOD][l * NMODC + nch * 256 + col];
              atomicAdd(MOD + (size_t)(l * 2 + w) * NMODC + nch * 256 + col, s); }
            __syncthreads();
        }
    }
    {
        LAS float* scr = (LAS float*)(lds + wave * 16640);
        const int gw = vcu * NWAVES + wave, NGW = G * NWAVES;
        constexpr int I_FI = 64 * 256, I_FO = 128 * 64, I_IN = 64 * 128, I_OUT = 64 * 64, I_Q = 16 * 48, I_KV = 8 * 64;
        constexpr int PER_L = 2 * I_FI + 2 * I_FO + I_IN + I_OUT + I_Q + I_KV;
        for (int it = gw; it < (BG_CONV ? 1 : 2) * PER_L; it += NGW) {
            const int l = it / PER_L; int r = it - l * PER_L;
            if (r < 2 * I_FI) { const int f = r / I_FI; r -= f * I_FI;
                transpose_item<1>(P.in[I_FWI] + (size_t)(l * 2 + f) * DM * 16384, DM, 16384, (bf16*)(ws + WS_WFI + (size_t)(l * 2 + f) * SZ_WFI), scr, r, lane); continue; } r -= 2 * I_FI;
            if (r < 2 * I_FO) { const int f = r / I_FO; r -= f * I_FO;
                transpose_item<0>(P.in[I_FWO] + (size_t)(l * 2 + f) * DFF * DM, DFF, DM, (bf16*)(ws + WS_WFO + (size_t)(l * 2 + f) * SZ_WFO), scr, r, lane); continue; } r -= 2 * I_FO;
            if (r < I_IN) { transpose_item<0>(P.in[I_WIN] + (size_t)l * DM * ZC, DM, ZC, (bf16*)(ws + WS_WIN + (size_t)l * SZ_WIN), scr, r, lane); continue; } r -= I_IN;
            if (r < I_OUT) { transpose_item<0>(P.in[I_WOUT] + (size_t)l * DM * DM, DM, DM, (bf16*)(ws + WS_WOUT + (size_t)l * SZ_WOUT), scr, r, lane); continue; } r -= I_OUT;
            if (r < I_Q) { transpose_item<0>(P.in[I_QUP] + (size_t)l * 1024 * 3072, 1024, 3072, (bf16*)(ws + WS_WQ + (size_t)l * SZ_WQ), scr, r, lane); continue; } r -= I_Q;
            transpose_item<0>(P.in[I_KVUP] + (size_t)l * 512 * 4096, 512, 4096, (bf16*)(ws + WS_WKV + (size_t)l * SZ_WKV), scr, r, lane);
        }
        const int gt = vcu * NTHR + tid, NGT = G * NTHR;
        for (int it = gt; it < 2 * 10240 * 64; it += NGT) {
            const int l = it / (10240 * 64), r = it - l * (10240 * 64), k8 = r / 10240, n = r - k8 * 10240;
            float v[8];
            if (n < 8192) {
                const bool isA = n >= 4096; const int d = (n >> 11) & 1, ch = n & 2047;
                const float* src = (isA ? P.in[I_AUP] : P.in[I_WUP]) + (size_t)(l * 2 + d) * 96 * RWW + ch;
#pragma unroll
                for (int j = 0; j < 8; ++j) { const int k = 8 * k8 + j - (isA ? 96 : 0); const bool ok_ = (k >= 0 && k < 96); const float t_ = src[(size_t)(ok_ ? k : 0) * RWW]; v[j] = ok_ ? t_ : 0.f; }
            } else {
                const int ch = n - 8192; const float* src = P.in[I_GUP] + (size_t)l * 256 * RWW + ch;
#pragma unroll
                for (int j = 0; j < 8; ++j) { const int k = 8 * k8 + j - 256; const bool ok_ = (k >= 0); const float t_ = src[(size_t)(ok_ ? k : 0) * RWW]; v[j] = ok_ ? t_ : 0.f; }
            }
            v4u o; o.x = pk2(v[0], v[1]); o.y = pk2(v[2], v[3]); o.z = pk2(v[4], v[5]); o.w = pk2(v[6], v[7]);
            *(v4u*)((bf16*)(ws + WS_WWA + (size_t)l * SZ_WWA) + (size_t)n * 512 + 8 * k8) = o;
        }
    }
}

__device__ __forceinline__ void prep_phase(LAS unsigned char* lds, const float* srcL, const float* srcC, int nrows, const float* g, const float* modL, const float* modC, int jm,
                                           bf16* XN, int gw, int NGW, int wave, const float* accC = nullptr, float* wbC = nullptr) {
    int lane = lane_vol(); const int tid = wave * 64 + lane;
    LAS float* gsL = (LAS float*)lds; LAS float* shL = gsL + DM; LAS float* gsC = shL + DM; LAS float* shC = gsC + DM;
    for (int i = tid; i < DM; i += NTHR) { const float gg = g[i];
        gsL[i] = gg * (1.f + modL[(jm + 1) * DM + i]); shL[i] = modL[jm * DM + i]; gsC[i] = gg * (1.f + modC[(jm + 1) * DM + i]); shC[i] = modC[jm * DM + i]; }
    __syncthreads();
    for (int row = gw; row < (nrows < SEQ ? nrows : SEQ); row += NGW) {
        asm volatile("" : "+v"(lane));
        const bool lat = row < SEQ;
        const f32x4* xr = (const f32x4*)(lat ? srcL + (size_t)row * DM : srcC + (size_t)(row - SEQ) * DM) + lane;
        const LAS float* gs = lat ? gsL : gsC; const LAS float* sh = lat ? shL : shC;
        f32x4 v[16]; float ss = 0.f;
#pragma unroll
        for (int j = 0; j < 16; ++j) { v[j] = xr[64 * j]; ss += dot4(v[j], v[j]); }
        const float rstd = 1.0f / sqrtf(wave_sum(ss) * (1.f / DM) + 1e-6f);
        u32x2* o = (u32x2*)(XN + (size_t)row * DM) + lane;
#pragma unroll
        for (int j = 0; j < 16; ++j) { const int c = 4 * (lane + 64 * j); const f32x4 g4 = *(const LAS f32x4*)(gs + c), s4 = *(const LAS f32x4*)(sh + c);
            o[64 * j] = pk4(v[j] * rstd * g4 + s4); }
    }
    if (nrows > SEQ) {
        LAS float* red = (LAS float*)(lds + 65536);
        for (int s = gw >> 3; s < CTXL; s += NGW >> 3) {
            asm volatile("" : "+v"(lane));
            const int c0 = wave * 512 + 4 * lane;
            const float* xr = srcC + (size_t)s * DM + c0;
            f32x4 v0 = *(const f32x4*)xr, v1 = *(const f32x4*)(xr + 256);
            if (accC != nullptr) {
#pragma unroll
                for (int sl = 0; sl < SK_NS; ++sl) { const float* a = accC + ((size_t)sl * CTXL + s) * DM + c0; v0 += *(const f32x4*)a; v1 += *(const f32x4*)(a + 256); }
                *(f32x4*)(wbC + (size_t)s * DM + c0) = v0; *(f32x4*)(wbC + (size_t)s * DM + c0 + 256) = v1;
            }
            const float ssw = wave_sum(dot4(v0, v0) + dot4(v1, v1));
            __syncthreads();
            if (lane == 0) red[wave] = ssw;
            __syncthreads();
            float tot = 0.f;
#pragma unroll
            for (int w = 0; w < NWAVES; ++w) tot += red[w];
            const float rstd = 1.0f / sqrtf(tot * (1.f / DM) + 1e-6f);
            bf16* o = XN + (size_t)(SEQ + s) * DM + c0;
            *(u32x2*)o = pk4(v0 * rstd * *(const LAS f32x4*)(gsC + c0) + *(const LAS f32x4*)(shC + c0));
            *(u32x2*)(o + 256) = pk4(v1 * rstd * *(const LAS f32x4*)(gsC + c0 + 256) + *(const LAS f32x4*)(shC + c0 + 256));
        }
    }
    __syncthreads();
}

__device__ __forceinline__ void ctx_reduce_z(const Ptrs& P, int vcu, int G, int wave) {
    int lane = lane_vol(); unsigned char* ws = P.ws;
    const float* slab = (const float*)(ws + WS_SLB); bf16* Z = (bf16*)(ws + WS_Z);
    for (int s = vcu; s < CTXL; s += G) {
        asm volatile("" : "+v"(lane));
#pragma unroll
        for (int j = 0; j < 4; ++j) { const int c = wave * 1024 + 256 * j + 4 * lane; f32x4 a = {0.f, 0.f, 0.f, 0.f};
#pragma unroll
            for (int sl = 0; sl < 4; ++sl) a += *(const f32x4*)(slab + ((size_t)sl * CTXL + s) * ZC + c);
            *(u32x2*)(Z + (size_t)(SEQ + s) * ZC + c) = pk4(a); }
    }
}

__device__ __forceinline__ void streams_phase(const Ptrs& P, int l, int gw, int NGW) {
    int lane = lane_vol();
    unsigned char* ws = P.ws;
    const bf16* Z = (const bf16*)(ws + WS_Z); bf16* SS = (bf16*)(ws + WS_SS); bf16* VV = (bf16*)(ws + WS_VV); bf16* KT = (bf16*)(ws + WS_KT);
    bf16* LWA = (bf16*)(ws + WS_LWA); bf16* QL = (bf16*)(ws + WS_QL); bf16* KVL = (bf16*)(ws + WS_KVL);
    const float* mu = P.in[I_MU] + l * RWCOLS; const float* k_k = P.in[I_KK] + l * RWW; const float* qn = P.in[I_QNORM] + l * 1024; const float* kvn = P.in[I_KVNORM] + l * 512;
    for (int row = gw; row < MROWS; row += NGW) {
        asm volatile("" : "+v"(lane));
        int nb0, nb1, nb2, nb3; bool ok0, ok1, ok2, ok3;
        if (row < SEQ) { const int gr = row >> 6, gc = row & 63; nb0 = row - 1; ok0 = gc > 0; nb1 = row + 1; ok1 = gc < 63; nb2 = row - 64; ok2 = gr > 0; nb3 = row + 64; ok3 = gr < 127; }
        else { const int s = row - SEQ; nb0 = nb1 = row - 1; ok0 = ok1 = s > 0; nb2 = nb3 = row + 1; ok2 = ok3 = s < CTXL - 1; }
        const bf16* zr = Z + (size_t)row * ZC;
#pragma unroll
        for (int sg = 0; sg < 4; ++sg) {
            const int i0_ = 8 * sg, ni = (sg < 3) ? 8 : 2;
            u32x2 zz_[8], zn_[8]; f32x4 mu_[8];
#pragma unroll
            for (int ii = 0; ii < ni; ++ii) { const int i = i0_ + ii; const int c4 = lane + 64 * i; const bool act = (i < 25 || lane < 48); const int c = 4 * (act ? c4 : 0);
                const int q = (c4 >= 412) + (c4 >= 824) + (c4 >= 1236);
                const int nrow = q == 0 ? nb0 : q == 1 ? nb1 : q == 2 ? nb2 : nb3; const bool nok = q == 0 ? ok0 : q == 1 ? ok1 : q == 2 ? ok2 : ok3;
                zz_[ii] = *(const u32x2*)(zr + c);
                u32x2 znr = *(const u32x2*)(Z + (size_t)(nok ? nrow : row) * ZC + c); if (!nok) { znr.x = 0u; znr.y = 0u; }
                zn_[ii] = znr; mu_[ii] = *(const f32x4*)(mu + c); }
#pragma unroll
            for (int ii = 0; ii < ni; ++ii) { const int i = i0_ + ii; const int c4 = lane + 64 * i, c = 4 * c4;
              if (i < 25 || lane < 48) {
                const f32x4 z = ubf4(zz_[ii]);
                const f32x4 zn = ubf4(zn_[ii]);
                const f32x4 zs = z + (zn - z) * mu_[ii];
                if (i < 8) { const int h = c >> 6, e = c & 63; *(u32x2*)(SS + ((size_t)(row * 32 + h) * 2) * 64 + e) = pk4(zs); }
                else if (i < 16) { const int ch = c - 2048, h = ch >> 6, e = ch & 63; *(u32x2*)(KT + (size_t)row * RWW + ch) = pk4(zs);
                    const f32x4 kr = zs * *(const f32x4*)(k_k + ch); const float ss = sum16(dot4(kr, kr)); const float inv = 1.f / fmaxf(sqrtf(ss), 1e-12f);
                    *(u32x2*)(SS + ((size_t)(row * 32 + h) * 2 + 1) * 64 + e) = pk4(kr * inv); }
                else if (i < 24) { *(u32x2*)(VV + (size_t)row * RWW + (c - 4096)) = pk4(zs); }
                else if (i == 24) {
                    if (lane < 24) { f32x4 t;
#pragma unroll
                        for (int j = 0; j < 4; ++j) t[j] = 1.f - 2.f * __builtin_amdgcn_rcpf(1.f + __builtin_amdgcn_exp2f(2.885390081777927f * zs[j]));
                        *(u32x2*)(LWA + (size_t)row * 512 + 4 * lane) = pk4(t); }
                    else if (lane < 48) { *(u32x2*)(LWA + (size_t)row * 512 + 96 + 4 * (lane - 24)) = pk4(zs); }
                    else { f32x4 t;
#pragma unroll
                        for (int j = 0; j < 4; ++j) t[j] = sigm(zs[j]);
                        *(u32x2*)(LWA + (size_t)row * 512 + 256 + 4 * (lane - 48)) = pk4(t); }
                } else { f32x4 t;
#pragma unroll
                    for (int j = 0; j < 4; ++j) t[j] = sigm(zs[j]);
                    *(u32x2*)(LWA + (size_t)row * 512 + 256 + 64 + 4 * lane) = pk4(t); }
              }
            }
        }
        if (lane < 16) { unsigned z0 = 0u; asm volatile("" : "+v"(z0)); u32x2 zz; zz.x = z0; zz.y = z0; *(u32x2*)(LWA + (size_t)row * 512 + 192 + 4 * lane) = zz; }
        { f32x4 v[4]; float ss = 0.f;
#pragma unroll
          for (int j = 0; j < 4; ++j) { v[j] = ubf4(*(const u32x2*)(zr + RWCOLS + 4 * (lane + 64 * j))); ss += dot4(v[j], v[j]); }
          const float rstd = 1.0f / sqrtf(wave_sum(ss) * (1.f / 1024.f) + 1e-6f);
#pragma unroll
          for (int j = 0; j < 4; ++j) { const int c = 4 * (lane + 64 * j); *(u32x2*)(QL + (size_t)row * 1024 + c) = pk4(v[j] * rstd * *(const f32x4*)(qn + c)); } }
        { f32x4 v[2]; float ss = 0.f;
#pragma unroll
          for (int j = 0; j < 2; ++j) { v[j] = ubf4(*(const u32x2*)(zr + RWCOLS + 1024 + 4 * (lane + 64 * j))); ss += dot4(v[j], v[j]); }
          const float rstd = 1.0f / sqrtf(wave_sum(ss) * (1.f / 512.f) + 1e-6f);
#pragma unroll
          for (int j = 0; j < 2; ++j) { const int c = 4 * (lane + 64 * j); *(u32x2*)(KVL + (size_t)row * 512 + c) = pk4(v[j] * rstd * *(const f32x4*)(kvn + c)); } }
    }
}

#ifndef QKN_ST
#define QKN_ST 1
#endif
#ifndef QKN_VST
#define QKN_VST 1
#endif
__device__ __forceinline__ void qknorm_phase(const Ptrs& P, int l, int gw, int NGW) {
    const int lane = lane_vol();
    unsigned char* ws = P.ws;
    const bf16* Z = (const bf16*)(ws + WS_Z); const bf16* QF = (const bf16*)(ws + WS_QF); const bf16* KVF = (const bf16*)(ws + WS_KVF);
    bf16* QB = (bf16*)(ws + WS_QB); bf16* KB = (bf16*)(ws + WS_KB); bf16* VB = (bf16*)(ws + WS_VB);
    const float* qg = P.in[I_QGAIN] + l * 192; const float* kg = P.in[I_KGAIN] + l * 192;
    const int lc = lane < 48 ? lane : 47, l32 = lane < 32 ? lane : 31;
    const f32x4 qg4 = *(const f32x4*)(qg + 4 * lc), kg4 = *(const f32x4*)(kg + 4 * lc);
    const int rl = lane - 32, ax = (rl >> 3) & 1, hf = (rl >> 2) & 1, f0 = 4 * (lane & 3);
    const bool rot = lane >= 32 && lane < 48;
    f32x4 invf;
#pragma unroll
    for (int j = 0; j < 4; ++j) invf[j] = exp2f(-(float)(f0 + j) * (13.287712379549449f / 16.f)) * 0.15915494309189535f;
    u32x2 nq_[4], nk_[4], nv_[4], nkr_;
#define QKN_LOAD(itx) do { const int row_ = (itx) >> 2, hq_ = ((itx) & 3) * 4; nkr_ = *(const u32x2*)(Z + (size_t)row_ * ZC + 8128 + 4 * (rot ? rl : 0)); \
        _Pragma("unroll") for (int hh = 0; hh < 4; ++hh) { const int h = hq_ + hh; nq_[hh] = *(const u32x2*)(QF + (size_t)row_ * 3072 + h * 192 + 4 * lc); \
            nk_[hh] = *(const u32x2*)(KVF + (size_t)row_ * 4096 + h * 256 + 4 * l32); nv_[hh] = *(const u32x2*)(KVF + (size_t)row_ * 4096 + h * 256 + 128 + 4 * l32); } } while (0)
    QKN_LOAD(gw < MROWS * 4 ? gw : 0);
    for (int it = gw; it < MROWS * 4; it += NGW) {
        const int row = it >> 2, h0 = (it & 3) * 4; const bool lat = row < SEQ;
        f32x4 cs = {1.f, 1.f, 1.f, 1.f}, sn = {0.f, 0.f, 0.f, 0.f};
        if (lat && rot) { const float pos = (float)(ax == 0 ? (row >> 6) : (row & 63));
#pragma unroll
            for (int j = 0; j < 4; ++j) { const float rev = pos * invf[j]; const float fr = rev - floorf(rev); cs[j] = __builtin_amdgcn_cosf(fr); sn[j] = __builtin_amdgcn_sinf(fr); } }
        u32x2 krr = nkr_; if (!rot) { krr.x = 0u; krr.y = 0u; }
        const f32x4 kr4 = ubf4(krr);
        const float ssr = wave_sum(rot ? dot4(kr4, kr4) : 0.f);
        u32x2 qq_[4], kq_[4], vv_[4];
#pragma unroll
        for (int hh = 0; hh < 4; ++hh) { qq_[hh] = nq_[hh]; kq_[hh] = nk_[hh]; vv_[hh] = nv_[hh]; }
        QKN_LOAD(it + NGW < MROWS * 4 ? it + NGW : it);
#pragma unroll
        for (int hh = 0; hh < 4; ++hh) {
            const int h = h0 + hh;
            u32x2 qq = qq_[hh]; if (lane >= 48) { qq.x = 0u; qq.y = 0u; }
            const f32x4 q4 = ubf4(qq);
            { const float ss = wave_sum(dot4(q4, q4)); const float rstd = 1.0f / sqrtf(ss * (1.f / 192.f) + 1e-6f);
              f32x4 x = q4 * rstd * qg4; f32x4 o;
#pragma unroll
              for (int j = 0; j < 4; ++j) o[j] = __shfl_xor(x[j], 4);
              if (lat && rot) { if (hf == 0) x = x * cs - o * sn; else x = o * sn + x * cs; }
              if (QKN_ST && lane < 48) *(u32x2*)(QB + (size_t)row * 3072 + h * 192 + 4 * lane) = pk4(x); }
            const u32x2 kq2 = kq_[hh];
            const f32x4 k4 = (lane < 32) ? ubf4(kq2) : kr4;
            { const float ss = wave_sum(lane < 32 ? dot4(k4, k4) : 0.f) + ssr; const float rstd = 1.0f / sqrtf(ss * (1.f / 192.f) + 1e-6f);
              f32x4 x = k4 * rstd * kg4; f32x4 o;
#pragma unroll
              for (int j = 0; j < 4; ++j) o[j] = __shfl_xor(x[j], 4);
              if (lat && rot) { if (hf == 0) x = x * cs - o * sn; else x = o * sn + x * cs; }
              if (QKN_ST && lane < 48) *(u32x2*)(KB + (size_t)row * 3072 + h * 192 + 4 * lane) = pk4(x); }
            { const u32x2 vv2 = vv_[hh]; if (QKN_VST && lane < 32) *(u32x2*)(VB + (size_t)row * 2048 + h * 128 + 4 * lane) = vv2; }
        }
    }
}

#undef QKN_LOAD
__device__ __forceinline__ void rwkvout_phase(const Ptrs& P, int l, int row0, int nrows, int gw, int NGW) {
    int lane = lane_vol();
    unsigned char* ws = P.ws;
    const float* Y = (const float*)(ws + WS_Y); const bf16* SS = (const bf16*)(ws + WS_SS); const bf16* LW = (const bf16*)(ws + WS_LW); const bf16* VV = (const bf16*)(ws + WS_VV);
    const bf16* KT = (const bf16*)(ws + WS_KT); bf16* OC = (bf16*)(ws + WS_OC);
    const float* lnw = P.in[I_LNW] + l * RWW; const float* lnb = P.in[I_LNB] + l * RWW; const float* rk = P.in[I_RK] + l * RWW;
    const float* a0 = P.in[I_A0] + (size_t)l * 2 * RWW; const float* k_a = P.in[I_KA] + (size_t)l * RWW;
    for (int row = row0 + gw; row < nrows; row += NGW) {
        asm volatile("" : "+v"(lane));
#pragma unroll
        for (int hb = 0; hb < 2; ++hb) {
            f32x4 ya_[4], yb_[4]; u32x2 r_[4], a0_[4], a1_[4], kt_[4], vv_[4], g_[4];
#pragma unroll
            for (int ii = 0; ii < 4; ++ii) { const int c = 4 * (lane + 64 * (4 * hb + ii)), h = c >> 6, e = c & 63;
                ya_[ii] = *(const f32x4*)(Y + (size_t)row * RWW + c); yb_[ii] = *(const f32x4*)(Y + (size_t)(MROWS + row) * RWW + c);
                r_[ii] = *(const u32x2*)(SS + ((size_t)(row * 32 + h) * 2) * 64 + e);
                a0_[ii] = *(const u32x2*)(LW + (size_t)row * 10240 + 4096 + c); a1_[ii] = *(const u32x2*)(LW + (size_t)row * 10240 + 6144 + c);
                kt_[ii] = *(const u32x2*)(KT + (size_t)row * RWW + c); vv_[ii] = *(const u32x2*)(VV + (size_t)row * RWW + c); g_[ii] = *(const u32x2*)(LW + (size_t)row * 10240 + 8192 + c); }
#pragma unroll
            for (int ii = 0; ii < 4; ++ii) { const int c = 4 * (lane + 64 * (4 * hb + ii));
                const f32x4 y = ya_[ii] + yb_[ii];
                const float mean = sum16((y.x + y.y) + (y.z + y.w)) * (1.f / 64.f);
                const f32x4 dlt = y - mean; const float var = sum16(dot4(dlt, dlt)) * (1.f / 64.f);
                const float rstd = 1.0f / sqrtf(var + 64e-5f);
                f32x4 o = dlt * rstd * *(const f32x4*)(lnw + c) + *(const f32x4*)(lnb + c);
                const f32x4 r4 = ubf4(r_[ii]);
                const f32x4 al0 = ubf4(a0_[ii]) + *(const f32x4*)(a0 + c), al1 = ubf4(a1_[ii]) + *(const f32x4*)(a0 + RWW + c);
                f32x4 am;
#pragma unroll
                for (int j = 0; j < 4; ++j) am[j] = 0.5f * (sigm(al0[j]) + sigm(al1[j]));
                const f32x4 kdm = ubf4(kt_[ii]) * (1.f + (am - 1.f) * *(const f32x4*)(k_a + c));
                const float bs = sum16(dot4(r4 * kdm, *(const f32x4*)(rk + c)));
                o = (o + ubf4(vv_[ii]) * bs) * ubf4(g_[ii]);
                *(u32x2*)(OC + (size_t)row * DM + c) = pk4(o);
            }
        }
    }
}

constexpr int BGQ_FI = 512 * 256, BGQ_FO = 1024 * 64, BGQ_IN = 512 * 128, BGQ_OUT = 512 * 64, BGQ_Q = 128 * 48, BGQ_KV = 64 * 64;
constexpr int BGQ_TOTAL = 2 * BGQ_FI + 2 * BGQ_FO + BGQ_IN + BGQ_OUT + BGQ_Q + BGQ_KV;
constexpr int BGQ_PER_WAVE = BGQ_TOTAL / 512;
static_assert(BGQ_PER_WAVE * 512 == BGQ_TOTAL && BGQ_PER_WAVE % 4 == 0 && BGQ_PER_WAVE / 4 <= MROWS / 32, "background quanta per loader wave");
struct BgQ { const float* src; bf16* dst; int N; };
__device__ __forceinline__ BgQ bg_decode(const Ptrs& P, int t, int lane) {
    unsigned char* ws = P.ws; const float* W; bf16* WT; int K, N, map = 0; constexpr int l = 1;
    if (t < 2 * BGQ_FI) { const int f = t / BGQ_FI; t -= f * BGQ_FI; W = P.in[I_FWI] + (size_t)(l * 2 + f) * DM * 16384; WT = (bf16*)(ws + WS_WFI + (size_t)(l * 2 + f) * SZ_WFI); K = DM; N = 16384; map = 1; }
    else if ((t -= 2 * BGQ_FI) < 2 * BGQ_FO) { const int f = t / BGQ_FO; t -= f * BGQ_FO; W = P.in[I_FWO] + (size_t)(l * 2 + f) * DFF * DM; WT = (bf16*)(ws + WS_WFO + (size_t)(l * 2 + f) * SZ_WFO); K = DFF; N = DM; }
    else if ((t -= 2 * BGQ_FO) < BGQ_IN) { W = P.in[I_WIN] + (size_t)l * DM * ZC; WT = (bf16*)(ws + WS_WIN + (size_t)l * SZ_WIN); K = DM; N = ZC; }
    else if ((t -= BGQ_IN) < BGQ_OUT) { W = P.in[I_WOUT] + (size_t)l * DM * DM; WT = (bf16*)(ws + WS_WOUT + (size_t)l * SZ_WOUT); K = DM; N = DM; }
    else if ((t -= BGQ_OUT) < BGQ_Q) { W = P.in[I_QUP] + (size_t)l * 1024 * 3072; WT = (bf16*)(ws + WS_WQ + (size_t)l * SZ_WQ); K = 1024; N = 3072; }
    else { t -= BGQ_Q; W = P.in[I_KVUP] + (size_t)l * 512 * 4096; WT = (bf16*)(ws + WS_WKV + (size_t)l * SZ_WKV); K = 512; N = 4096; }
    const int nk8 = K >> 3, nq = t / nk8, kq = t - nq * nk8, n = 64 * nq + lane;
    const int row = map ? map_row<1>(n) : n;
    BgQ q; q.src = W + (size_t)(8 * kq) * N + n; q.dst = WT + (size_t)row * K + 8 * kq; q.N = N; return q;
}

template <int CTRL> __device__ __forceinline__ float dpp_add(float x) { return x + __int_as_float(__builtin_amdgcn_update_dpp(0, __float_as_int(x), CTRL, 0xf, 0xf, true)); }
__device__ __forceinline__ float red16(float x) { x = dpp_add<0xB1>(x); x = dpp_add<0x4E>(x); x = dpp_add<0x141>(x); x = dpp_add<0x140>(x); return x; }
constexpr int SCAN_TC = 32, SCAN_STEP_B = 1424, SCAN_BUF = SCAN_TC * SCAN_STEP_B;
__device__ __forceinline__ void scan_phase(const Ptrs& P, int l, LAS unsigned char* lds, int vcu, int wave) {
    const int lane = lane_vol();
    if (vcu >= 128) return;
    const int h = vcu >> 2, d = (vcu >> 1) & 1, half = vcu & 1;
    unsigned char* ws = P.ws;
    const bf16* LW = (const bf16*)(ws + WS_LW); const bf16* SS = (const bf16*)(ws + WS_SS); const bf16* VV = (const bf16*)(ws + WS_VV); const bf16* KT = (const bf16*)(ws + WS_KT); float* Y = (float*)(ws + WS_Y);
    LAS float* ybuf = (LAS float*)(lds + 2 * SCAN_BUF);
    constexpr int NCH = MROWS / SCAN_TC;
    typedef float f32x2s __attribute__((ext_vector_type(2)));
#define rowof(tau) (d == 0 ? ((tau) < CTXL ? SEQ + (tau) : (tau) - CTXL) : (MROWS - 1 - (tau)))
    if (wave >= 4) {
        const int tl = (wave - 4) * 64 + lane;
        const int le = 4 * (tl & 15);
        const float* cw = P.in[I_W0] + (size_t)(l * 2 + d) * RWW + h * 64 + le; const float* ca = P.in[I_A0] + (size_t)(l * 2 + d) * RWW + h * 64 + le; const float* ck = P.in[I_KA] + (size_t)l * RWW + h * 64 + le;
        const f32x4 bw = *(const f32x4*)cw, ba = *(const f32x4*)ca, ka = *(const f32x4*)ck;
        u32x2 sr[2][5]; u32x2 svr;
#define LD_CHUNK(ci) do { _Pragma("unroll") for (int j_ = 0; j_ < 2; ++j_) { const int ls_ = (tl >> 4) + 16 * j_; const int row_ = rowof((ci) * SCAN_TC + ls_); const bf16* lw_ = LW + (size_t)row_ * 10240 + d * RWW + h * 64 + le; \
            sr[j_][0] = *(const u32x2*)(lw_); sr[j_][1] = *(const u32x2*)(lw_ + 4096); sr[j_][2] = *(const u32x2*)(KT + (size_t)row_ * RWW + h * 64 + le); \
            sr[j_][3] = *(const u32x2*)(SS + ((size_t)(row_ * 32 + h) * 2 + 1) * 64 + le); sr[j_][4] = *(const u32x2*)(SS + ((size_t)(row_ * 32 + h) * 2) * 64 + le); } \
          { const int row2_ = rowof((ci) * SCAN_TC + (tl >> 3)); svr = *(const u32x2*)(VV + (size_t)row2_ * RWW + h * 64 + 32 * half + 4 * (tl & 7)); } } while (0)
#define ST_CHUNK(b) do { _Pragma("unroll") for (int j_ = 0; j_ < 2; ++j_) { const int ls_ = (tl >> 4) + 16 * j_; LAS unsigned char* rec_ = lds + (b) * SCAN_BUF + ls_ * SCAN_STEP_B + le * 4; f32x4 w_, kd_, kka_; \
            f32x4 st[5]; _Pragma("unroll") for (int v_ = 0; v_ < 5; ++v_) st[v_] = ubf4(sr[j_][v_]); \
            _Pragma("unroll") for (int q_ = 0; q_ < 4; ++q_) { w_[q_] = __builtin_amdgcn_exp2f(-0.60653065971263342f * 1.4426950408889634f * sigm(st[0][q_] + bw[q_])); \
                const float a_ = sigm(st[1][q_] + ba[q_]); kd_[q_] = st[2][q_] * (1.f + (a_ - 1.f) * ka[q_]); kka_[q_] = st[3][q_] * a_; } \
            const float c1_ = red16(dot4(kka_, st[4])), c2_ = red16(dot4(kd_, st[4])); \
            *(LAS f32x4*)(rec_) = w_; *(LAS f32x4*)(rec_ + 256) = kd_; *(LAS f32x4*)(rec_ + 512) = kka_; *(LAS f32x4*)(rec_ + 768) = w_ * st[4]; *(LAS f32x4*)(rec_ + 1024) = st[3]; \
            if ((tl & 15) == 0) *(LAS f32x2s*)(lds + (b) * SCAN_BUF + ls_ * SCAN_STEP_B + 1408) = (f32x2s){c1_, c2_}; } \
          *(LAS f32x4*)(lds + (b) * SCAN_BUF + (tl >> 3) * SCAN_STEP_B + 1280 + 16 * (tl & 7)) = ubf4(svr); } while (0)
#define Y_OUT(ci) do { const int s_ = tl >> 3, j_ = tl & 7; const int row_ = rowof((ci) * SCAN_TC + s_); \
            *(f32x4*)(Y + (size_t)(d * MROWS + row_) * RWW + h * 64 + 32 * half + 4 * j_) = *(const LAS f32x4*)(ybuf + ((ci) & 1) * 1024 + s_ * 32 + 4 * j_); } while (0)
        const bool bg_on = BG_CONV && (l == 0);
        const int bq0 = (vcu * 4 + (wave - 4)) * BGQ_PER_WAVE;
        float bgr[4][8]; bf16* bg_dst = nullptr;
#define BG_ISSUE(g) do { if (bg_on && (g) < BGQ_PER_WAVE / 4) { const BgQ b_ = bg_decode(P, bq0 + 4 * (g), lane); bg_dst = b_.dst; \
            _Pragma("unroll") for (int q_ = 0; q_ < 4; ++q_) _Pragma("unroll") for (int j_ = 0; j_ < 8; ++j_) bgr[q_][j_] = b_.src[(size_t)(8 * q_ + j_) * b_.N]; } } while (0)
#define BG_FLUSH(g) do { if (bg_on && (g) >= 0 && (g) < BGQ_PER_WAVE / 4) { _Pragma("unroll") for (int q_ = 0; q_ < 4; ++q_) { \
            v4u o_; o_.x = pg8::cvt_pk_bf16(bgr[q_][0], bgr[q_][1]); o_.y = pg8::cvt_pk_bf16(bgr[q_][2], bgr[q_][3]); o_.z = pg8::cvt_pk_bf16(bgr[q_][4], bgr[q_][5]); o_.w = pg8::cvt_pk_bf16(bgr[q_][6], bgr[q_][7]); \
            *(v4u*)(bg_dst + 8 * q_) = o_; } } } while (0)
        const int gv_lw = vcu * 4 + (wave - 4);
        f32x4 gvr[8]; f32x4 gva0 = {0.f, 0.f, 0.f, 0.f}, gva1 = {0.f, 0.f, 0.f, 0.f};
#define GV_ISSUE(g) do { if (bg_on && (g) < 144) { const int u_ = gv_lw + 512 * ((g) >> 4), nch_ = u_ >> 5, ks_ = u_ & 31; \
            const float* w_ = P.in[I_WMOD] + (size_t)DM * NMODC + (size_t)(128 * ks_ + 8 * ((g) & 15)) * NMODC + 256 * nch_ + 4 * lane; \
            _Pragma("unroll") for (int j_ = 0; j_ < 8; ++j_) gvr[j_] = *(const f32x4*)(w_ + (size_t)j_ * NMODC); } } while (0)
#define GV_ACC(g) do { if (bg_on && (g) >= 0 && (g) < 144) { const int u_ = gv_lw + 512 * ((g) >> 4), nch_ = u_ >> 5, ks_ = u_ & 31; const int k0_ = 128 * ks_ + 8 * ((g) & 15); \
            _Pragma("unroll") for (int j_ = 0; j_ < 8; ++j_) { const float a_ = P.in[I_C][k0_ + j_], b_ = P.in[I_CCTX][k0_ + j_]; gva0 += gvr[j_] * (a_ * sigm(a_)); gva1 += gvr[j_] * (b_ * sigm(b_)); } \
            if (((g) & 15) == 15) { float* mo_ = (float*)(ws + WS_MOD) + (size_t)2 * NMODC + 256 * nch_ + 4 * lane; \
                if (ks_ == 0) { const f32x4 bb_ = *(const f32x4*)(P.in[I_BMOD] + NMODC + 256 * nch_ + 4 * lane); gva0 += bb_; gva1 += bb_; } \
                _Pragma("unroll") for (int j_ = 0; j_ < 4; ++j_) { atomicAdd(mo_ + j_, gva0[j_]); atomicAdd(mo_ + NMODC + j_, gva1[j_]); } \
                gva0 = (f32x4){0.f, 0.f, 0.f, 0.f}; gva1 = (f32x4){0.f, 0.f, 0.f, 0.f}; } } } while (0)
        LD_CHUNK(0); ST_CHUNK(0); LD_CHUNK(1);
        __syncthreads();
        for (int ci = 0; ci < NCH; ++ci) {
            if (ci > 0) Y_OUT(ci - 1);
            if (ci + 1 < NCH) ST_CHUNK((ci + 1) & 1);
            BG_FLUSH(ci - 1); GV_ACC(ci - 1);
            if (ci + 2 < NCH) LD_CHUNK(ci + 2);
            BG_ISSUE(ci); GV_ISSUE(ci);
            __syncthreads();
        }
        Y_OUT(NCH - 1);
        BG_FLUSH(NCH - 1);
#undef GV_ISSUE
#undef GV_ACC
#undef BG_ISSUE
#undef BG_FLUSH
#undef LD_CHUNK
#undef ST_CHUNK
#undef Y_OUT
    } else {
        const int kc = lane & 7, rl = wave * 8 + (lane >> 3);
        f32x2s Sa = {0.f, 0.f}, Sb = {0.f, 0.f}, Sc = {0.f, 0.f}, Sd = {0.f, 0.f};
        __syncthreads();
        for (int ci = 0; ci < NCH; ++ci) {
            const LAS unsigned char* buf = lds + (ci & 1) * SCAN_BUF + kc * 32;
            const LAS unsigned char* vbuf = lds + (ci & 1) * SCAN_BUF + 1280 + rl * 4;
            const LAS unsigned char* cbase = lds + (ci & 1) * SCAN_BUF + 1408;
            float ys0 = 0.f, ys1 = 0.f, ys2 = 0.f, ys3 = 0.f;
#define LDV(dst0, dst1, off, sb_) dst0 = *(const LAS f32x4*)((sb_) + (off)); dst1 = *(const LAS f32x4*)((sb_) + (off) + 16)
            f32x4 w0, w1, d0, d1, a0, a1, r0, r1, k0, k1; float vv; f32x2s cc;
            LDV(w0, w1, 0, buf); LDV(d0, d1, 256, buf); LDV(a0, a1, 512, buf); LDV(r0, r1, 768, buf); LDV(k0, k1, 1024, buf); vv = *(const LAS float*)(vbuf); cc = *(const LAS f32x2s*)(cbase);
#pragma unroll
            for (int s = 0; s < SCAN_TC; ++s) {
                f32x4 w0n = w0, w1n = w1, d0n = d0, d1n = d1, a0n = a0, a1n = a1, r0n = r0, r1n = r1, k0n = k0, k1n = k1; float vvn = vv; f32x2s ccn = cc;
                if (s + 1 < SCAN_TC) { const LAS unsigned char* sb = buf + (s + 1) * SCAN_STEP_B;
                    LDV(w0n, w1n, 0, sb); LDV(d0n, d1n, 256, sb); LDV(a0n, a1n, 512, sb); LDV(r0n, r1n, 768, sb); LDV(k0n, k1n, 1024, sb);
                    vvn = *(const LAS float*)(vbuf + (s + 1) * SCAN_STEP_B); ccn = *(const LAS f32x2s*)(cbase + (s + 1) * SCAN_STEP_B); }
#define LO(v) ((f32x2s){(v).x, (v).y})
#define HI(v) ((f32x2s){(v).z, (v).w})
                const f32x2s pa = (Sa * LO(k0) + Sb * HI(k0)) + (Sc * LO(k1) + Sd * HI(k1)), pb = (Sa * LO(r0) + Sb * HI(r0)) + (Sc * LO(r1) + Sd * HI(r1));
                float p1 = pa.x + pa.y, p2 = pb.x + pb.y;
                p1 = dpp_add<0xB1>(p1); p2 = dpp_add<0xB1>(p2); p1 = dpp_add<0x4E>(p1); p2 = dpp_add<0x4E>(p2); p1 = dpp_add<0x141>(p1); p2 = dpp_add<0x141>(p2);
                const float sk = p1, yv = p2 - sk * cc.x + vv * cc.y;
                Sa = Sa * LO(w0) + (LO(d0) * vv - LO(a0) * sk); Sb = Sb * HI(w0) + (HI(d0) * vv - HI(a0) * sk);
                Sc = Sc * LO(w1) + (LO(d1) * vv - LO(a1) * sk); Sd = Sd * HI(w1) + (HI(d1) * vv - HI(a1) * sk);
                if ((s >> 3) == 0) ys0 = (kc == (s & 7)) ? yv : ys0; else if ((s >> 3) == 1) ys1 = (kc == (s & 7)) ? yv : ys1; else if ((s >> 3) == 2) ys2 = (kc == (s & 7)) ? yv : ys2; else ys3 = (kc == (s & 7)) ? yv : ys3;
                w0 = w0n; w1 = w1n; d0 = d0n; d1 = d1n; a0 = a0n; a1 = a1n; r0 = r0n; r1 = r1n; k0 = k0n; k1 = k1n; vv = vvn; cc = ccn;
#undef LO
#undef HI
            }
#undef LDV
            LAS float* yb = ybuf + (ci & 1) * 1024;
            yb[kc * 32 + rl] = ys0; yb[(kc + 8) * 32 + rl] = ys1; yb[(kc + 16) * 32 + rl] = ys2; yb[(kc + 24) * 32 + rl] = ys3;
            __syncthreads();
        }
    }
#undef rowof
}

namespace att {
constexpr int NW = 8, QBLK = 32, KVBLK = 64;
constexpr float SCALE = 0.07216878364870322f;
constexpr float THR = 8.f;
constexpr int LDQ = 3072, LDKK = 3072, LDVV = 2048, LDO = 4096;
constexpr int SHM_V = KVBLK * 128 * 2, SHM_K = KVBLK * 400, SHM_QP = 256 * 208, SHM_ATTN = 2 * SHM_V + 2 * SHM_K + NW * 64 * 4 + SHM_QP;
using bf16x8 = __attribute__((ext_vector_type(8))) short;
using s16x4  = __attribute__((ext_vector_type(4))) short;
using f32x16 = __attribute__((ext_vector_type(16))) float;
using u32x4  = __attribute__((ext_vector_type(4))) unsigned;
#define KSWZ(row, colB) ((row) * 400 + (colB))
#define SBAR() __builtin_amdgcn_sched_barrier(0)
__device__ __forceinline__ int crow(int r, int hi) { return (r & 3) + 8 * (r >> 2) + 4 * hi; }
__device__ __forceinline__ unsigned cvtpk(float lo, float hi) { unsigned r; asm volatile("s_nop 0\n\tv_cvt_pk_bf16_f32 %0, %1, %2" : "=v"(r) : "v"(lo), "v"(hi)); return r; }
__device__ __forceinline__ void partialSM(f32x16& p0, f32x16& p1, float& m_reg, float& mn, float& alpha) {
  constexpr float C = SCALE * 1.4426950408889634f;
  float pmax = p0[0];
#pragma unroll
  for (int r = 1; r < 16; ++r) pmax = fmaxf(pmax, p0[r]);
#pragma unroll
  for (int r = 0; r < 16; ++r) pmax = fmaxf(pmax, p1[r]);
  { auto rr = __builtin_amdgcn_permlane32_swap(__float_as_uint(pmax), __float_as_uint(pmax), false, false);
    pmax = fmaxf(__uint_as_float(rr[0]), __uint_as_float(rr[1])); }
  if (__builtin_expect(__all(pmax - m_reg <= THR / SCALE), 1)) { mn = m_reg; alpha = 1.f; }
  else { mn = fmaxf(m_reg, pmax); alpha = __builtin_amdgcn_exp2f((m_reg - mn) * C); m_reg = mn; }
  float mnC = -mn * C;
#pragma unroll
  for (int r = 0; r < 16; ++r) p0[r] = fmaf(p0[r], C, mnC);
#pragma unroll
  for (int r = 0; r < 16; ++r) p1[r] = fmaf(p1[r], C, mnC);
#pragma unroll
  for (int r = 0; r < 16; ++r) p0[r] = __builtin_amdgcn_exp2f(p0[r]);
}
__device__ __forceinline__ void finishSM(f32x16& p0, f32x16& p1, float alpha, float& l_reg, bf16x8& pa0, bf16x8& pa1, bf16x8& pa2, bf16x8& pa3) {
#pragma unroll
  for (int r = 0; r < 16; ++r) p1[r] = __builtin_amdgcn_exp2f(p1[r]);
  float ps = 0;
#pragma unroll
  for (int r = 0; r < 16; ++r) ps += p0[r];
#pragma unroll
  for (int r = 0; r < 16; ++r) ps += p1[r];
  { auto rr = __builtin_amdgcn_permlane32_swap(__float_as_uint(ps), __float_as_uint(ps), false, false);
    ps = __uint_as_float(rr[0]) + __uint_as_float(rr[1]); }
  l_reg = l_reg * alpha + ps;
#define PK4(P, BASE, OUT) do { unsigned a0 = cvtpk(P[BASE + 0], P[BASE + 1]), a1 = cvtpk(P[BASE + 2], P[BASE + 3]);   \
    unsigned b0 = cvtpk(P[BASE + 4], P[BASE + 5]), b1 = cvtpk(P[BASE + 6], P[BASE + 7]);                              \
    auto r0 = __builtin_amdgcn_permlane32_swap(a0, b0, false, false); auto r1 = __builtin_amdgcn_permlane32_swap(a1, b1, false, false); \
    u32x4 w = {r0[0], r1[0], r0[1], r1[1]}; OUT = *reinterpret_cast<bf16x8*>(&w); } while (0)
  PK4(p0, 0, pa0); PK4(p0, 8, pa1); PK4(p1, 0, pa2); PK4(p1, 8, pa3);
#undef PK4
}
__device__ __forceinline__ void qkt(f32x16& p0, f32x16& p1, const char* Ks, const bf16x8* qr, const char* qpark, int r32, int hi) {
  p0 = f32x16{}; p1 = f32x16{};
#pragma unroll
  for (int d0 = 0; d0 < 12; ++d0) { int cb = (d0 * 16 + hi * 8) * 2;
    bf16x8 b0 = *reinterpret_cast<const bf16x8*>(Ks + KSWZ(r32, cb));
    bf16x8 b1 = *reinterpret_cast<const bf16x8*>(Ks + KSWZ(32 + r32, cb));
    const bf16x8 q = d0 < 6 ? qr[d0 < 6 ? d0 : 0] : *reinterpret_cast<const bf16x8*>(qpark + (d0 - 6) * 32);
    p0 = __builtin_amdgcn_mfma_f32_32x32x16_bf16(b0, q, p0, 0, 0, 0);
    p1 = __builtin_amdgcn_mfma_f32_32x32x16_bf16(b1, q, p1, 0, 0, 0); }
}
__device__ __forceinline__ int v_st(int k, int c) { const int kk = (k & ~0xC) | ((k & 4) << 1) | ((k & 8) >> 1); return ((kk >> 3) * 4 + (c >> 5)) * 512 + ((kk & 7) * 32 + (c & 31)) * 2; }
__device__ __forceinline__ int v_rd_base(int lane) { return ((lane & 3) << 3) | (((lane >> 2) & 3) << 6) | (((lane >> 4) & 1) << 5) | (((lane >> 5) & 1) << 8); }
constexpr int v_rd_off(int d0, int ks, int half) { return d0 * 512 + ks * 4096 + half * 2048; }
template <int OFF> __device__ __forceinline__ s16x4 tr_read(int vb) {
  s16x4 r; asm volatile("ds_read_b64_tr_b16 %0, %1 offset:%2" : "=&v"(r) : "v"(vb), "i"(OFF) : "memory"); return r;
}
template <int D0> __device__ __forceinline__ void pv_one(f32x16& od, int vb, bf16x8 pa0, bf16x8 pa1, bf16x8 pa2, bf16x8 pa3) {
  const s16x4 l0 = tr_read<v_rd_off(D0, 0, 0)>(vb), h0 = tr_read<v_rd_off(D0, 0, 1)>(vb), l1 = tr_read<v_rd_off(D0, 1, 0)>(vb), h1 = tr_read<v_rd_off(D0, 1, 1)>(vb);
  const s16x4 l2 = tr_read<v_rd_off(D0, 2, 0)>(vb), h2 = tr_read<v_rd_off(D0, 2, 1)>(vb), l3 = tr_read<v_rd_off(D0, 3, 0)>(vb), h3 = tr_read<v_rd_off(D0, 3, 1)>(vb);
  asm volatile("s_waitcnt lgkmcnt(0)" ::: "memory"); SBAR();
#define PK(L, H) (bf16x8){L[0], L[1], L[2], L[3], H[0], H[1], H[2], H[3]}
  od = __builtin_amdgcn_mfma_f32_32x32x16_bf16(pa0, PK(l0, h0), od, 0, 0, 0);
  od = __builtin_amdgcn_mfma_f32_32x32x16_bf16(pa1, PK(l1, h1), od, 0, 0, 0);
  od = __builtin_amdgcn_mfma_f32_32x32x16_bf16(pa2, PK(l2, h2), od, 0, 0, 0);
  od = __builtin_amdgcn_mfma_f32_32x32x16_bf16(pa3, PK(l3, h3), od, 0, 0, 0);
#undef PK
}
__device__ __forceinline__ void pv_d0(f32x16* o, int vb, bf16x8 pa0, bf16x8 pa1, bf16x8 pa2, bf16x8 pa3) {
  pv_one<0>(o[0], vb, pa0, pa1, pa2, pa3); pv_one<1>(o[1], vb, pa0, pa1, pa2, pa3); pv_one<2>(o[2], vb, pa0, pa1, pa2, pa3); pv_one<3>(o[3], vb, pa0, pa1, pa2, pa3);
}
__device__ __forceinline__ void attn_body(const unsigned short* __restrict__ Qb, const unsigned short* __restrict__ Kh, const unsigned short* __restrict__ Vh,
                                          unsigned short* __restrict__ Ob, int seq, char* lds, int wave_in) {
  int tid_o; asm volatile("v_mbcnt_lo_u32_b32 %0, -1, 0\n\tv_mbcnt_hi_u32_b32 %0, -1, %0" : "=v"(tid_o)); tid_o += wave_in * 64;
  const int tid = tid_o, wid = wave_in, lane = tid & 63, r32 = lane & 31, hi = lane >> 5;
  char* V_lds = lds; char* K_lds = lds + 2 * SHM_V;
  float* wsx = (float*)(lds + 2 * SHM_V + 2 * SHM_K) + wid * 64; float* li_l = wsx; float* al_l = wsx + 32;
  float m_reg = -1e30f, l_reg = 0; f32x16 o[4] = {}; bf16x8 qr[6];
  char* qpark = lds + 2 * SHM_V + 2 * SHM_K + NW * 64 * 4 + (wid * QBLK + r32) * 208 + hi * 16;
  const unsigned short* Qw = Qb + (long)(wid * QBLK + r32) * LDQ + hi * 8;
#pragma unroll
  for (int d0 = 0; d0 < 6; ++d0) qr[d0] = *reinterpret_cast<const bf16x8*>(Qw + d0 * 16);
#pragma unroll
  for (int d0 = 6; d0 < 12; ++d0) *reinterpret_cast<bf16x8*>(qpark + (d0 - 6) * 32) = *reinterpret_cast<const bf16x8*>(Qw + d0 * 16);
  const int sr = tid >> 4, sc = (tid & 15) * 8, vst0 = v_st(sr, sc), vst1 = v_st(32 + sr, sc);
  const int kr0 = tid / 24, kc0 = (tid % 24) * 8, kr1 = (tid + 512) / 24, kc1 = ((tid + 512) % 24) * 8, kr2 = (tid + 1024) / 24, kc2 = ((tid + 1024) % 24) * 8;
  const int vb0 = (int)(uintptr_t)V_lds + v_rd_base(lane);
  const unsigned ko0 = (unsigned)(kr0 * LDKK + kc0) * 2u, ko1 = (unsigned)(kr1 * LDKK + kc1) * 2u, ko2 = (unsigned)(kr2 * LDKK + kc2) * 2u;
  const unsigned vo0 = (unsigned)(sr * LDVV + sc) * 2u, vo1 = (unsigned)((32 + sr) * LDVV + sc) * 2u;
  const int kl0 = KSWZ(kr0, kc0 * 2), kl1 = KSWZ(kr1, kc1 * 2), kl2 = KSWZ(kr2, kc2 * 2);
  bf16x8 vs0, vs1, ks0, ks1, ks2;
#define SLOAD(k0) do { const char* kb_ = (const char*)Kh + (size_t)(k0) * (LDKK * 2); const char* vb_ = (const char*)Vh + (size_t)(k0) * (LDVV * 2); \
    vs0 = *reinterpret_cast<const bf16x8*>(vb_ + vo0); vs1 = *reinterpret_cast<const bf16x8*>(vb_ + vo1); \
    ks0 = *reinterpret_cast<const bf16x8*>(kb_ + ko0); ks1 = *reinterpret_cast<const bf16x8*>(kb_ + ko1); ks2 = *reinterpret_cast<const bf16x8*>(kb_ + ko2); } while (0)
#define SWRITE(b) do { *(bf16x8*)(V_lds + (b) * SHM_V + vst0) = vs0; *(bf16x8*)(V_lds + (b) * SHM_V + vst1) = vs1; \
    *(bf16x8*)(K_lds + (b) * SHM_K + kl0) = ks0; *(bf16x8*)(K_lds + (b) * SHM_K + kl1) = ks1; *(bf16x8*)(K_lds + (b) * SHM_K + kl2) = ks2; } while (0)
#define SWAIT() asm volatile("s_waitcnt vmcnt(0)" ::: "memory")
#define RESC(a) do { if (__any((a) < 1.f)) { if (hi == 0) al_l[r32] = (a); asm volatile("s_waitcnt lgkmcnt(0)" ::: "memory"); \
    _Pragma("unroll") for (int d = 0; d < 4; ++d) _Pragma("unroll") for (int r = 0; r < 16; ++r) o[d][r] *= al_l[crow(r, hi)]; } } while (0)
  f32x16 pA0, pA1, pB0, pB1; float mnA, mnB, alA, alB; bf16x8 pa0, pa1, pa2, pa3; const int NT = seq / KVBLK;
  __syncthreads();
  SLOAD(0); SWAIT(); SWRITE(0); __syncthreads();
  qkt(pA0, pA1, K_lds, qr, qpark, r32, hi); partialSM(pA0, pA1, m_reg, mnA, alA);
  SLOAD(KVBLK);
  SWAIT(); SWRITE(1); __syncthreads();
  for (int j = 1; j + 1 < NT; j += 2) {
    SBAR(); qkt(pB0, pB1, K_lds + SHM_K, qr, qpark, r32, hi);
    finishSM(pA0, pA1, alA, l_reg, pa0, pa1, pa2, pa3); SBAR();
    SLOAD((j + 1) * KVBLK); SBAR();
    pv_d0(o, vb0, pa0, pa1, pa2, pa3); partialSM(pB0, pB1, m_reg, mnB, alB);
    __syncthreads(); SWAIT(); SWRITE(0);
    RESC(alB); __syncthreads();
    SBAR(); qkt(pA0, pA1, K_lds, qr, qpark, r32, hi);
    finishSM(pB0, pB1, alB, l_reg, pa0, pa1, pa2, pa3); SBAR();
    SLOAD((j + 2) * KVBLK); SBAR();
    pv_d0(o, vb0 + SHM_V, pa0, pa1, pa2, pa3); partialSM(pA0, pA1, m_reg, mnA, alA);
    __syncthreads(); SWAIT(); SWRITE(1);
    RESC(alA); __syncthreads();
  }
  SBAR(); qkt(pB0, pB1, K_lds + SHM_K, qr, qpark, r32, hi);
  finishSM(pA0, pA1, alA, l_reg, pa0, pa1, pa2, pa3); SBAR();
  pv_d0(o, vb0, pa0, pa1, pa2, pa3); partialSM(pB0, pB1, m_reg, mnB, alB);
  __syncthreads(); RESC(alB);
  finishSM(pB0, pB1, alB, l_reg, pa0, pa1, pa2, pa3); SBAR();
  pv_d0(o, vb0 + SHM_V, pa0, pa1, pa2, pa3);
  if (hi == 0) li_l[r32] = l_reg; asm volatile("s_waitcnt lgkmcnt(0)" ::: "memory");
  float rli[16];
#pragma unroll
  for (int r = 0; r < 16; ++r) rli[r] = __builtin_amdgcn_rcpf(li_l[crow(r, hi)]);
  unsigned short* Ow = Ob + (long)(wid * QBLK) * LDO;
#pragma unroll
  for (int r = 0; r < 16; ++r) { int orow = crow(r, hi);
#pragma unroll
    for (int d0 = 0; d0 < 4; ++d0) Ow[(long)orow * LDO + d0 * 32 + r32] = (unsigned short)f2bf(o[d0][r] * rli[r]); }
#undef SLOAD
#undef SWRITE
#undef SWAIT
#undef RESC
}
#undef KSWZ
#undef SBAR
}

#ifndef DBG_STOP
#define DBG_STOP 1000
#endif
constexpr int PH_PER_LAYER = 15, NPHASE = 1 + 2 * PH_PER_LAYER, PH_COPY = NPHASE;
struct Args { const float* in[N_IN]; float* out; unsigned char* ws; int ph_lo, ph_hi; };

template <class Epi> __device__ __forceinline__ void run_gemm(LAS unsigned char* lds, const bf16* A, const bf16* Bt, int M, int N, int K, int G, const Epi& E, int wave, int cshift = 0) {
    asm volatile("" : "+s"(K));
    pg8::Gemm g{A, Bt, M, N, K, K, (size_t)256 * K * 2, (size_t)0}; pg8::StaticOrder S; S.init(M, N, G, (int)((blockIdx.x + (unsigned)cshift) % (unsigned)G));
    pg8::gemm_phase<Epi, pg8::StaticOrder, true, true>(lds, g, S, E, wave);
}

#ifndef SK_MASK
#define SK_MASK 15
#endif
#ifndef SK_DRY
#define SK_DRY 0
#endif
#ifndef PH7_BAL
#define PH7_BAL 1
#endif
#define SK_F1 ((SK_MASK) & 1)
#define SK_IN (((SK_MASK) >> 3) & 1)
#define SK_OP (((SK_MASK) >> 1) & 1)
#define SK_F2 (((SK_MASK) >> 2) & 1)
template <class Epi> __device__ __forceinline__ void run_gemm_sk(LAS unsigned char* lds, const bf16* A, const bf16* Bt, int ld, int N, int G, const Epi& E, int wave, int ns = SK_NS) {
    asm volatile("" : "+s"(ld));
    asm volatile("" : "+s"(ns)); int Ks = ld / ns; asm volatile("" : "+s"(Ks));
    pg8::Gemm g{A, Bt, ns * 256, N, Ks, ld, (size_t)Ks * 2, (size_t)Ks * 2}; pg8::StaticOrder S; S.init(ns * 256, N, G, (int)blockIdx.x);
    pg8::gemm_phase<Epi, pg8::StaticOrder, true, true>(lds, g, S, E, wave);
}
#define WSP(T, off) ((T*)(ws + (off)))

template <int PHSEL> __global__ void __launch_bounds__(NTHR, 2) fwd_kernel(Args args) {
    extern __shared__ __attribute__((aligned(16))) unsigned char lds_raw[];
    LAS unsigned char* lds = (LAS unsigned char*)lds_raw;
    const int wave = __builtin_amdgcn_readfirstlane((int)(threadIdx.x >> 6));
    const int G = gridDim.x; const int bx = blockIdx.x; const int vcu = (G % 8 == 0) ? (bx % 8) * (G / 8) + bx / 8 : bx;
    const int gw = vcu * NWAVES + wave, NGW = G * NWAVES;
    const int lo = args.ph_lo, hi = args.ph_hi;
    volatile LAS unsigned* MISC = (volatile LAS unsigned*)(lds + MISC_OFF);
    if (threadIdx.x < 64) MISC[threadIdx.x] = 0u;
    if (threadIdx.x == 0) {
        LAS unsigned long long* PT = (LAS unsigned long long*)(lds + PT_OFF);
#pragma unroll
        for (int i = 0; i < N_IN; ++i) PT[i] = (unsigned long long)args.in[i];
        PT[N_IN] = (unsigned long long)args.out; PT[N_IN + 1] = (unsigned long long)args.ws;
    }
    __syncthreads();
    XcdBarrier bar; bar.bar = (unsigned*)(args.ws + WS_CTL) + CW_BAR; bar.x = 0; bar.st = nullptr;
    if (hi - lo > 1) bar = xcd_barrier_post((unsigned*)(args.ws + WS_CTL) + CW_BAR, MISC + 8);
    bar.wave = wave;
#ifndef PH_MASK
#define PH_MASK 0xFFFFF
#endif
#ifndef DBG_REP
#define DBG_REP -1
#endif
#define REPS(j) ((DBG_REP == (j)) ? 2 : 1)
#define EN(j) ((((PH_MASK) >> (j)) & 1) && (PHSEL < 0 || PHSEL == ((j) >= 16 ? 7 : (j))))
#define IN(k) (lo <= (k) && (k) < hi && (k) <= DBG_STOP)
#define SEAM(k) do { if (lo <= (k) && (k) + 1 < hi) { asm volatile("" ::: "memory"); XcdBarrier bb_ = bar; bb_.bar = (unsigned*)((GAS unsigned char*)ld_uptr(lds, N_IN + 1) + WS_CTL) + CW_BAR; xcd_barrier(bb_); if (bx == 0) TSW(k); } } while (0)
#ifdef DBG_TS_A
#define TSW(id) do { if (wave == 0 && lane_vol() == 0) __hip_atomic_store((gu32*)((GAS unsigned char*)ld_uptr(lds, N_IN + 1) + WS_CTL) + 16384 + (id), (unsigned)__builtin_amdgcn_s_memrealtime(), RLX_AGENT); } while (0)
#else
#define TSW(id) do {} while (0)
#endif
#define PHASE_PTRS() const Ptrs P = load_ptrs(lds); unsigned char* ws = P.ws; const float* MOD = WSP(const float, WS_MOD); \
        const float* modL = MOD + (size_t)(l * 2 + 0) * NMODC; const float* modC = MOD + (size_t)(l * 2 + 1) * NMODC; float* X = WSP(float, WS_X); float* XC = X + (size_t)SEQ * DM; \
        (void)modL; (void)modC; (void)X; (void)XC

    if (bx == 0) TSW(62);
    if (EN(0) && IN(0)) for (int rp = 0; rp < REPS(0); ++rp) prologue_phase(lds, vcu, G, wave);
    SEAM(0);

    for (int l = 0; l < 2; ++l) {
        const int pb = 1 + PH_PER_LAYER * l;
        const bool last = (l == 1);
        const int nrows2 = last ? SEQ : MROWS;
        if (EN(1) && IN(pb + 0)) for (int rp = 0; rp < REPS(1); ++rp) { PHASE_PTRS(); const float* x0L = (l == 0) ? P.in[I_X] : X; const float* x0C = (l == 0) ? P.in[I_CTX] : XC;
            prep_phase(lds, x0L, x0C, MROWS, P.in[I_NORMG] + (size_t)(l * 3 + 0) * DM, modL, modC, 0, WSP(bf16, WS_XN), gw, NGW, wave, SK_F2 && l == 1 ? WSP(const float, WS_ACC) : nullptr, XC); }
        SEAM(pb + 0);
        if (EN(2) && IN(pb + 1)) for (int rp = 0; rp < REPS(2); ++rp) { PHASE_PTRS(); EpiSwiGLU E{WSP(bf16, WS_H)}; run_gemm(lds, WSP(const bf16, WS_XN), WSP(const bf16, WS_WFI + (size_t)(l * 2 + 0) * SZ_WFI), MROWS, 16384, DM, G, E, wave); }
        SEAM(pb + 1);
        if (EN(3) && IN(pb + 2)) { PHASE_PTRS(); const float* x0L = (l == 0) ? P.in[I_X] : X; const float* x0C = (l == 0) ? P.in[I_CTX] : XC;
            EpiRes E{x0L, x0C, X, XC, modL + 2 * DM, modC + 2 * DM, 0.5f}; run_gemm(lds, WSP(const bf16, WS_H), WSP(const bf16, WS_WFO + (size_t)(l * 2 + 0) * SZ_WFO), (SK_F1 && !SK_DRY) ? SEQ : MROWS, DM, DFF, G, E, wave);
            if (SK_F1) { EpiSlab EA{WSP(float, WS_ACC), modC + 2 * DM, 0.5f};
#if SK_DRY == 2
            run_gemm(lds, WSP(const bf16, WS_H) + (size_t)SEQ * DFF, WSP(const bf16, WS_WFO + (size_t)(l * 2 + 0) * SZ_WFO), 256, DM, DFF, G, EA, wave); } }
#else
            run_gemm_sk(lds, WSP(const bf16, WS_H) + (size_t)SEQ * DFF, WSP(const bf16, WS_WFO + (size_t)(l * 2 + 0) * SZ_WFO), DFF, DM, G, EA, wave); } }
#endif
        SEAM(pb + 2);
        if (EN(4) && IN(pb + 3)) for (int rp = 0; rp < REPS(4); ++rp) { PHASE_PTRS(); prep_phase(lds, X, (SK_F1 && !SK_DRY && l == 0) ? P.in[I_CTX] : XC, MROWS, P.in[I_NORMG] + (size_t)(l * 3 + 1) * DM, modL, modC, 3, WSP(bf16, WS_XN), gw, NGW, wave, (SK_F1 && !SK_DRY) ? WSP(const float, WS_ACC) : nullptr, XC); }
        SEAM(pb + 3);
        if (EN(5) && IN(pb + 4)) for (int rp = 0; rp < REPS(5); ++rp) { PHASE_PTRS();
            EpiB16 E{WSP(bf16, WS_Z), ZC}; run_gemm(lds, WSP(const bf16, WS_XN), WSP(const bf16, WS_WIN + (size_t)l * SZ_WIN), SK_IN ? SEQ : MROWS, ZC, DM, G, E, wave);
            if (SK_IN) { EpiSlabP ES{WSP(float, WS_SLB), ZC}; run_gemm_sk(lds, WSP(const bf16, WS_XN) + (size_t)SEQ * DM, WSP(const bf16, WS_WIN + (size_t)l * SZ_WIN), DM, ZC, G, ES, wave, 4); } }
        SEAM(pb + 4);
        if (EN(6) && IN(pb + 5)) { if (SK_IN) { { PHASE_PTRS(); ctx_reduce_z(P, vcu, G, wave); } SEAM(pb + 4); } PHASE_PTRS(); streams_phase(P, l, gw, NGW); }
        SEAM(pb + 5);
        if (EN(7) && IN(pb + 6)) {
#if PH7_BAL
            if (EN(16)) { PHASE_PTRS(); EpiB16 E{WSP(bf16, WS_LW), 10240}; run_gemm(lds, WSP(const bf16, WS_LWA), WSP(const bf16, WS_WWA + (size_t)l * SZ_WWA), SEQ, 10240, 512, G, E, wave); }
            if (EN(19)) { PHASE_PTRS(); EpiB16 E{WSP(bf16, WS_KVF), 4096}; run_gemm(lds, WSP(const bf16, WS_KVL), WSP(const bf16, WS_WKV + (size_t)l * SZ_WKV), SEQ, 4096, 512, G, E, wave); }
            if (EN(18)) { PHASE_PTRS(); EpiB16 E{WSP(bf16, WS_QF), 3072}; run_gemm(lds, WSP(const bf16, WS_QL), WSP(const bf16, WS_WQ + (size_t)l * SZ_WQ), SEQ, 3072, 1024, G, E, wave); }
            if (EN(16)) { PHASE_PTRS(); EpiB16 E{WSP(bf16, WS_LW) + (size_t)SEQ * 10240, 10240}; run_gemm(lds, WSP(const bf16, WS_LWA) + (size_t)SEQ * 512, WSP(const bf16, WS_WWA + (size_t)l * SZ_WWA), CTXL, 10240, 512, G, E, wave, 128); }
            if (EN(18)) { PHASE_PTRS(); EpiB16 E{WSP(bf16, WS_QF) + (size_t)SEQ * 3072, 3072}; run_gemm(lds, WSP(const bf16, WS_QL) + (size_t)SEQ * 1024, WSP(const bf16, WS_WQ + (size_t)l * SZ_WQ), CTXL, 3072, 1024, G, E, wave, 88); }
            if (EN(19)) { PHASE_PTRS(); EpiB16 E{WSP(bf16, WS_KVF) + (size_t)SEQ * 4096, 4096}; run_gemm(lds, WSP(const bf16, WS_KVL) + (size_t)SEQ * 512, WSP(const bf16, WS_WKV + (size_t)l * SZ_WKV), CTXL, 4096, 512, G, E, wave, 72); }
#else
            if (EN(16)) { PHASE_PTRS(); EpiB16 E{WSP(bf16, WS_LW), 10240}; run_gemm(lds, WSP(const bf16, WS_LWA), WSP(const bf16, WS_WWA + (size_t)l * SZ_WWA), MROWS, 10240, 512, G, E, wave); }
            if (EN(18)) { PHASE_PTRS(); EpiB16 E{WSP(bf16, WS_QF), 3072}; run_gemm(lds, WSP(const bf16, WS_QL), WSP(const bf16, WS_WQ + (size_t)l * SZ_WQ), MROWS, 3072, 1024, G, E, wave); }
            if (EN(19)) { PHASE_PTRS(); EpiB16 E{WSP(bf16, WS_KVF), 4096}; run_gemm(lds, WSP(const bf16, WS_KVL), WSP(const bf16, WS_WKV + (size_t)l * SZ_WKV), MROWS, 4096, 512, G, E, wave); }
#endif
        }
        SEAM(pb + 6);
        if (EN(9) && IN(pb + 8)) {
            PHASE_PTRS();
            gu32* ctlw = (gu32*)(ws + WS_CTL);
            gu32* qk_done = ctlw + CW_MIX + 64 * l; gu32* q_head = ctlw + CW_MIX + 64 * (2 + l); gu32* tmo = ctlw + CW_MIX + 64 * 4;
            gu32* scan_done = ctlw + CW_MIX + 64 * (5 + l);
            if (vcu < 128) {
                scan_phase(P, l, lds, vcu, wave);
                if (bx == 0) TSW(40 + l);
                asm volatile("s_waitcnt vmcnt(0)" ::: "memory"); __syncthreads();
                if (wave == 0 && lane_vol() == 0) { __builtin_amdgcn_fence(__ATOMIC_RELEASE, "agent"); asm volatile("s_waitcnt vmcnt(0)" ::: "memory"); __hip_atomic_fetch_add(scan_done, 1u, RLX_AGENT); }
            } else {
                qknorm_phase(P, l, (vcu - 128) * NWAVES + wave, 128 * NWAVES);
                if (vcu == 200) TSW(46 + l);
                asm volatile("s_waitcnt vmcnt(0)" ::: "memory"); __syncthreads();
                if (wave == 0 && lane_vol() == 0) { __builtin_amdgcn_fence(__ATOMIC_RELEASE, "agent"); asm volatile("s_waitcnt vmcnt(0)" ::: "memory"); __hip_atomic_fetch_add(qk_done, 1u, RLX_AGENT); }
            }
            if (wave == 0 && lane_vol() == 0) {
                unsigned sp = 0;
                while (__hip_atomic_load(qk_done, RLX_AGENT) < 128u) { __builtin_amdgcn_s_sleep(2); if (++sp > (1u << 22)) { __hip_atomic_store(tmo, 1u, RLX_AGENT); break; } }
                __builtin_amdgcn_fence(__ATOMIC_ACQUIRE, "agent"); asm volatile("s_waitcnt vmcnt(0)" ::: "memory");
            }
            __syncthreads();
            if (bx == 0) TSW(50 + l);
            const int nun = 512 + (last ? 0 : 16);
            const bf16* QB = WSP(const bf16, WS_QB); const bf16* KB = WSP(const bf16, WS_KB); const bf16* VB = WSP(const bf16, WS_VB); bf16* OC = WSP(bf16, WS_OC);
            bool scan_ok = false;
            for (;;) {
                if (wave == 0 && lane_vol() == 0) MISC[16] = __hip_atomic_fetch_add(q_head, 1u, RLX_AGENT);
                __syncthreads();
                const int u = (int)MISC[16];
                if (u >= nun) {
                    const int v = u - nun; if (v * 32 >= nrows2) break;
                    if (!scan_ok) {
                        if (wave == 0 && lane_vol() == 0) { unsigned sp = 0;
                            while (__hip_atomic_load(scan_done, RLX_AGENT) < 128u) { __builtin_amdgcn_s_sleep(2); if (++sp > (1u << 22)) { __hip_atomic_store(tmo, 1u, RLX_AGENT); break; } }
                            __builtin_amdgcn_fence(__ATOMIC_ACQUIRE, "agent"); asm volatile("s_waitcnt vmcnt(0)" ::: "memory"); }
                        __syncthreads(); scan_ok = true;
                    }
                    rwkvout_phase(P, l, v * 32, v * 32 + 32, wave, NWAVES);
                    __syncthreads();
                    continue;
                }
                int h, q0, key0, nk;
                if (u < 512) { h = u >> 5; q0 = (u & 31) * 256; key0 = 0; nk = MROWS; } else { h = u - 512; q0 = SEQ; key0 = SEQ; nk = CTXL; }
                att::attn_body(QB + (size_t)q0 * 3072 + h * 192, KB + (size_t)key0 * 3072 + h * 192, VB + (size_t)key0 * 2048 + h * 128, OC + (size_t)q0 * DM + 2048 + h * 128, nk, (char*)lds_raw, wave);
                __syncthreads();
            }
            __syncthreads();
            if (bx == 0) TSW(44 + l); if (vcu == 200) TSW(48 + l);
        }
        SEAM(pb + 8);
        if (EN(12) && IN(pb + 11)) { PHASE_PTRS(); EpiRes E{X, XC, X, XC, modL + 5 * DM, modC + 5 * DM, 1.0f}; run_gemm(lds, WSP(const bf16, WS_OC), WSP(const bf16, WS_WOUT + (size_t)l * SZ_WOUT), SK_OP ? SEQ : nrows2, DM, DM, G, E, wave);
            if (SK_OP && !last) { EpiSlab EA{WSP(float, WS_ACC), modC + 5 * DM, 1.0f}; run_gemm_sk(lds, WSP(const bf16, WS_OC) + (size_t)SEQ * DM, WSP(const bf16, WS_WOUT + (size_t)l * SZ_WOUT), DM, DM, G, EA, wave); } }
        SEAM(pb + 11);
        if (EN(13) && IN(pb + 12)) for (int rp = 0; rp < REPS(13); ++rp) { PHASE_PTRS(); prep_phase(lds, X, XC, nrows2, P.in[I_NORMG] + (size_t)(l * 3 + 2) * DM, modL, modC, 6, WSP(bf16, WS_XN), gw, NGW, wave, (SK_OP && !last) ? WSP(const float, WS_ACC) : nullptr, XC); }
        SEAM(pb + 12);
        if (EN(14) && IN(pb + 13)) for (int rp = 0; rp < REPS(14); ++rp) { PHASE_PTRS(); EpiSwiGLU E{WSP(bf16, WS_H)}; run_gemm(lds, WSP(const bf16, WS_XN), WSP(const bf16, WS_WFI + (size_t)(l * 2 + 1) * SZ_WFI), nrows2, 16384, DM, G, E, wave); }
        SEAM(pb + 13);
        if (EN(15) && IN(pb + 14)) { PHASE_PTRS(); float* oL = last ? P.out : X;
            EpiRes E{X, XC, oL, XC, modL + 8 * DM, modC + 8 * DM, 0.5f}; run_gemm(lds, WSP(const bf16, WS_H), WSP(const bf16, WS_WFO + (size_t)(l * 2 + 1) * SZ_WFO), SK_F2 ? SEQ : nrows2, DM, DFF, G, E, wave);
            if (SK_F2 && !last) { EpiSlab EA{WSP(float, WS_ACC), modC + 8 * DM, 0.5f}; run_gemm_sk(lds, WSP(const bf16, WS_H) + (size_t)SEQ * DFF, WSP(const bf16, WS_WFO + (size_t)(l * 2 + 1) * SZ_WFO), DFF, DM, G, EA, wave); } }
        SEAM(pb + 14);
    }
    if ((PHSEL < 0 || PHSEL == 100) && DBG_STOP < NPHASE - 1 && lo <= PH_COPY && PH_COPY < hi) {
        const int l = 0; PHASE_PTRS();
        const int tid = wave * 64 + lane_vol();
#if 0
#else
        const float* src = (DBG_STOP >= 3) ? X : P.in[I_X];
        for (size_t i = (size_t)(bx * NTHR + tid); i < (size_t)SEQ * DM / 4; i += (size_t)G * NTHR) ((f32x4*)P.out)[i] = ((const f32x4*)src)[i];
#endif
    }
#ifdef DBG_TS_A
    if (bx == 0 && wave == 0 && lane_vol() == 0) {
        gu32* tsp = (gu32*)((GAS unsigned char*)ld_uptr(lds, N_IN + 1) + WS_CTL) + 16384;
        const unsigned tb = (DBG_TS_B == 99) ? (unsigned)__builtin_amdgcn_s_memrealtime() : __hip_atomic_load(tsp + DBG_TS_B, RLX_AGENT);
        const unsigned ta = __hip_atomic_load(tsp + DBG_TS_A, RLX_AGENT);
        const unsigned long long dt = (unsigned long long)(tb - ta) * (unsigned long long)(DBG_TS_MULT);
        const unsigned long long t0_ = __builtin_amdgcn_s_memrealtime();
        while (__builtin_amdgcn_s_memrealtime() - t0_ < dt) __builtin_amdgcn_s_sleep(64);
    }
#endif
#undef IN
#undef SEAM
}

extern "C" void kernel_launch(void* const* d_in, const int* in_sizes, int n_in, void* d_out, int out_size, void* d_ws, size_t ws_size, hipStream_t stream) {
    static int grid = 0;
    if (grid == 0) {
        if (n_in != N_IN || out_size != SEQ * DM || ws_size < WS_END) { fprintf(stderr, "kernel_launch: unexpected shapes: n_in %d out %d ws %zu (need %zu)\n", n_in, out_size, ws_size, (size_t)WS_END); grid = -1; return; }
        int dev = 0, cus = 0;
        if (hipGetDevice(&dev) != hipSuccess || hipDeviceGetAttribute(&cus, hipDeviceAttributeMultiprocessorCount, dev) != hipSuccess) { grid = -1; return; }
        {
            hipError_t e = hipSuccess;
#if MK_ONE_LAUNCH
            e = hipFuncSetAttribute((const void*)fwd_kernel<-1>, hipFuncAttributeMaxDynamicSharedMemorySize, LDS_BYTES);
#else
#define SETA(S) if (e == hipSuccess) e = hipFuncSetAttribute((const void*)fwd_kernel<S>, hipFuncAttributeMaxDynamicSharedMemorySize, LDS_BYTES)
            SETA(0); SETA(1); SETA(2); SETA(3); SETA(4); SETA(5); SETA(6); SETA(7); SETA(8); SETA(9); SETA(10); SETA(11); SETA(12); SETA(13); SETA(14); SETA(15); SETA(100);
#undef SETA
#endif
            if (e != hipSuccess) { fprintf(stderr, "kernel_launch: hipFuncSetAttribute failed\n"); grid = -1; return; }
        }
        (void)hipGetLastError();
        grid = cus;
    }
    if (grid < 0) return;
    (void)hipMemsetAsync((char*)d_ws + WS_CTL, 0, ZERO_BYTES, stream);
    Args a{};
    for (int i = 0; i < N_IN; ++i) a.in[i] = (const float*)d_in[i];
    a.out = (float*)d_out; a.ws = (unsigned char*)d_ws;
    const int last_phase = (DBG_STOP < NPHASE - 1) ? PH_COPY : NPHASE - 1;
#if MK_ONE_LAUNCH
    a.ph_lo = 0; a.ph_hi = last_phase + 1;
    hipLaunchKernelGGL(fwd_kernel<-1>, dim3(grid), dim3(NTHR), LDS_BYTES, stream, a);
#else
    for (int p = 0; p <= last_phase; ++p) {
        if (p > DBG_STOP && p != PH_COPY) continue;
#ifdef HOST_SKIP_FROM
        if (p >= HOST_SKIP_FROM && p != PH_COPY) continue;
#endif
        a.ph_lo = p; a.ph_hi = p + 1;
        const int slot = (p == 0) ? 0 : (p == PH_COPY ? 100 : 1 + (p - 1) % PH_PER_LAYER);
#define LCH(S) case S: hipLaunchKernelGGL(fwd_kernel<S>, dim3(grid), dim3(NTHR), LDS_BYTES, stream, a); break
        switch (slot) { LCH(0); LCH(1); LCH(2); LCH(3); LCH(4); LCH(5); LCH(6); LCH(7); LCH(8); LCH(9); LCH(10); LCH(11); LCH(12); LCH(13); LCH(14); LCH(15); LCH(100); default: break; }
#undef LCH
    }
#endif
    const hipError_t le = hipPeekAtLastError();
    if (le != hipSuccess) fprintf(stderr, "kernel_launch: launch failed: %s\n", hipGetErrorName(le));
}
```

```cpp
#include <hip/hip_runtime.h>
#include <cstdio>
#include <cstdint>
#define MK_ONE_LAUNCH 1
#define DBG_STOP 1000
#ifndef MK_ONE_LAUNCH
#define MK_ONE_LAUNCH 1
#endif
namespace pg8 {
#define PG8_LAS __attribute__((address_space(3)))
typedef unsigned short bf16_t;
typedef short bf16x8 __attribute__((ext_vector_type(8)));
typedef float f32x4 __attribute__((ext_vector_type(4)));
typedef unsigned u32x4 __attribute__((ext_vector_type(4)));
constexpr int BM = 256, BK = 64, HALF = 128, HTB = HALF * BK * 2  , STAGE_BYTES = 8 * HTB, NXCD = 8, WGM = 8;

__host__ __device__ __forceinline__ int lds_byte(int r, int c) { const int st = (r >> 4) * 2 + (c >> 5), rr = r & 15, cc = c & 31, ob = rr * 64 + cc * 2; return st * 1024 + (ob ^ (((ob >> 9) & 1) << 5)); }
__host__ __device__ __forceinline__ void stage_rc(int b, int& R, int& C) { const int st = b / 1024, sb = b % 1024, swz = sb ^ (((sb >> 9) & 1) << 5); R = (st >> 1) * 16 + swz / 64; C = (st & 1) * 32 + (swz % 64) / 2; }
__host__ __device__ __forceinline__ int perm32(int rho) { const int n = rho >> 4, i = rho & 15; return 8 * (i >> 2) + 4 * n + (i & 3); }

struct Unit { int pm, pn; };
struct Gemm { const bf16_t* A; const bf16_t* Bt; int M, N, K; int ld; size_t apm, bpm; };

struct StaticOrder {
    int nM, nN, nwg, G, c;
    __host__ __device__ void init(int M, int N, int G_, int c_) { nM = M / BM; nN = N / BM; nwg = nM * nN; G = G_; c = c_; }
    __host__ __device__ bool next(int i, Unit& u) const {
        const long L = (long)i * G + c; if (L >= nwg) return false;
        int wgid = (int)L; { const int q = nwg / NXCD, r = nwg % NXCD, xcd = wgid % NXCD, off = wgid / NXCD; wgid = (xcd < r ? xcd * (q + 1) : r * (q + 1) + (xcd - r) * q) + off; }
        const int nig = WGM * nN, gid = wgid / nig, fm = gid * WGM, gsz = (nM - fm) < WGM ? (nM - fm) : WGM;
        u.pm = fm + ((wgid % nig) % gsz); u.pn = (wgid % nig) / gsz; return true;
    }
    __device__ __forceinline__ void a_ready(const Unit&) const {}
    __device__ __forceinline__ void done(const Unit&) const {}
};

__device__ __forceinline__ unsigned cvt_pk_bf16(float lo, float hi) { unsigned r; asm volatile("s_nop 0\n\tv_cvt_pk_bf16_f32 %0, %1, %2" : "=v"(r) : "v"(lo), "v"(hi)); return r; }
template <class Epi, class Sched, bool ALIGN_EPI = false, bool SP2 = false>
__device__ __forceinline__ void gemm_phase(PG8_LAS unsigned char* lds, const Gemm g, const Sched& S, const Epi& E, int wave_in) {
    int tid_o; asm volatile("v_mbcnt_lo_u32_b32 %0, -1, 0\n\tv_mbcnt_hi_u32_b32 %0, -1, %0" : "=v"(tid_o)); tid_o += wave_in * 64;
    const int tid = tid_o, wid = wave_in, lane = tid & 63, wr = wid >> 2, wc = wid & 3, fr = lane & 15, fq = lane >> 4;
    const int K = g.K, nt = K / BK, LD = g.ld;
    unsigned voffA[2], voffB[2];
#pragma unroll
    for (int i = 0; i < 2; ++i) { int R, C; stage_rc(tid * 16 + i * 8192, R, C); const int Rb = Epi::PERM ? ((R & ~31) + perm32(R & 31)) : R;
        voffA[i] = (unsigned)(R * LD + C) * 2u; voffB[i] = (unsigned)(Rb * LD + C) * 2u; }
    const size_t kstep = (size_t)(BK * 2);
    const size_t hstep = (size_t)HALF * LD * 2;
    const size_t tstep = 2 * hstep;
    const unsigned ldsw = (unsigned)wid * 1024u;
    const int aoff = lds_byte(wr * 64 + fr, fq * 8), boff = lds_byte(wc * 32 + fr, fq * 8);
#define PG8_SA(b, h) (((b) * 2 + (h)) * HTB)
#define PG8_SB(b, h) ((4 + (b) * 2 + (h)) * HTB)
#define PG8_STAGE(bufoff, gbase, voff) do { _Pragma("unroll") for (int _i = 0; _i < 2; ++_i) \
        __builtin_amdgcn_global_load_lds((const unsigned*)((const char*)(gbase) + (voff)[_i]), (PG8_LAS unsigned*)(lds + (bufoff) + ldsw + _i * 8192), 16, 0, 0); } while (0)
#define PG8_LDA(dst, b, h) do { _Pragma("unroll") for (int m = 0; m < 4; ++m) _Pragma("unroll") for (int k = 0; k < 2; ++k) dst[m][k] = *(const PG8_LAS bf16x8*)(lds + PG8_SA(b, h) + aoff + m * 2048 + k * 1024); } while (0)
#define PG8_LDB(dst, b, h) do { _Pragma("unroll") for (int n = 0; n < 2; ++n) _Pragma("unroll") for (int k = 0; k < 2; ++k) dst[n][k] = *(const PG8_LAS bf16x8*)(lds + PG8_SB(b, h) + boff + n * 2048 + k * 1024); } while (0)
#define PG8_MMA(ai, bj, At, Bt) do { __builtin_amdgcn_s_setprio(1); _Pragma("unroll") for (int m = 0; m < 4; ++m) _Pragma("unroll") for (int n = 0; n < 2; ++n) _Pragma("unroll") for (int k = 0; k < 2; ++k) \
        acc[ai][bj][m][n] = __builtin_amdgcn_mfma_f32_16x16x32_bf16(Bt[n][k], At[m][k], acc[ai][bj][m][n], 0, 0, 0); __builtin_amdgcn_s_setprio(0); } while (0)
#define PG8_WAIT_V(n) asm volatile("s_waitcnt vmcnt(" #n ")" ::: "memory")
#define PG8_WAIT_L(n) asm volatile("s_waitcnt lgkmcnt(" #n ")" ::: "memory")
#define PG8_BAR __builtin_amdgcn_s_barrier()
#define PG8_SCHED __builtin_amdgcn_sched_barrier(0)
    Unit cur, nxt; int ui = 0;
    if (!S.next(0, cur)) return;
    f32x4 acc[2][2][4][2];
#pragma unroll
    for (int a = 0; a < 2; ++a)
#pragma unroll
        for (int b = 0; b < 2; ++b)
#pragma unroll
            for (int m = 0; m < 4; ++m)
#pragma unroll
                for (int n = 0; n < 2; ++n) acc[a][b][m][n] = (f32x4){0.f, 0.f, 0.f, 0.f};
    bf16x8 At[4][2], B0[2][2], B1[2][2];
    const char* cA = (const char*)g.A + (size_t)cur.pm * g.apm; const char* cB = (const char*)g.Bt + (size_t)cur.pn * tstep + (size_t)cur.pm * g.bpm;
    S.a_ready(cur);
    if constexpr (SP2) {
        PG8_STAGE(PG8_SB(0, 0), cB, voffB); PG8_STAGE(PG8_SB(0, 1), cB + hstep, voffB); PG8_STAGE(PG8_SA(0, 0), cA, voffA); PG8_STAGE(PG8_SA(0, 1), cA + hstep, voffA);
        if (wr == 1) PG8_BAR;
        PG8_WAIT_V(2); PG8_BAR;
        PG8_STAGE(PG8_SB(1, 0), cB + kstep, voffB); PG8_STAGE(PG8_SA(1, 0), cA + kstep, voffA); PG8_STAGE(PG8_SB(1, 1), cB + hstep + kstep, voffB);
        PG8_WAIT_V(6); PG8_BAR;
    } else {
        PG8_STAGE(PG8_SB(0, 0), cB, voffB); PG8_STAGE(PG8_SA(0, 0), cA, voffA); PG8_STAGE(PG8_SB(0, 1), cB + hstep, voffB); PG8_STAGE(PG8_SA(0, 1), cA + hstep, voffA);
        if (wr == 1) PG8_BAR;
        PG8_WAIT_V(4); PG8_BAR;
        PG8_STAGE(PG8_SB(1, 0), cB + kstep, voffB); PG8_STAGE(PG8_SA(1, 0), cA + kstep, voffA); PG8_STAGE(PG8_SB(1, 1), cB + hstep + kstep, voffB);
        PG8_WAIT_V(6); PG8_BAR;
    }
    for (;;) {
        const bool has_next = S.next(ui + 1, nxt);
        const char* nA = has_next ? (const char*)g.A + (size_t)nxt.pm * g.apm : cA; const char* nB = has_next ? (const char*)g.Bt + (size_t)nxt.pn * tstep + (size_t)nxt.pm * g.bpm : cB;
        for (int t = 0; t < nt; t += 2) {
            const bool last = (t == nt - 2);
            const char* a1 = cA + (size_t)(t + 1) * kstep;
            const char* a2 = last ? nA : cA + (size_t)(t + 2) * kstep; const char* b2 = last ? nB : cB + (size_t)(t + 2) * kstep;
            const char* a3 = a2 + kstep; const char* b3 = b2 + kstep;
            if (last && has_next) S.a_ready(nxt);
            if constexpr (SP2) {
            PG8_LDB(B0, 0, 0); PG8_LDB(B1, 0, 1); PG8_SCHED; PG8_LDA(At, 0, 0); PG8_STAGE(PG8_SA(1, 1), a1 + hstep, voffA);
            PG8_WAIT_V(8); PG8_WAIT_L(0); PG8_BAR; PG8_MMA(0, 0, At, B0); PG8_MMA(0, 1, At, B1); PG8_BAR; PG8_SCHED;
            PG8_LDA(At, 0, 1); PG8_STAGE(PG8_SB(0, 0), b2, voffB); PG8_STAGE(PG8_SB(0, 1), b2 + hstep, voffB); PG8_STAGE(PG8_SA(0, 0), a2, voffA);
            PG8_WAIT_V(8); PG8_WAIT_L(0); PG8_BAR; PG8_MMA(1, 0, At, B0); PG8_MMA(1, 1, At, B1); PG8_BAR; PG8_SCHED;
            PG8_LDB(B0, 1, 0); PG8_LDB(B1, 1, 1); PG8_SCHED; PG8_LDA(At, 1, 0); PG8_STAGE(PG8_SA(0, 1), a2 + hstep, voffA);
            PG8_WAIT_V(8); PG8_WAIT_L(0); PG8_BAR; PG8_MMA(0, 0, At, B0); PG8_MMA(0, 1, At, B1); PG8_BAR; PG8_SCHED;
            PG8_LDA(At, 1, 1); PG8_STAGE(PG8_SB(1, 0), b3, voffB); PG8_STAGE(PG8_SB(1, 1), b3 + hstep, voffB); PG8_STAGE(PG8_SA(1, 0), a3, voffA);
            PG8_WAIT_V(8); PG8_WAIT_L(0); PG8_BAR; PG8_MMA(1, 0, At, B0); PG8_MMA(1, 1, At, B1); PG8_BAR; PG8_SCHED;
            } else {
            PG8_LDB(B0, 0, 0); PG8_SCHED; PG8_LDA(At, 0, 0); PG8_STAGE(PG8_SA(1, 1), a1 + hstep, voffA);
            PG8_WAIT_L(8); PG8_BAR; PG8_WAIT_L(0); PG8_MMA(0, 0, At, B0); PG8_BAR; PG8_SCHED;
            PG8_LDB(B1, 0, 1); PG8_STAGE(PG8_SB(0, 0), b2, voffB);
            PG8_BAR; PG8_WAIT_L(0); PG8_MMA(0, 1, At, B1); PG8_BAR;
            PG8_LDA(At, 0, 1); PG8_STAGE(PG8_SA(0, 0), a2, voffA);
            PG8_BAR; PG8_WAIT_L(0); PG8_MMA(1, 0, At, B0); PG8_BAR; PG8_SCHED;
            PG8_STAGE(PG8_SB(0, 1), b2 + hstep, voffB);
            PG8_WAIT_V(6); PG8_BAR; PG8_MMA(1, 1, At, B1); PG8_BAR;
            PG8_LDB(B0, 1, 0); PG8_SCHED; PG8_LDA(At, 1, 0); PG8_STAGE(PG8_SA(0, 1), a2 + hstep, voffA);
            PG8_WAIT_L(8); PG8_BAR; PG8_WAIT_L(0); PG8_MMA(0, 0, At, B0); PG8_BAR; PG8_SCHED;
            PG8_LDB(B1, 1, 1); PG8_STAGE(PG8_SB(1, 0), b3, voffB);
            PG8_BAR; PG8_WAIT_L(0); PG8_MMA(0, 1, At, B1); PG8_BAR;
            PG8_LDA(At, 1, 1); PG8_STAGE(PG8_SA(1, 0), a3, voffA);
            PG8_BAR; PG8_WAIT_L(0); PG8_MMA(1, 0, At, B0); PG8_BAR; PG8_SCHED;
            PG8_STAGE(PG8_SB(1, 1), b3 + hstep, voffB);
            PG8_WAIT_V(6); PG8_BAR; PG8_MMA(1, 1, At, B1); PG8_BAR;
            }
        }
        if constexpr (ALIGN_EPI) { if (wr == 0) PG8_BAR; }
        if constexpr (!Epi::AFTER_DRAIN) { E(acc, cur, wr, wc, fr, fq); S.done(cur); }
        if (!has_next) break;
#pragma unroll
        for (int a = 0; a < 2; ++a)
#pragma unroll
            for (int b = 0; b < 2; ++b)
#pragma unroll
                for (int m = 0; m < 4; ++m)
#pragma unroll
                    for (int n = 0; n < 2; ++n) acc[a][b][m][n] = (f32x4){0.f, 0.f, 0.f, 0.f};
        cur = nxt; cA = nA; cB = nB; ++ui;
        if constexpr (ALIGN_EPI) { if (wr == 1) PG8_BAR; }
    }
    PG8_WAIT_V(0);
    if constexpr (!ALIGN_EPI) { if (wr == 0) PG8_BAR; }
    PG8_BAR;
    if constexpr (Epi::AFTER_DRAIN) { E.fused(acc, cur, wr, wc, fr, fq, lds, wid, lane); S.done(cur); }
#undef PG8_SA
#undef PG8_SB
#undef PG8_STAGE
#undef PG8_LDA
#undef PG8_LDB
#undef PG8_MMA
#undef PG8_WAIT_V
#undef PG8_WAIT_L
#undef PG8_BAR
#undef PG8_SCHED
}
}
#define GAS __attribute__((address_space(1)))
#define LAS __attribute__((address_space(3)))
typedef unsigned short bf16;
typedef unsigned v4u __attribute__((ext_vector_type(4)));
typedef float f32x4 __attribute__((ext_vector_type(4)));
typedef short bf16x8 __attribute__((ext_vector_type(8)));
typedef GAS unsigned gu32;
typedef GAS unsigned long long gu64;
#define RLX_AGENT __ATOMIC_RELAXED, __HIP_MEMORY_SCOPE_AGENT
#define LDS_WAIT() asm volatile("s_waitcnt lgkmcnt(0)" ::: "memory")
#define VM_WAIT() asm volatile("s_waitcnt vmcnt(0)" ::: "memory")
__device__ __forceinline__ unsigned long long rt() { return __builtin_amdgcn_s_memrealtime(); }
__device__ __forceinline__ unsigned f2bf(float f) { unsigned u = __builtin_bit_cast(unsigned, f); return (u + 0x7fffu + ((u >> 16) & 1u)) >> 16; }
__device__ __forceinline__ unsigned pk2(float lo, float hi) { return f2bf(lo) | (f2bf(hi) << 16); }

#define XB_TMO      128
#define XB_XCNT(j)  (256  + 64 * (j))
#define XB_XSUB(j)  (1280 + 64 * (j))
#define XB_XGEN(j)  (2304 + 64 * (j))
#define XB_TOP      3328
#define XB_TOPGEN   3392
#define XCD_BAR_WORDS 3456
#define XB_SPIN_CAP (1u << 18)

__device__ __forceinline__ unsigned xb_ld(unsigned* p)              { return __hip_atomic_load(p, __ATOMIC_RELAXED, __HIP_MEMORY_SCOPE_AGENT); }
__device__ __forceinline__ unsigned xb_add(unsigned* p, unsigned v) { return __hip_atomic_fetch_add(p, v, __ATOMIC_RELAXED, __HIP_MEMORY_SCOPE_AGENT); }
__device__ __forceinline__ unsigned xb_xcc_id() { return (unsigned)__builtin_amdgcn_s_getreg((3 << 11) | 20) & 0xFu; }
#define XB_SPIN(cond, bar) do { unsigned _sp = 0; while (cond) { __builtin_amdgcn_s_sleep(1); \
    if ((++_sp & 255u) == 0u) { if (xb_ld(&(bar)[XB_TMO])) break; if (_sp > XB_SPIN_CAP) { atomicAdd(&(bar)[XB_TMO], 1u); break; } } } } while (0)

struct XcdBarrier {
    unsigned* bar; unsigned x;
    volatile LAS unsigned* st;
    int wave;
};
__device__ __forceinline__ int xb_lane() { int l; asm volatile("v_mbcnt_lo_u32_b32 %0, -1, 0\n\tv_mbcnt_hi_u32_b32 %0, -1, %0" : "=v"(l)); return l; }

__device__ __forceinline__ XcdBarrier xcd_barrier_post(unsigned* bar, volatile LAS unsigned* st) {
    XcdBarrier b; b.bar = bar; b.x = xb_xcc_id(); b.st = st; b.wave = 0;
    if (threadIdx.x == 0) (void)xb_add(&bar[XB_XCNT(b.x)], 1u);
    return b;
}
__device__ __forceinline__ void xcd_barrier_complete(unsigned* bar, unsigned x, unsigned& nloc, unsigned& nx) {
    const unsigned G = gridDim.x * gridDim.y * gridDim.z;
    unsigned sum, cnt, mine, sp = 0u;
    for (;;) {
        sum = 0u; cnt = 0u; mine = 0u;
#pragma unroll
        for (unsigned j = 0; j < 16; ++j) { const unsigned c = xb_ld(&bar[XB_XCNT(j)]); sum += c; cnt += (c > 0u) ? 1u : 0u; mine = (j == x) ? c : mine; }
        if (sum == G) break;
        __builtin_amdgcn_s_sleep(1);
        if ((++sp & 255u) == 0u) { if (xb_ld(&bar[XB_TMO])) break; if (sp > XB_SPIN_CAP) { atomicAdd(&bar[XB_TMO], 1u); break; } }
    }
    nloc = mine > 0u ? mine : 1u; nx = cnt > 0u ? cnt : 1u;
}

__device__ __forceinline__ void xcd_barrier(const XcdBarrier& b) {
    asm volatile("s_waitcnt vmcnt(0)" ::: "memory");
    __syncthreads();
    if (b.wave == 0 && xb_lane() == 0) {
        unsigned* bar = b.bar;
        __builtin_amdgcn_s_waitcnt(0);
        unsigned nloc = b.st[0], nx = b.st[1];
        if (nloc == 0u) { xcd_barrier_complete(bar, b.x, nloc, nx); b.st[0] = nloc; b.st[1] = nx; }
        const unsigned old = xb_add(&bar[XB_XSUB(b.x)], 1u);
        const unsigned gen = old / nloc;
        if (old + 1u == (gen + 1u) * nloc) {
            __builtin_amdgcn_fence(__ATOMIC_RELEASE, "agent");
            asm volatile("s_waitcnt vmcnt(0)" ::: "memory");
            const unsigned og = xb_add(&bar[XB_TOP], 1u);
            const unsigned tg = og / nx;
            if (og + 1u == (tg + 1u) * nx) xb_add(&bar[XB_TOPGEN], 1u);
            else XB_SPIN(xb_ld(&bar[XB_TOPGEN]) == tg, bar);
            __builtin_amdgcn_fence(__ATOMIC_ACQUIRE, "agent");
            xb_add(&bar[XB_XGEN(b.x)], 1u);
            asm volatile("s_waitcnt vmcnt(0)" ::: "memory");
        } else {
            XB_SPIN(xb_ld(&bar[XB_XGEN(b.x)]) == gen, bar);
            __builtin_amdgcn_fence(__ATOMIC_ACQUIRE, "agent");
            asm volatile("s_waitcnt vmcnt(0)" ::: "memory");
        }
    }
    __syncthreads();
}

#ifndef BG_CONV
#define BG_CONV 1
#endif
constexpr int NWAVES = 8, NTHR = 512;
constexpr int DM = 4096, SEQ = 8192, CTXL = 256, MROWS = SEQ + CTXL, DFF = 8192, NMODC = 9 * DM;
constexpr int RWW = 2048, RWCOLS = 6592, ZC = 8192;
constexpr int LDS_BYTES = 155648;
constexpr int MISC_OFF = 151552;

constexpr size_t MiB = 1u << 20;
constexpr size_t al(size_t x) { return (x + MiB - 1) / MiB * MiB; }
constexpr size_t WS_CTL = 0, WS_MOD = 1 * MiB, ZERO_BYTES = 2 * MiB;
constexpr size_t SZ_WFI = (size_t)16384 * 4096 * 2, SZ_WFO = (size_t)4096 * 8192 * 2, SZ_WIN = (size_t)8192 * 4096 * 2, SZ_WOUT = (size_t)4096 * 4096 * 2;
constexpr size_t SZ_WQ = (size_t)3072 * 1024 * 2, SZ_WKV = (size_t)4096 * 512 * 2, SZ_WWA = (size_t)10240 * 512 * 2, SZ_WG = 0;
constexpr size_t WS_WFI = 2 * MiB, WS_WFO = WS_WFI + 4 * SZ_WFI, WS_WIN = WS_WFO + 4 * SZ_WFO, WS_WOUT = WS_WIN + 2 * SZ_WIN, WS_WQ = WS_WOUT + 2 * SZ_WOUT;
constexpr size_t WS_WKV = WS_WQ + 2 * SZ_WQ, WS_WWA = WS_WKV + 2 * SZ_WKV, WS_WG = WS_WWA + 2 * SZ_WWA, WS_ACT = WS_WG + 2 * SZ_WG;
constexpr size_t WS_X = WS_ACT;
constexpr size_t WS_XN = WS_X + al((size_t)MROWS * DM * 4);
constexpr size_t WS_H = WS_XN + al((size_t)MROWS * DM * 2);
constexpr size_t WS_Z = WS_H + al((size_t)MROWS * DFF * 2);
constexpr size_t WS_SS = WS_Z + al((size_t)MROWS * ZC * 4);
constexpr size_t WS_VV = WS_SS + al((size_t)MROWS * 4096 * 4);
constexpr size_t WS_KT = WS_VV + al((size_t)MROWS * 2048 * 4);
constexpr size_t WS_LW = WS_KT + al((size_t)MROWS * 2048 * 4);
constexpr size_t WS_LWA = WS_LW + al((size_t)MROWS * 10240 * 4);
constexpr size_t WS_LG = WS_LWA + al((size_t)MROWS * 512 * 2);
constexpr size_t WS_QL = WS_LG + al((size_t)MROWS * 256 * 2);
constexpr size_t WS_KVL = WS_QL + al((size_t)MROWS * 1024 * 2);
constexpr size_t WS_QF = WS_KVL + al((size_t)MROWS * 512 * 2);
constexpr size_t WS_KVF = WS_QF + al((size_t)MROWS * 3072 * 4);
#ifndef QB_GAP
#define QB_GAP 0
#endif
constexpr size_t WS_QB = WS_KVF + al((size_t)MROWS * 4096 * 4) + (size_t)QB_GAP * MiB;
constexpr size_t WS_KB = WS_QB + al((size_t)MROWS * 3072 * 2);
constexpr size_t WS_VB = WS_KB + al((size_t)MROWS * 3072 * 2);
constexpr size_t WS_Y = WS_VB + al((size_t)MROWS * 2048 * 2);
constexpr size_t WS_OC = WS_Y + al((size_t)2 * MROWS * 2048 * 4);
constexpr int SK_NS = 8;
constexpr size_t WS_ACC = WS_OC + al((size_t)MROWS * DM * 2);
constexpr size_t SZ_ACC = (size_t)CTXL * DM * 4;
constexpr size_t WS_SLB = WS_ACC + SK_NS * SZ_ACC;
constexpr size_t WS_END = WS_SLB + 32 * MiB;
constexpr int CW_BAR = 4096, CW_MIX = 8192;

enum { I_X = 0, I_C, I_CTX, I_CCTX, I_WMOD, I_BMOD, I_NORMG, I_FWI, I_FWO, I_WIN, I_WOUT, I_MU, I_W0, I_WUP, I_A0, I_AUP, I_GUP, I_KK, I_KA, I_RK, I_LNW, I_LNB,
       I_QNORM, I_QUP, I_KVNORM, I_KVUP, I_QGAIN, I_KGAIN, N_IN };

__device__ __forceinline__ int lane_vol() { int l; asm volatile("v_mbcnt_lo_u32_b32 %0, -1, 0\n\tv_mbcnt_hi_u32_b32 %0, -1, %0" : "=v"(l)); return l; }
__device__ __forceinline__ float wave_sum(float v) {
#pragma unroll
    for (int o = 1; o < 64; o <<= 1) v += __shfl_xor(v, o);
    return v;
}
__device__ __forceinline__ float sum16(float v) {
#pragma unroll
    for (int o = 1; o < 16; o <<= 1) v += __shfl_xor(v, o);
    return v;
}
__device__ __forceinline__ float sigm(float x) { return __builtin_amdgcn_rcpf(1.f + __builtin_amdgcn_exp2f(-1.4426950408889634f * x)); }
__device__ __forceinline__ float dot4(f32x4 a, f32x4 b) { return (a.x * b.x + a.y * b.y) + (a.z * b.z + a.w * b.w); }
typedef unsigned u32x2 __attribute__((ext_vector_type(2)));
__device__ __forceinline__ f32x4 ubf4(u32x2 w) { f32x4 r; r.x = __uint_as_float(w.x << 16); r.y = __uint_as_float(w.x & 0xffff0000u); r.z = __uint_as_float(w.y << 16); r.w = __uint_as_float(w.y & 0xffff0000u); return r; }
__device__ __forceinline__ u32x2 pk4(f32x4 v) { u32x2 r; r.x = pg8::cvt_pk_bf16(v.x, v.y); r.y = pg8::cvt_pk_bf16(v.z, v.w); return r; }

struct EpiSwiGLU {
    static constexpr bool PERM = true, AFTER_DRAIN = false;
    bf16* H;
    __device__ __forceinline__ void operator()(const pg8::f32x4 (&acc)[2][2][4][2], const pg8::Unit& u, int wr, int wc, int fr, int fq) const {
        const int row0 = u.pm * 256 + wr * 64 + fr, col0 = u.pn * 128 + wc * 32 + 8 * fq;
#pragma unroll
        for (int ai = 0; ai < 2; ++ai)
#pragma unroll
            for (int m = 0; m < 4; ++m) {
                bf16* rowp = H + (size_t)(row0 + ai * 128 + m * 16) * DFF + col0;
                const pg8::f32x4 g0 = acc[ai][0][m][0], g1 = acc[ai][0][m][1], u0 = acc[ai][1][m][0], u1 = acc[ai][1][m][1];
                pg8::u32x4 w;
                w.x = pg8::cvt_pk_bf16(g0[0] * sigm(g0[0]) * u0[0], g0[1] * sigm(g0[1]) * u0[1]);
                w.y = pg8::cvt_pk_bf16(g0[2] * sigm(g0[2]) * u0[2], g0[3] * sigm(g0[3]) * u0[3]);
                w.z = pg8::cvt_pk_bf16(g1[0] * sigm(g1[0]) * u1[0], g1[1] * sigm(g1[1]) * u1[1]);
                w.w = pg8::cvt_pk_bf16(g1[2] * sigm(g1[2]) * u1[2], g1[3] * sigm(g1[3]) * u1[3]);
                *(pg8::u32x4*)rowp = w;
            }
    }
};
struct EpiRes {
    static constexpr bool PERM = false, AFTER_DRAIN = false;
    const float* inL; const float* inC; float* outL; float* outC; const float* gateL; const float* gateC; float coef;
    __device__ __forceinline__ void operator()(const pg8::f32x4 (&acc)[2][2][4][2], const pg8::Unit& u, int wr, int wc, int fr, int fq) const {
        const bool lat = u.pm < 32;
        const int rl0 = (lat ? u.pm : u.pm - 32) * 256 + wr * 64 + fr, col0 = u.pn * 256 + wc * 32 + 4 * fq;
        const float* in = lat ? inL : inC; float* out = lat ? outL : outC; const float* gate = lat ? gateL : gateC;
        pg8::f32x4 gv[2][2];
#pragma unroll
        for (int bj = 0; bj < 2; ++bj)
#pragma unroll
            for (int n = 0; n < 2; ++n) gv[bj][n] = *(const pg8::f32x4*)(gate + col0 + bj * 128 + n * 16) * coef;
#pragma unroll
        for (int ai = 0; ai < 2; ++ai)
#pragma unroll
            for (int m = 0; m < 4; ++m) {
                const size_t off = (size_t)(rl0 + ai * 128 + m * 16) * DM + col0;
#pragma unroll
                for (int bj = 0; bj < 2; ++bj)
#pragma unroll
                    for (int n = 0; n < 2; ++n) { const pg8::f32x4 xi = *(const pg8::f32x4*)(in + off + bj * 128 + n * 16);
                        *(pg8::f32x4*)(out + off + bj * 128 + n * 16) = xi + gv[bj][n] * acc[ai][bj][m][n]; }
            }
    }
};
struct EpiSlab {
    static constexpr bool PERM = false, AFTER_DRAIN = false;
    float* out; const float* gate; float coef;
    __device__ __forceinline__ void operator()(const pg8::f32x4 (&acc)[2][2][4][2], const pg8::Unit& u, int wr, int wc, int fr, int fq) const {
        const int rl0 = wr * 64 + fr, col0 = u.pn * 256 + wc * 32 + 4 * fq;
        float* o = out + (size_t)u.pm * CTXL * DM;
        pg8::f32x4 gv[2][2];
#pragma unroll
        for (int bj = 0; bj < 2; ++bj)
#pragma unroll
            for (int n = 0; n < 2; ++n) gv[bj][n] = *(const pg8::f32x4*)(gate + col0 + bj * 128 + n * 16) * coef;
#pragma unroll
        for (int ai = 0; ai < 2; ++ai)
#pragma unroll
            for (int m = 0; m < 4; ++m) {
                const size_t off = (size_t)(rl0 + ai * 128 + m * 16) * DM + col0;
#pragma unroll
                for (int bj = 0; bj < 2; ++bj)
#pragma unroll
                    for (int n = 0; n < 2; ++n) *(pg8::f32x4*)(o + off + bj * 128 + n * 16) = gv[bj][n] * acc[ai][bj][m][n];
            }
    }
};
struct EpiB16 {
    static constexpr bool PERM = true, AFTER_DRAIN = false;
    bf16* C; int ldc;
    __device__ __forceinline__ void operator()(const pg8::f32x4 (&acc)[2][2][4][2], const pg8::Unit& u, int wr, int wc, int fr, int fq) const {
        const int row0 = u.pm * 256 + wr * 64 + fr, col0 = u.pn * 256 + wc * 32 + 8 * fq;
#pragma unroll
        for (int ai = 0; ai < 2; ++ai)
#pragma unroll
            for (int m = 0; m < 4; ++m) { bf16* rowp = C + (size_t)(row0 + ai * 128 + m * 16) * ldc + col0;
#pragma unroll
                for (int bj = 0; bj < 2; ++bj) { const pg8::f32x4 v0 = acc[ai][bj][m][0], v1 = acc[ai][bj][m][1]; pg8::u32x4 w;
                    w.x = pg8::cvt_pk_bf16(v0[0], v0[1]); w.y = pg8::cvt_pk_bf16(v0[2], v0[3]); w.z = pg8::cvt_pk_bf16(v1[0], v1[1]); w.w = pg8::cvt_pk_bf16(v1[2], v1[3]);
                    *(pg8::u32x4*)(rowp + bj * 128) = w; } }
    }
};
struct EpiSlabP {
    static constexpr bool PERM = true, AFTER_DRAIN = false;
    float* out; int ldo;
    __device__ __forceinline__ void operator()(const pg8::f32x4 (&acc)[2][2][4][2], const pg8::Unit& u, int wr, int wc, int fr, int fq) const {
        const int row0 = wr * 64 + fr, col0 = u.pn * 256 + wc * 32 + 8 * fq;
        float* o = out + (size_t)u.pm * CTXL * ldo;
#pragma unroll
        for (int ai = 0; ai < 2; ++ai)
#pragma unroll
            for (int m = 0; m < 4; ++m) { float* rowp = o + (size_t)(row0 + ai * 128 + m * 16) * ldo + col0;
#pragma unroll
                for (int bj = 0; bj < 2; ++bj) { *(pg8::f32x4*)(rowp + bj * 128) = acc[ai][bj][m][0]; *(pg8::f32x4*)(rowp + bj * 128 + 4) = acc[ai][bj][m][1]; } }
    }
};
struct EpiF32 {
    static constexpr bool PERM = false, AFTER_DRAIN = false;
    float* C; int ldc;
    __device__ __forceinline__ void operator()(const pg8::f32x4 (&acc)[2][2][4][2], const pg8::Unit& u, int wr, int wc, int fr, int fq) const {
        const int row0 = u.pm * 256 + wr * 64 + fr, col0 = u.pn * 256 + wc * 32 + 4 * fq;
#pragma unroll
        for (int ai = 0; ai < 2; ++ai)
#pragma unroll
            for (int m = 0; m < 4; ++m) { float* rowp = C + (size_t)(row0 + ai * 128 + m * 16) * ldc + col0;
#pragma unroll
                for (int bj = 0; bj < 2; ++bj)
#pragma unroll
                    for (int n = 0; n < 2; ++n) *(pg8::f32x4*)(rowp + bj * 128 + n * 16) = acc[ai][bj][m][n]; }
    }
};
template <int MAP> __device__ __forceinline__ int map_row(int n) {
    if (MAP == 1) { const int bj = n >> 13, r = n & 8191; return 256 * (r >> 7) + 128 * bj + (r & 127); }
    return n;
}
template <int MAP> __device__ __forceinline__ void transpose_item(const float* W, int K, int N, bf16* WT, LAS float* scr, int item, int lane) {
    const int nblk = N >> 6, kb = item / nblk, nb = item - kb * nblk, k0 = kb * 64, n0 = nb * 64;
    const int kr = lane >> 4, nq = lane & 15;
    f32x4 v[16];
#pragma unroll
    for (int i = 0; i < 16; ++i) v[i] = *(const f32x4*)(W + (size_t)(k0 + 4 * i + kr) * N + n0 + 4 * nq);
#pragma unroll
    for (int i = 0; i < 16; ++i) { const int k = 4 * i + kr;
        scr[(4 * nq + 0) * 65 + k] = v[i].x; scr[(4 * nq + 1) * 65 + k] = v[i].y; scr[(4 * nq + 2) * 65 + k] = v[i].z; scr[(4 * nq + 3) * 65 + k] = v[i].w; }
    LDS_WAIT(); asm volatile("" ::: "memory");
    const int c = lane & 7, nl = lane >> 3, r0 = map_row<MAP>(n0);
#pragma unroll
    for (int j = 0; j < 8; ++j) { const int n = nl + 8 * j; const LAS float* s = scr + n * 65 + 8 * c;
        v4u o; o.x = pk2(s[0], s[1]); o.y = pk2(s[2], s[3]); o.z = pk2(s[4], s[5]); o.w = pk2(s[6], s[7]);
        *(v4u*)(WT + (size_t)(r0 + n) * K + k0 + 8 * c) = o; }
    LDS_WAIT(); asm volatile("" ::: "memory");
}

struct Ptrs {
    const float* in[N_IN]; float* out; unsigned char* ws;
};
constexpr int PT_OFF = 151552 + 1024;
__device__ __forceinline__ unsigned long long ld_uptr(LAS unsigned char* lds, int i) {
    const unsigned long long v = *(const LAS unsigned long long*)(lds + PT_OFF + 8 * i);
    const unsigned lo = __builtin_amdgcn_readfirstlane((unsigned)v), hi = __builtin_amdgcn_readfirstlane((unsigned)(v >> 32));
    return ((unsigned long long)hi << 32) | lo;
}
__device__ __forceinline__ Ptrs load_ptrs(LAS unsigned char* lds) {
    asm volatile("" ::: "memory");
    Ptrs P;
#pragma unroll
    for (int i = 0; i < N_IN; ++i) P.in[i] = (const float*)(const GAS float*)ld_uptr(lds, i);
    P.out = (float*)(GAS float*)ld_uptr(lds, N_IN); P.ws = (unsigned char*)(GAS unsigned char*)ld_uptr(lds, N_IN + 1);
    return P;
}

__device__ __forceinline__ void prologue_phase(LAS unsigned char* lds, int vcu, int G, int wave) {
    const Ptrs P = load_ptrs(lds); const int lane = lane_vol(), tid = wave * 64 + lane;
    unsigned char* ws = P.ws;
    {
        LAS float* sil = (LAS float*)lds; LAS float* red = (LAS float*)(lds + 32768);
        for (int i = tid; i < DM; i += NTHR) { const float a = P.in[I_C][i], b = P.in[I_CCTX][i]; sil[i] = a * sigm(a); sil[DM + i] = b * sigm(b); }
        __syncthreads();
        float* MOD = (float*)(ws + WS_MOD);
        for (int u = vcu; u < (BG_CONV ? 2304 : 4608); u += G) {
            const int l = u / 2304, rem = u - l * 2304, nch = rem >> 4, ks = rem & 15;
            const float* W = P.in[I_WMOD] + (size_t)l * DM * NMODC + (size_t)(ks * 256 + wave * 32) * NMODC + nch * 256 + 4 * lane;
            f32x4 a0 = {0.f, 0.f, 0.f, 0.f}, a1 = {0.f, 0.f, 0.f, 0.f};
#pragma unroll
            for (int hb = 0; hb < 2; ++hb) {
                f32x4 wv[16];
#pragma unroll
                for (int kk = 0; kk < 16; ++kk) wv[kk] = *(const f32x4*)(W + (size_t)(hb * 16 + kk) * NMODC);
#pragma unroll
                for (int kk = 0; kk < 16; ++kk) { const int k = ks * 256 + wave * 32 + hb * 16 + kk; const float s0 = sil[k], s1 = sil[DM + k]; a0 += wv[kk] * s0; a1 += wv[kk] * s1; }
            }
            *(LAS f32x4*)(red + wave * 512 + 4 * lane) = a0; *(LAS f32x4*)(red + wave * 512 + 256 + 4 * lane) = a1;
            __syncthreads();
            { const int w = tid >> 8, col = tid & 255; float s = 0.f;
#pragma unroll
              for (int q = 0; q < 8; ++q) s += red[q * 512 + w * 256 + col];
              if (ks == 0) s += P.in[I_BMOD][l * NMODC + nch * 256 + col];
              atomicAdd(MOD + (size_t)(l * 2 + w) * NMODC + nch * 256 + col, s); }
            __syncthreads();
        }
    }
    {
        LAS float* scr = (LAS float*)(lds + wave * 16640);
        const int gw = vcu * NWAVES + wave, NGW = G * NWAVES;
        constexpr int I_FI = 64 * 256, I_FO = 128 * 64, I_IN = 64 * 128, I_OUT = 64 * 64, I_Q = 16 * 48, I_KV = 8 * 64;
        constexpr int PER_L = 2 * I_FI + 2 * I_FO + I_IN + I_OUT + I_Q + I_KV;
        for (int it = gw; it < (BG_CONV ? 1 : 2) * PER_L; it += NGW) {
            const int l = it / PER_L; int r = it - l * PER_L;
            if (r < 2 * I_FI) { const int f = r / I_FI; r -= f * I_FI;
                transpose_item<1>(P.in[I_FWI] + (size_t)(l * 2 + f) * DM * 16384, DM, 16384, (bf16*)(ws + WS_WFI + (size_t)(l * 2 + f) * SZ_WFI), scr, r, lane); continue; } r -= 2 * I_FI;
            if (r < 2 * I_FO) { const int f = r / I_FO; r -= f * I_FO;
                transpose_item<0>(P.in[I_FWO] + (size_t)(l * 2 + f) * DFF * DM, DFF, DM, (bf16*)(ws + WS_WFO + (size_t)(l * 2 + f) * SZ_WFO), scr, r, lane); continue; } r -= 2 * I_FO;
            if (r < I_IN) { transpose_item<0>(P.in[I_WIN] + (size_t)l * DM * ZC, DM, ZC, (bf16*)(ws + WS_WIN + (size_t)l * SZ_WIN), scr, r, lane); continue; } r -= I_IN;
            if (r < I_OUT) { transpose_item<0>(P.in[I_WOUT] + (size_t)l * DM * DM, DM, DM, (bf16*)(ws + WS_WOUT + (size_t)l * SZ_WOUT), scr, r, lane); continue; } r -= I_OUT;
            if (r < I_Q) { transpose_item<0>(P.in[I_QUP] + (size_t)l * 1024 * 3072, 1024, 3072, (bf16*)(ws + WS_WQ + (size_t)l * SZ_WQ), scr, r, lane); continue; } r -= I_Q;
            transpose_item<0>(P.in[I_KVUP] + (size_t)l * 512 * 4096, 512, 4096, (bf16*)(ws + WS_WKV + (size_t)l * SZ_WKV), scr, r, lane);
        }
        const int gt = vcu * NTHR + tid, NGT = G * NTHR;
        for (int it = gt; it < 2 * 10240 * 64; it += NGT) {
            const int l = it / (10240 * 64), r = it - l * (10240 * 64), k8 = r / 10240, n = r - k8 * 10240;
            float v[8];
            if (n < 8192) {
                const bool isA = n >= 4096; const int d = (n >> 11) & 1, ch = n & 2047;
                const float* src = (isA ? P.in[I_AUP] : P.in[I_WUP]) + (size_t)(l * 2 + d) * 96 * RWW + ch;
#pragma unroll
                for (int j = 0; j < 8; ++j) { const int k = 8 * k8 + j - (isA ? 96 : 0); const bool ok_ = (k >= 0 && k < 96); const float t_ = src[(size_t)(ok_ ? k : 0) * RWW]; v[j] = ok_ ? t_ : 0.f; }
            } else {
                const int ch = n - 8192; const float* src = P.in[I_GUP] + (size_t)l * 256 * RWW + ch;
#pragma unroll
                for (int j = 0; j < 8; ++j) { const int k = 8 * k8 + j - 256; const bool ok_ = (k >= 0); const float t_ = src[(size_t)(ok_ ? k : 0) * RWW]; v[j] = ok_ ? t_ : 0.f; }
            }
            v4u o; o.x = pk2(v[0], v[1]); o.y = pk2(v[2], v[3]); o.z = pk2(v[4], v[5]); o.w = pk2(v[6], v[7]);
            *(v4u*)((bf16*)(ws + WS_WWA + (size_t)l * SZ_WWA) + (size_t)n * 512 + 8 * k8) = o;
        }
    }
}

__device__ __forceinline__ void prep_phase(LAS unsigned char* lds, const float* srcL, const float* srcC, int nrows, const float* g, const float* modL, const float* modC, int jm,
                                           bf16* XN, int gw, int NGW, int wave, const float* accC = nullptr, float* wbC = nullptr) {
    int lane = lane_vol(); const int tid = wave * 64 + lane;
    LAS float* gsL = (LAS float*)lds; LAS float* shL = gsL + DM; LAS float* gsC = shL + DM; LAS float* shC = gsC + DM;
    for (int i = tid; i < DM; i += NTHR) { const float gg = g[i];
        gsL[i] = gg * (1.f + modL[(jm + 1) * DM + i]); shL[i] = modL[jm * DM + i]; gsC[i] = gg * (1.f + modC[(jm + 1) * DM + i]); shC[i] = modC[jm * DM + i]; }
    __syncthreads();
    for (int row = gw; row < (nrows < SEQ ? nrows : SEQ); row += NGW) {
        asm volatile("" : "+v"(lane));
        const bool lat = row < SEQ;
        const f32x4* xr = (const f32x4*)(lat ? srcL + (size_t)row * DM : srcC + (size_t)(row - SEQ) * DM) + lane;
        const LAS float* gs = lat ? gsL : gsC; const LAS float* sh = lat ? shL : shC;
        f32x4 v[16]; float ss = 0.f;
#pragma unroll
        for (int j = 0; j < 16; ++j) { v[j] = xr[64 * j]; ss += dot4(v[j], v[j]); }
        const float rstd = 1.0f / sqrtf(wave_sum(ss) * (1.f / DM) + 1e-6f);
        u32x2* o = (u32x2*)(XN + (size_t)row * DM) + lane;
#pragma unroll
        for (int j = 0; j < 16; ++j) { const int c = 4 * (lane + 64 * j); const f32x4 g4 = *(const LAS f32x4*)(gs + c), s4 = *(const LAS f32x4*)(sh + c);
            o[64 * j] = pk4(v[j] * rstd * g4 + s4); }
    }
    if (nrows > SEQ) {
        LAS float* red = (LAS float*)(lds + 65536);
        for (int s = gw >> 3; s < CTXL; s += NGW >> 3) {
            asm volatile("" : "+v"(lane));
            const int c0 = wave * 512 + 4 * lane;
            const float* xr = srcC + (size_t)s * DM + c0;
            f32x4 v0 = *(const f32x4*)xr, v1 = *(const f32x4*)(xr + 256);
            if (accC != nullptr) {
#pragma unroll
                for (int sl = 0; sl < SK_NS; ++sl) { const float* a = accC + ((size_t)sl * CTXL + s) * DM + c0; v0 += *(const f32x4*)a; v1 += *(const f32x4*)(a + 256); }
                *(f32x4*)(wbC + (size_t)s * DM + c0) = v0; *(f32x4*)(wbC + (size_t)s * DM + c0 + 256) = v1;
            }
            const float ssw = wave_sum(dot4(v0, v0) + dot4(v1, v1));
            __syncthreads();
            if (lane == 0) red[wave] = ssw;
            __syncthreads();
            float tot = 0.f;
#pragma unroll
            for (int w = 0; w < NWAVES; ++w) tot += red[w];
            const float rstd = 1.0f / sqrtf(tot * (1.f / DM) + 1e-6f);
            bf16* o = XN + (size_t)(SEQ + s) * DM + c0;
            *(u32x2*)o = pk4(v0 * rstd * *(const LAS f32x4*)(gsC + c0) + *(const LAS f32x4*)(shC + c0));
            *(u32x2*)(o + 256) = pk4(v1 * rstd * *(const LAS f32x4*)(gsC + c0 + 256) + *(const LAS f32x4*)(shC + c0 + 256));
        }
    }
    __syncthreads();
}

__device__ __forceinline__ void ctx_reduce_z(const Ptrs& P, int vcu, int G, int wave) {
    int lane = lane_vol(); unsigned char* ws = P.ws;
    const float* slab = (const float*)(ws + WS_SLB); bf16* Z = (bf16*)(ws + WS_Z);
    for (int s = vcu; s < CTXL; s += G) {
        asm volatile("" : "+v"(lane));
#pragma unroll
        for (int j = 0; j < 4; ++j) { const int c = wave * 1024 + 256 * j + 4 * lane; f32x4 a = {0.f, 0.f, 0.f, 0.f};
#pragma unroll
            for (int sl = 0; sl < 4; ++sl) a += *(const f32x4*)(slab + ((size_t)sl * CTXL + s) * ZC + c);
            *(u32x2*)(Z + (size_t)(SEQ + s) * ZC + c) = pk4(a); }
    }
}

__device__ __forceinline__ void streams_phase(const Ptrs& P, int l, int gw, int NGW) {
    int lane = lane_vol();
    unsigned char* ws = P.ws;
    const bf16* Z = (const bf16*)(ws + WS_Z); bf16* SS = (bf16*)(ws + WS_SS); bf16* VV = (bf16*)(ws + WS_VV); bf16* KT = (bf16*)(ws + WS_KT);
    bf16* LWA = (bf16*)(ws + WS_LWA); bf16* QL = (bf16*)(ws + WS_QL); bf16* KVL = (bf16*)(ws + WS_KVL);
    const float* mu = P.in[I_MU] + l * RWCOLS; const float* k_k = P.in[I_KK] + l * RWW; const float* qn = P.in[I_QNORM] + l * 1024; const float* kvn = P.in[I_KVNORM] + l * 512;
    for (int row = gw; row < MROWS; row += NGW) {
        asm volatile("" : "+v"(lane));
        int nb0, nb1, nb2, nb3; bool ok0, ok1, ok2, ok3;
        if (row < SEQ) { const int gr = row >> 6, gc = row & 63; nb0 = row - 1; ok0 = gc > 0; nb1 = row + 1; ok1 = gc < 63; nb2 = row - 64; ok2 = gr > 0; nb3 = row + 64; ok3 = gr < 127; }
        else { const int s = row - SEQ; nb0 = nb1 = row - 1; ok0 = ok1 = s > 0; nb2 = nb3 = row + 1; ok2 = ok3 = s < CTXL - 1; }
        const bf16* zr = Z + (size_t)row * ZC;
#define SEG_LOAD(sg, ZZ, ZN, MU) do { constexpr int i0_ = 8 * (sg), ni = ((sg) < 3) ? 8 : 2; \
            _Pragma("unroll") for (int ii = 0; ii < ni; ++ii) { const int i = i0_ + ii; const int c4 = lane + 64 * i; const bool act = (i < 25 || lane < 48); const int c = 4 * (act ? c4 : 0); \
                const int q = (c4 >= 412) + (c4 >= 824) + (c4 >= 1236); \
                const int nrow = q == 0 ? nb0 : q == 1 ? nb1 : q == 2 ? nb2 : nb3; const bool nok = q == 0 ? ok0 : q == 1 ? ok1 : q == 2 ? ok2 : ok3; \
                ZZ[ii] = *(const u32x2*)(zr + c); \
                u32x2 znr = *(const u32x2*)(Z + (size_t)(nok ? nrow : row) * ZC + c); if (!nok) { znr.x = 0u; znr.y = 0u; }     \
                ZN[ii] = znr; MU[ii] = *(const f32x4*)(mu + c); } } while (0)
#define SEG_PROC(sg, ZZ, ZN, MU) do { constexpr int i0_ = 8 * (sg), ni = ((sg) < 3) ? 8 : 2; \
            _Pragma("unroll") for (int ii = 0; ii < ni; ++ii) { const int i = i0_ + ii; const int c4 = lane + 64 * i, c = 4 * c4; \
              if (i < 25 || lane < 48) { \
                const f32x4 z = ubf4(ZZ[ii]); const f32x4 zn = ubf4(ZN[ii]); const f32x4 zs = z + (zn - z) * MU[ii]; \
                if (i < 8) { const int h = c >> 6, e = c & 63; *(u32x2*)(SS + ((size_t)(row * 32 + h) * 2) * 64 + e) = pk4(zs); } \
                else if (i < 16) { const int ch = c - 2048, h = ch >> 6, e = ch & 63; *(u32x2*)(KT + (size_t)row * RWW + ch) = pk4(zs); \
                    const f32x4 kr = zs * *(const f32x4*)(k_k + ch); const float ss = sum16(dot4(kr, kr)); const float inv = 1.f / fmaxf(sqrtf(ss), 1e-12f); \
                    *(u32x2*)(SS + ((size_t)(row * 32 + h) * 2 + 1) * 64 + e) = pk4(kr * inv); } \
                else if (i < 24) { *(u32x2*)(VV + (size_t)row * RWW + (c - 4096)) = pk4(zs); } \
                else if (i == 24) { \
                    if (lane < 24) { f32x4 t; _Pragma("unroll") for (int j = 0; j < 4; ++j) t[j] = 1.f - 2.f * __builtin_amdgcn_rcpf(1.f + __builtin_amdgcn_exp2f(2.885390081777927f * zs[j])); \
                        *(u32x2*)(LWA + (size_t)row * 512 + 4 * lane) = pk4(t); } \
                    else if (lane < 48) { *(u32x2*)(LWA + (size_t)row * 512 + 96 + 4 * (lane - 24)) = pk4(zs); } \
                    else { f32x4 t; _Pragma("unroll") for (int j = 0; j < 4; ++j) t[j] = sigm(zs[j]); \
                        *(u32x2*)(LWA + (size_t)row * 512 + 256 + 4 * (lane - 48)) = pk4(t); } \
                } else { f32x4 t; _Pragma("unroll") for (int j = 0; j < 4; ++j) t[j] = sigm(zs[j]); \
                    *(u32x2*)(LWA + (size_t)row * 512 + 256 + 64 + 4 * lane) = pk4(t); } \
              } } } while (0)
        u32x2 zzA[8], znA[8], zzB[8], znB[8]; f32x4 muA[8], muB[8]; f32x4 lq[4], lk[2];
        SEG_LOAD(0, zzA, znA, muA);
        SEG_LOAD(1, zzB, znB, muB); SEG_PROC(0, zzA, znA, muA);
        SEG_LOAD(2, zzA, znA, muA); SEG_PROC(1, zzB, znB, muB);
        SEG_LOAD(3, zzB, znB, muB); SEG_PROC(2, zzA, znA, muA);
#pragma unroll
        for (int j = 0; j < 4; ++j) lq[j] = ubf4(*(const u32x2*)(zr + RWCOLS + 4 * (lane + 64 * j)));
#pragma unroll
        for (int j = 0; j < 2; ++j) lk[j] = ubf4(*(const u32x2*)(zr + RWCOLS + 1024 + 4 * (lane + 64 * j)));
        SEG_PROC(3, zzB, znB, muB);
#undef SEG_LOAD
#undef SEG_PROC
        if (lane < 16) { unsigned z0 = 0u; asm volatile("" : "+v"(z0)); u32x2 zz; zz.x = z0; zz.y = z0; *(u32x2*)(LWA + (size_t)row * 512 + 192 + 4 * lane) = zz; }
        { f32x4 v[4]; float ss = 0.f;
#pragma unroll
          for (int j = 0; j < 4; ++j) { v[j] = lq[j]; ss += dot4(v[j], v[j]); }
          const float rstd = 1.0f / sqrtf(wave_sum(ss) * (1.f / 1024.f) + 1e-6f);
#pragma unroll
          for (int j = 0; j < 4; ++j) { const int c = 4 * (lane + 64 * j); *(u32x2*)(QL + (size_t)row * 1024 + c) = pk4(v[j] * rstd * *(const f32x4*)(qn + c)); } }
        { f32x4 v[2]; float ss = 0.f;
#pragma unroll
          for (int j = 0; j < 2; ++j) { v[j] = lk[j]; ss += dot4(v[j], v[j]); }
          const float rstd = 1.0f / sqrtf(wave_sum(ss) * (1.f / 512.f) + 1e-6f);
#pragma unroll
          for (int j = 0; j < 2; ++j) { const int c = 4 * (lane + 64 * j); *(u32x2*)(KVL + (size_t)row * 512 + c) = pk4(v[j] * rstd * *(const f32x4*)(kvn + c)); } }
    }
}

#ifndef QKN_ST
#define QKN_ST 1
#endif
#ifndef QKN_VST
#define QKN_VST 1
#endif
__device__ __forceinline__ void qknorm_phase(const Ptrs& P, int l, int gw, int NGW) {
    const int lane = lane_vol();
    unsigned char* ws = P.ws;
    const bf16* Z = (const bf16*)(ws + WS_Z); const bf16* QF = (const bf16*)(ws + WS_QF); const bf16* KVF = (const bf16*)(ws + WS_KVF);
    bf16* QB = (bf16*)(ws + WS_QB); bf16* KB = (bf16*)(ws + WS_KB); bf16* VB = (bf16*)(ws + WS_VB);
    const float* qg = P.in[I_QGAIN] + l * 192; const float* kg = P.in[I_KGAIN] + l * 192;
    const int lc = lane < 48 ? lane : 47, l32 = lane < 32 ? lane : 31;
    const f32x4 qg4 = *(const f32x4*)(qg + 4 * lc), kg4 = *(const f32x4*)(kg + 4 * lc);
    const int rl = lane - 32, ax = (rl >> 3) & 1, hf = (rl >> 2) & 1, f0 = 4 * (lane & 3);
    const bool rot = lane >= 32 && lane < 48;
    f32x4 invf;
#pragma unroll
    for (int j = 0; j < 4; ++j) invf[j] = exp2f(-(float)(f0 + j) * (13.287712379549449f / 16.f)) * 0.15915494309189535f;
    u32x2 nq_[4], nk_[4], nv_[4], nkr_;
#define QKN_LOAD(itx) do { const int row_ = (itx) >> 2, hq_ = ((itx) & 3) * 4; nkr_ = *(const u32x2*)(Z + (size_t)row_ * ZC + 8128 + 4 * (rot ? rl : 0)); \
        _Pragma("unroll") for (int hh = 0; hh < 4; ++hh) { const int h = hq_ + hh; nq_[hh] = *(const u32x2*)(QF + (size_t)row_ * 3072 + h * 192 + 4 * lc); \
            nk_[hh] = *(const u32x2*)(KVF + (size_t)row_ * 4096 + h * 256 + 4 * l32); nv_[hh] = *(const u32x2*)(KVF + (size_t)row_ * 4096 + h * 256 + 128 + 4 * l32); } } while (0)
    QKN_LOAD(gw < MROWS * 4 ? gw : 0);
    for (int it = gw; it < MROWS * 4; it += NGW) {
        const int row = it >> 2, h0 = (it & 3) * 4; const bool lat = row < SEQ;
        f32x4 cs = {1.f, 1.f, 1.f, 1.f}, sn = {0.f, 0.f, 0.f, 0.f};
        if (lat && rot) { const float pos = (float)(ax == 0 ? (row >> 6) : (row & 63));
#pragma unroll
            for (int j = 0; j < 4; ++j) { const float rev = pos * invf[j]; const float fr = rev - floorf(rev); cs[j] = __builtin_amdgcn_cosf(fr); sn[j] = __builtin_amdgcn_sinf(fr); } }
        u32x2 krr = nkr_; if (!rot) { krr.x = 0u; krr.y = 0u; }
        const f32x4 kr4 = ubf4(krr);
        const float ssr = wave_sum(rot ? dot4(kr4, kr4) : 0.f);
        u32x2 qq_[4], kq_[4], vv_[4];
#pragma unroll
        for (int hh = 0; hh < 4; ++hh) { qq_[hh] = nq_[hh]; kq_[hh] = nk_[hh]; vv_[hh] = nv_[hh]; }
        QKN_LOAD(it + NGW < MROWS * 4 ? it + NGW : it);
#pragma unroll
        for (int hh = 0; hh < 4; ++hh) {
            const int h = h0 + hh;
            u32x2 qq = qq_[hh]; if (lane >= 48) { qq.x = 0u; qq.y = 0u; }
            const f32x4 q4 = ubf4(qq);
            { const float ss = wave_sum(dot4(q4, q4)); const float rstd = 1.0f / sqrtf(ss * (1.f / 192.f) + 1e-6f);
              f32x4 x = q4 * rstd * qg4; f32x4 o;
#pragma unroll
              for (int j = 0; j < 4; ++j) o[j] = __shfl_xor(x[j], 4);
              if (lat && rot) { if (hf == 0) x = x * cs - o * sn; else x = o * sn + x * cs; }
              if (QKN_ST && lane < 48) *(u32x2*)(QB + (size_t)row * 3072 + h * 192 + 4 * lane) = pk4(x); }
            const u32x2 kq2 = kq_[hh];
            const f32x4 k4 = (lane < 32) ? ubf4(kq2) : kr4;
            { const float ss = wave_sum(lane < 32 ? dot4(k4, k4) : 0.f) + ssr; const float rstd = 1.0f / sqrtf(ss * (1.f / 192.f) + 1e-6f);
              f32x4 x = k4 * rstd * kg4; f32x4 o;
#pragma unroll
              for (int j = 0; j < 4; ++j) o[j] = __shfl_xor(x[j], 4);
              if (lat && rot) { if (hf == 0) x = x * cs - o * sn; else x = o * sn + x * cs; }
              if (QKN_ST && lane < 48) *(u32x2*)(KB + (size_t)row * 3072 + h * 192 + 4 * lane) = pk4(x); }
            { const u32x2 vv2 = vv_[hh]; if (QKN_VST && lane < 32) *(u32x2*)(VB + (size_t)row * 2048 + h * 128 + 4 * lane) = vv2; }
        }
    }
}

#undef QKN_LOAD
__device__ __forceinline__ void rwkvout_phase(const Ptrs& P, int l, int row0, int nrows, int gw, int NGW) {
    int lane = lane_vol();
    unsigned char* ws = P.ws;
    const float* Y = (const float*)(ws + WS_Y); const bf16* SS = (const bf16*)(ws + WS_SS); const bf16* LW = (const bf16*)(ws + WS_LW); const bf16* VV = (const bf16*)(ws + WS_VV);
    const bf16* KT = (const bf16*)(ws + WS_KT); bf16* OC = (bf16*)(ws + WS_OC);
    const float* lnw = P.in[I_LNW] + l * RWW; const float* lnb = P.in[I_LNB] + l * RWW; const float* rk = P.in[I_RK] + l * RWW;
    const float* a0 = P.in[I_A0] + (size_t)l * 2 * RWW; const float* k_a = P.in[I_KA] + (size_t)l * RWW;
    for (int row = row0 + gw; row < nrows; row += NGW) {
        asm volatile("" : "+v"(lane));
#define RO_LOAD(hb, YA, YB, R, A0, A1, KTv, VVv, Gv) do { _Pragma("unroll") for (int ii = 0; ii < 4; ++ii) { const int c = 4 * (lane + 64 * (4 * (hb) + ii)), h = c >> 6, e = c & 63; \
                YA[ii] = *(const f32x4*)(Y + (size_t)row * RWW + c); YB[ii] = *(const f32x4*)(Y + (size_t)(MROWS + row) * RWW + c); \
                R[ii] = *(const u32x2*)(SS + ((size_t)(row * 32 + h) * 2) * 64 + e); \
                A0[ii] = *(const u32x2*)(LW + (size_t)row * 10240 + 4096 + c); A1[ii] = *(const u32x2*)(LW + (size_t)row * 10240 + 6144 + c); \
                KTv[ii] = *(const u32x2*)(KT + (size_t)row * RWW + c); VVv[ii] = *(const u32x2*)(VV + (size_t)row * RWW + c); Gv[ii] = *(const u32x2*)(LW + (size_t)row * 10240 + 8192 + c); } } while (0)
#define RO_PROC(hb, YA, YB, R, A0, A1, KTv, VVv, Gv) do { _Pragma("unroll") for (int ii = 0; ii < 4; ++ii) { const int c = 4 * (lane + 64 * (4 * (hb) + ii)); \
                const f32x4 y = YA[ii] + YB[ii]; \
                const float mean = sum16((y.x + y.y) + (y.z + y.w)) * (1.f / 64.f); \
                const f32x4 dlt = y - mean; const float var = sum16(dot4(dlt, dlt)) * (1.f / 64.f); \
                const float rstd = 1.0f / sqrtf(var + 64e-5f); \
                f32x4 o = dlt * rstd * *(const f32x4*)(lnw + c) + *(const f32x4*)(lnb + c); \
                const f32x4 r4 = ubf4(R[ii]); \
                  \
                const f32x4 al0 = ubf4(A0[ii]) + *(const f32x4*)(a0 + c), al1 = ubf4(A1[ii]) + *(const f32x4*)(a0 + RWW + c); \
                f32x4 am; _Pragma("unroll") for (int j = 0; j < 4; ++j) am[j] = 0.5f * (sigm(al0[j]) + sigm(al1[j])); \
                const f32x4 kdm = ubf4(KTv[ii]) * (1.f + (am - 1.f) * *(const f32x4*)(k_a + c)); \
                const float bs = sum16(dot4(r4 * kdm, *(const f32x4*)(rk + c))); \
                o = (o + ubf4(VVv[ii]) * bs) * ubf4(Gv[ii]); \
                *(u32x2*)(OC + (size_t)row * DM + c) = pk4(o); } } while (0)
        f32x4 yaA[4], ybA[4], yaB[4], ybB[4]; u32x2 rA[4], a0A[4], a1A[4], ktA[4], vvA[4], gA[4], rB[4], a0B[4], a1B[4], ktB[4], vvB[4], gB[4];
        RO_LOAD(0, yaA, ybA, rA, a0A, a1A, ktA, vvA, gA);
        RO_LOAD(1, yaB, ybB, rB, a0B, a1B, ktB, vvB, gB);
        RO_PROC(0, yaA, ybA, rA, a0A, a1A, ktA, vvA, gA);
        RO_PROC(1, yaB, ybB, rB, a0B, a1B, ktB, vvB, gB);
#undef RO_LOAD
#undef RO_PROC
    }
}

constexpr int BGQ_FI = 512 * 256, BGQ_FO = 1024 * 64, BGQ_IN = 512 * 128, BGQ_OUT = 512 * 64, BGQ_Q = 128 * 48, BGQ_KV = 64 * 64;
constexpr int BGQ_TOTAL = 2 * BGQ_FI + 2 * BGQ_FO + BGQ_IN + BGQ_OUT + BGQ_Q + BGQ_KV;
constexpr int BGQ_PER_WAVE = BGQ_TOTAL / 512;
static_assert(BGQ_PER_WAVE * 512 == BGQ_TOTAL && BGQ_PER_WAVE % 4 == 0 && BGQ_PER_WAVE / 4 <= MROWS / 32, "background quanta per loader wave");
struct BgQ { const float* src; bf16* dst; int N; };
__device__ __forceinline__ BgQ bg_decode(const Ptrs& P, int t, int lane) {
    unsigned char* ws = P.ws; const float* W; bf16* WT; int K, N, map = 0; constexpr int l = 1;
    if (t < 2 * BGQ_FI) { const int f = t / BGQ_FI; t -= f * BGQ_FI; W = P.in[I_FWI] + (size_t)(l * 2 + f) * DM * 16384; WT = (bf16*)(ws + WS_WFI + (size_t)(l * 2 + f) * SZ_WFI); K = DM; N = 16384; map = 1; }
    else if ((t -= 2 * BGQ_FI) < 2 * BGQ_FO) { const int f = t / BGQ_FO; t -= f * BGQ_FO; W = P.in[I_FWO] + (size_t)(l * 2 + f) * DFF * DM; WT = (bf16*)(ws + WS_WFO + (size_t)(l * 2 + f) * SZ_WFO); K = DFF; N = DM; }
    else if ((t -= 2 * BGQ_FO) < BGQ_IN) { W = P.in[I_WIN] + (size_t)l * DM * ZC; WT = (bf16*)(ws + WS_WIN + (size_t)l * SZ_WIN); K = DM; N = ZC; }
    else if ((t -= BGQ_IN) < BGQ_OUT) { W = P.in[I_WOUT] + (size_t)l * DM * DM; WT = (bf16*)(ws + WS_WOUT + (size_t)l * SZ_WOUT); K = DM; N = DM; }
    else if ((t -= BGQ_OUT) < BGQ_Q) { W = P.in[I_QUP] + (size_t)l * 1024 * 3072; WT = (bf16*)(ws + WS_WQ + (size_t)l * SZ_WQ); K = 1024; N = 3072; }
    else { t -= BGQ_Q; W = P.in[I_KVUP] + (size_t)l * 512 * 4096; WT = (bf16*)(ws + WS_WKV + (size_t)l * SZ_WKV); K = 512; N = 4096; }
    const int nk8 = K >> 3, nq = t / nk8, kq = t - nq * nk8, n = 64 * nq + lane;
    const int row = map ? map_row<1>(n) : n;
    BgQ q; q.src = W + (size_t)(8 * kq) * N + n; q.dst = WT + (size_t)row * K + 8 * kq; q.N = N; return q;
}

template <int CTRL> __device__ __forceinline__ float dpp_add(float x) { return x + __int_as_float(__builtin_amdgcn_update_dpp(0, __float_as_int(x), CTRL, 0xf, 0xf, true)); }
__device__ __forceinline__ float red16(float x) { x = dpp_add<0xB1>(x); x = dpp_add<0x4E>(x); x = dpp_add<0x141>(x); x = dpp_add<0x140>(x); return x; }
constexpr int SCAN_TC = 32, SCAN_STEP_B = 1424, SCAN_BUF = SCAN_TC * SCAN_STEP_B;
__device__ __forceinline__ void scan_phase(const Ptrs& P, int l, LAS unsigned char* lds, int vcu, int wave) {
    const int lane = lane_vol();
    if (vcu >= 128) return;
    const int h = vcu >> 2, d = (vcu >> 1) & 1, half = vcu & 1;
    unsigned char* ws = P.ws;
    const bf16* LW = (const bf16*)(ws + WS_LW); const bf16* SS = (const bf16*)(ws + WS_SS); const bf16* VV = (const bf16*)(ws + WS_VV); const bf16* KT = (const bf16*)(ws + WS_KT); float* Y = (float*)(ws + WS_Y);
    LAS float* ybuf = (LAS float*)(lds + 2 * SCAN_BUF);
    constexpr int NCH = MROWS / SCAN_TC;
    typedef float f32x2s __attribute__((ext_vector_type(2)));
#define rowof(tau) (d == 0 ? ((tau) < CTXL ? SEQ + (tau) : (tau) - CTXL) : (MROWS - 1 - (tau)))
    if (wave >= 4) {
        const int tl = (wave - 4) * 64 + lane;
        const int le = 4 * (tl & 15);
        const float* cw = P.in[I_W0] + (size_t)(l * 2 + d) * RWW + h * 64 + le; const float* ca = P.in[I_A0] + (size_t)(l * 2 + d) * RWW + h * 64 + le; const float* ck = P.in[I_KA] + (size_t)l * RWW + h * 64 + le;
        const f32x4 bw = *(const f32x4*)cw, ba = *(const f32x4*)ca, ka = *(const f32x4*)ck;
        u32x2 sr[2][5]; u32x2 svr;
#define LD_CHUNK(ci) do { _Pragma("unroll") for (int j_ = 0; j_ < 2; ++j_) { const int ls_ = (tl >> 4) + 16 * j_; const int row_ = rowof((ci) * SCAN_TC + ls_); const bf16* lw_ = LW + (size_t)row_ * 10240 + d * RWW + h * 64 + le; \
            sr[j_][0] = *(const u32x2*)(lw_); sr[j_][1] = *(const u32x2*)(lw_ + 4096); sr[j_][2] = *(const u32x2*)(KT + (size_t)row_ * RWW + h * 64 + le); \
            sr[j_][3] = *(const u32x2*)(SS + ((size_t)(row_ * 32 + h) * 2 + 1) * 64 + le); sr[j_][4] = *(const u32x2*)(SS + ((size_t)(row_ * 32 + h) * 2) * 64 + le); } \
          { const int row2_ = rowof((ci) * SCAN_TC + (tl >> 3)); svr = *(const u32x2*)(VV + (size_t)row2_ * RWW + h * 64 + 32 * half + 4 * (tl & 7)); } } while (0)
#define ST_CHUNK(b) do { _Pragma("unroll") for (int j_ = 0; j_ < 2; ++j_) { const int ls_ = (tl >> 4) + 16 * j_; LAS unsigned char* rec_ = lds + (b) * SCAN_BUF + ls_ * SCAN_STEP_B + le * 4; f32x4 w_, kd_, kka_; \
            f32x4 st[5]; _Pragma("unroll") for (int v_ = 0; v_ < 5; ++v_) st[v_] = ubf4(sr[j_][v_]); \
            _Pragma("unroll") for (int q_ = 0; q_ < 4; ++q_) { w_[q_] = __builtin_amdgcn_exp2f(-0.60653065971263342f * 1.4426950408889634f * sigm(st[0][q_] + bw[q_])); \
                const float a_ = sigm(st[1][q_] + ba[q_]); kd_[q_] = st[2][q_] * (1.f + (a_ - 1.f) * ka[q_]); kka_[q_] = st[3][q_] * a_; } \
            const float c1_ = red16(dot4(kka_, st[4])), c2_ = red16(dot4(kd_, st[4])); \
            *(LAS f32x4*)(rec_) = w_; *(LAS f32x4*)(rec_ + 256) = kd_; *(LAS f32x4*)(rec_ + 512) = kka_; *(LAS f32x4*)(rec_ + 768) = w_ * st[4]; *(LAS f32x4*)(rec_ + 1024) = st[3]; \
            if ((tl & 15) == 0) *(LAS f32x2s*)(lds + (b) * SCAN_BUF + ls_ * SCAN_STEP_B + 1408) = (f32x2s){c1_, c2_}; } \
          *(LAS f32x4*)(lds + (b) * SCAN_BUF + (tl >> 3) * SCAN_STEP_B + 1280 + 16 * (tl & 7)) = ubf4(svr); } while (0)
#define Y_OUT(ci) do { const int s_ = tl >> 3, j_ = tl & 7; const int row_ = rowof((ci) * SCAN_TC + s_); \
            *(f32x4*)(Y + (size_t)(d * MROWS + row_) * RWW + h * 64 + 32 * half + 4 * j_) = *(const LAS f32x4*)(ybuf + ((ci) & 1) * 1024 + s_ * 32 + 4 * j_); } while (0)
        const bool bg_on = BG_CONV && (l == 0);
        const int bq0 = (vcu * 4 + (wave - 4)) * BGQ_PER_WAVE;
        float bgr[4][8]; bf16* bg_dst = nullptr;
#define BG_ISSUE(g) do { if (bg_on && (g) < BGQ_PER_WAVE / 4) { const BgQ b_ = bg_decode(P, bq0 + 4 * (g), lane); bg_dst = b_.dst; \
            _Pragma("unroll") for (int q_ = 0; q_ < 4; ++q_) _Pragma("unroll") for (int j_ = 0; j_ < 8; ++j_) bgr[q_][j_] = b_.src[(size_t)(8 * q_ + j_) * b_.N]; } } while (0)
#define BG_FLUSH(g) do { if (bg_on && (g) >= 0 && (g) < BGQ_PER_WAVE / 4) { _Pragma("unroll") for (int q_ = 0; q_ < 4; ++q_) { \
            v4u o_; o_.x = pg8::cvt_pk_bf16(bgr[q_][0], bgr[q_][1]); o_.y = pg8::cvt_pk_bf16(bgr[q_][2], bgr[q_][3]); o_.z = pg8::cvt_pk_bf16(bgr[q_][4], bgr[q_][5]); o_.w = pg8::cvt_pk_bf16(bgr[q_][6], bgr[q_][7]); \
            *(v4u*)(bg_dst + 8 * q_) = o_; } } } while (0)
        const int gv_lw = vcu * 4 + (wave - 4);
        f32x4 gvr[8]; f32x4 gva0 = {0.f, 0.f, 0.f, 0.f}, gva1 = {0.f, 0.f, 0.f, 0.f};
#define GV_ISSUE(g) do { if (bg_on && (g) < 144) { const int u_ = gv_lw + 512 * ((g) >> 4), nch_ = u_ >> 5, ks_ = u_ & 31; \
            const float* w_ = P.in[I_WMOD] + (size_t)DM * NMODC + (size_t)(128 * ks_ + 8 * ((g) & 15)) * NMODC + 256 * nch_ + 4 * lane; \
            _Pragma("unroll") for (int j_ = 0; j_ < 8; ++j_) gvr[j_] = *(const f32x4*)(w_ + (size_t)j_ * NMODC); } } while (0)
#define GV_ACC(g) do { if (bg_on && (g) >= 0 && (g) < 144) { const int u_ = gv_lw + 512 * ((g) >> 4), nch_ = u_ >> 5, ks_ = u_ & 31; const int k0_ = 128 * ks_ + 8 * ((g) & 15); \
            _Pragma("unroll") for (int j_ = 0; j_ < 8; ++j_) { const float a_ = P.in[I_C][k0_ + j_], b_ = P.in[I_CCTX][k0_ + j_]; gva0 += gvr[j_] * (a_ * sigm(a_)); gva1 += gvr[j_] * (b_ * sigm(b_)); } \
            if (((g) & 15) == 15) { float* mo_ = (float*)(ws + WS_MOD) + (size_t)2 * NMODC + 256 * nch_ + 4 * lane; \
                if (ks_ == 0) { const f32x4 bb_ = *(const f32x4*)(P.in[I_BMOD] + NMODC + 256 * nch_ + 4 * lane); gva0 += bb_; gva1 += bb_; } \
                _Pragma("unroll") for (int j_ = 0; j_ < 4; ++j_) { atomicAdd(mo_ + j_, gva0[j_]); atomicAdd(mo_ + NMODC + j_, gva1[j_]); } \
                gva0 = (f32x4){0.f, 0.f, 0.f, 0.f}; gva1 = (f32x4){0.f, 0.f, 0.f, 0.f}; } } } while (0)
        LD_CHUNK(0); ST_CHUNK(0); LD_CHUNK(1);
        __syncthreads();
        for (int ci = 0; ci < NCH; ++ci) {
            if (ci > 0) Y_OUT(ci - 1);
            if (ci + 1 < NCH) ST_CHUNK((ci + 1) & 1);
            BG_FLUSH(ci - 1); GV_ACC(ci - 1);
            if (ci + 2 < NCH) LD_CHUNK(ci + 2);
            BG_ISSUE(ci); GV_ISSUE(ci);
            __syncthreads();
        }
        Y_OUT(NCH - 1);
        BG_FLUSH(NCH - 1);
#undef GV_ISSUE
#undef GV_ACC
#undef BG_ISSUE
#undef BG_FLUSH
#undef LD_CHUNK
#undef ST_CHUNK
#undef Y_OUT
    } else {
        const int kc = lane & 7, rl = wave * 8 + (lane >> 3);
        f32x2s Sa = {0.f, 0.f}, Sb = {0.f, 0.f}, Sc = {0.f, 0.f}, Sd = {0.f, 0.f};
        __syncthreads();
        for (int ci = 0; ci < NCH; ++ci) {
            const LAS unsigned char* buf = lds + (ci & 1) * SCAN_BUF + kc * 32;
            const LAS unsigned char* vbuf = lds + (ci & 1) * SCAN_BUF + 1280 + rl * 4;
            const LAS unsigned char* cbase = lds + (ci & 1) * SCAN_BUF + 1408;
            float ys0 = 0.f, ys1 = 0.f, ys2 = 0.f, ys3 = 0.f;
#define LDV(dst0, dst1, off, sb_) dst0 = *(const LAS f32x4*)((sb_) + (off)); dst1 = *(const LAS f32x4*)((sb_) + (off) + 16)
            f32x4 w0, w1, d0, d1, a0, a1, r0, r1, k0, k1; float vv; f32x2s cc;
            LDV(w0, w1, 0, buf); LDV(d0, d1, 256, buf); LDV(a0, a1, 512, buf); LDV(r0, r1, 768, buf); LDV(k0, k1, 1024, buf); vv = *(const LAS float*)(vbuf); cc = *(const LAS f32x2s*)(cbase);
#pragma unroll
            for (int s = 0; s < SCAN_TC; ++s) {
                f32x4 w0n = w0, w1n = w1, d0n = d0, d1n = d1, a0n = a0, a1n = a1, r0n = r0, r1n = r1, k0n = k0, k1n = k1; float vvn = vv; f32x2s ccn = cc;
                if (s + 1 < SCAN_TC) { const LAS unsigned char* sb = buf + (s + 1) * SCAN_STEP_B;
                    LDV(w0n, w1n, 0, sb); LDV(d0n, d1n, 256, sb); LDV(a0n, a1n, 512, sb); LDV(r0n, r1n, 768, sb); LDV(k0n, k1n, 1024, sb);
                    vvn = *(const LAS float*)(vbuf + (s + 1) * SCAN_STEP_B); ccn = *(const LAS f32x2s*)(cbase + (s + 1) * SCAN_STEP_B); }
#define LO(v) ((f32x2s){(v).x, (v).y})
#define HI(v) ((f32x2s){(v).z, (v).w})
                const f32x2s pa = (Sa * LO(k0) + Sb * HI(k0)) + (Sc * LO(k1) + Sd * HI(k1)), pb = (Sa * LO(r0) + Sb * HI(r0)) + (Sc * LO(r1) + Sd * HI(r1));
                float p1 = pa.x + pa.y, p2 = pb.x + pb.y;
                p1 = dpp_add<0xB1>(p1); p2 = dpp_add<0xB1>(p2); p1 = dpp_add<0x4E>(p1); p2 = dpp_add<0x4E>(p2); p1 = dpp_add<0x141>(p1); p2 = dpp_add<0x141>(p2);
                const float sk = p1, yv = p2 - sk * cc.x + vv * cc.y;
                Sa = Sa * LO(w0) + (LO(d0) * vv - LO(a0) * sk); Sb = Sb * HI(w0) + (HI(d0) * vv - HI(a0) * sk);
                Sc = Sc * LO(w1) + (LO(d1) * vv - LO(a1) * sk); Sd = Sd * HI(w1) + (HI(d1) * vv - HI(a1) * sk);
                if ((s >> 3) == 0) ys0 = (kc == (s & 7)) ? yv : ys0; else if ((s >> 3) == 1) ys1 = (kc == (s & 7)) ? yv : ys1; else if ((s >> 3) == 2) ys2 = (kc == (s & 7)) ? yv : ys2; else ys3 = (kc == (s & 7)) ? yv : ys3;
                w0 = w0n; w1 = w1n; d0 = d0n; d1 = d1n; a0 = a0n; a1 = a1n; r0 = r0n; r1 = r1n; k0 = k0n; k1 = k1n; vv = vvn; cc = ccn;
#undef LO
#undef HI
            }
#undef LDV
            LAS float* yb = ybuf + (ci & 1) * 1024;
            yb[kc * 32 + rl] = ys0; yb[(kc + 8) * 32 + rl] = ys1; yb[(kc + 16) * 32 + rl] = ys2; yb[(kc + 24) * 32 + rl] = ys3;
            __syncthreads();
        }
    }
#undef rowof
}

namespace att {
constexpr int NW = 8, QBLK = 32, KVBLK = 64;
constexpr float SCALE = 0.07216878364870322f;
constexpr float THR = 8.f;
constexpr int LDQ = 3072, LDKK = 3072, LDVV = 2048, LDO = 4096;
constexpr int SHM_V = KVBLK * 128 * 2, SHM_K = KVBLK * 400, SHM_QP = 256 * 208, SHM_ATTN = 2 * SHM_V + 2 * SHM_K + NW * 64 * 4 + SHM_QP;
using bf16x8 = __attribute__((ext_vector_type(8))) short;
using s16x4  = __attribute__((ext_vector_type(4))) short;
using f32x16 = __attribute__((ext_vector_type(16))) float;
using u32x4  = __attribute__((ext_vector_type(4))) unsigned;
#define KSWZ(row, colB) ((row) * 400 + (colB))
#define SBAR() __builtin_amdgcn_sched_barrier(0)
__device__ __forceinline__ int crow(int r, int hi) { return (r & 3) + 8 * (r >> 2) + 4 * hi; }
__device__ __forceinline__ unsigned cvtpk(float lo, float hi) { unsigned r; asm volatile("s_nop 0\n\tv_cvt_pk_bf16_f32 %0, %1, %2" : "=v"(r) : "v"(lo), "v"(hi)); return r; }
__device__ __forceinline__ void partialSM(f32x16& p0, f32x16& p1, float& m_reg, float& mn, float& alpha) {
  constexpr float C = SCALE * 1.4426950408889634f;
  float pmax = p0[0];
#pragma unroll
  for (int r = 1; r < 16; ++r) pmax = fmaxf(pmax, p0[r]);
#pragma unroll
  for (int r = 0; r < 16; ++r) pmax = fmaxf(pmax, p1[r]);
  { auto rr = __builtin_amdgcn_permlane32_swap(__float_as_uint(pmax), __float_as_uint(pmax), false, false);
    pmax = fmaxf(__uint_as_float(rr[0]), __uint_as_float(rr[1])); }
  if (__builtin_expect(__all(pmax - m_reg <= THR / SCALE), 1)) { mn = m_reg; alpha = 1.f; }
  else { mn = fmaxf(m_reg, pmax); alpha = __builtin_amdgcn_exp2f((m_reg - mn) * C); m_reg = mn; }
  float mnC = -mn * C;
#pragma unroll
  for (int r = 0; r < 16; ++r) p0[r] = fmaf(p0[r], C, mnC);
#pragma unroll
  for (int r = 0; r < 16; ++r) p1[r] = fmaf(p1[r], C, mnC);
#pragma unroll
  for (int r = 0; r < 16; ++r) p0[r] = __builtin_amdgcn_exp2f(p0[r]);
}
__device__ __forceinline__ void finishSM(f32x16& p0, f32x16& p1, float alpha, float& l_reg, bf16x8& pa0, bf16x8& pa1, bf16x8& pa2, bf16x8& pa3) {
#pragma unroll
  for (int r = 0; r < 16; ++r) p1[r] = __builtin_amdgcn_exp2f(p1[r]);
  float ps = 0;
#pragma unroll
  for (int r = 0; r < 16; ++r) ps += p0[r];
#pragma unroll
  for (int r = 0; r < 16; ++r) ps += p1[r];
  { auto rr = __builtin_amdgcn_permlane32_swap(__float_as_uint(ps), __float_as_uint(ps), false, false);
    ps = __uint_as_float(rr[0]) + __uint_as_float(rr[1]); }
  l_reg = l_reg * alpha + ps;
#define PK4(P, BASE, OUT) do { unsigned a0 = cvtpk(P[BASE + 0], P[BASE + 1]), a1 = cvtpk(P[BASE + 2], P[BASE + 3]);   \
    unsigned b0 = cvtpk(P[BASE + 4], P[BASE + 5]), b1 = cvtpk(P[BASE + 6], P[BASE + 7]);                              \
    auto r0 = __builtin_amdgcn_permlane32_swap(a0, b0, false, false); auto r1 = __builtin_amdgcn_permlane32_swap(a1, b1, false, false); \
    u32x4 w = {r0[0], r1[0], r0[1], r1[1]}; OUT = *reinterpret_cast<bf16x8*>(&w); } while (0)
  PK4(p0, 0, pa0); PK4(p0, 8, pa1); PK4(p1, 0, pa2); PK4(p1, 8, pa3);
#undef PK4
}
__device__ __forceinline__ void qkt(f32x16& p0, f32x16& p1, const char* Ks, const bf16x8* qr, const char* qpark, int r32, int hi) {
  p0 = f32x16{}; p1 = f32x16{};
#pragma unroll
  for (int d0 = 0; d0 < 12; ++d0) { int cb = (d0 * 16 + hi * 8) * 2;
    bf16x8 b0 = *reinterpret_cast<const bf16x8*>(Ks + KSWZ(r32, cb));
    bf16x8 b1 = *reinterpret_cast<const bf16x8*>(Ks + KSWZ(32 + r32, cb));
    const bf16x8 q = d0 < 6 ? qr[d0 < 6 ? d0 : 0] : *reinterpret_cast<const bf16x8*>(qpark + (d0 - 6) * 32);
    p0 = __builtin_amdgcn_mfma_f32_32x32x16_bf16(b0, q, p0, 0, 0, 0);
    p1 = __builtin_amdgcn_mfma_f32_32x32x16_bf16(b1, q, p1, 0, 0, 0); }
}
__device__ __forceinline__ int v_st(int k, int c) { const int kk = (k & ~0xC) | ((k & 4) << 1) | ((k & 8) >> 1); return ((kk >> 3) * 4 + (c >> 5)) * 512 + ((kk & 7) * 32 + (c & 31)) * 2; }
__device__ __forceinline__ int v_rd_base(int lane) { return ((lane & 3) << 3) | (((lane >> 2) & 3) << 6) | (((lane >> 4) & 1) << 5) | (((lane >> 5) & 1) << 8); }
constexpr int v_rd_off(int d0, int ks, int half) { return d0 * 512 + ks * 4096 + half * 2048; }
template <int OFF> __device__ __forceinline__ s16x4 tr_read(int vb) {
  s16x4 r; asm volatile("ds_read_b64_tr_b16 %0, %1 offset:%2" : "=&v"(r) : "v"(vb), "i"(OFF) : "memory"); return r;
}
template <int D0> __device__ __forceinline__ void pv_one(f32x16& od, int vb, bf16x8 pa0, bf16x8 pa1, bf16x8 pa2, bf16x8 pa3) {
  const s16x4 l0 = tr_read<v_rd_off(D0, 0, 0)>(vb), h0 = tr_read<v_rd_off(D0, 0, 1)>(vb), l1 = tr_read<v_rd_off(D0, 1, 0)>(vb), h1 = tr_read<v_rd_off(D0, 1, 1)>(vb);
  const s16x4 l2 = tr_read<v_rd_off(D0, 2, 0)>(vb), h2 = tr_read<v_rd_off(D0, 2, 1)>(vb), l3 = tr_read<v_rd_off(D0, 3, 0)>(vb), h3 = tr_read<v_rd_off(D0, 3, 1)>(vb);
  asm volatile("s_waitcnt lgkmcnt(0)" ::: "memory"); SBAR();
#define PK(L, H) (bf16x8){L[0], L[1], L[2], L[3], H[0], H[1], H[2], H[3]}
  od = __builtin_amdgcn_mfma_f32_32x32x16_bf16(pa0, PK(l0, h0), od, 0, 0, 0);
  od = __builtin_amdgcn_mfma_f32_32x32x16_bf16(pa1, PK(l1, h1), od, 0, 0, 0);
  od = __builtin_amdgcn_mfma_f32_32x32x16_bf16(pa2, PK(l2, h2), od, 0, 0, 0);
  od = __builtin_amdgcn_mfma_f32_32x32x16_bf16(pa3, PK(l3, h3), od, 0, 0, 0);
#undef PK
}
__device__ __forceinline__ void pv_d0(f32x16* o, int vb, bf16x8 pa0, bf16x8 pa1, bf16x8 pa2, bf16x8 pa3) {
  pv_one<0>(o[0], vb, pa0, pa1, pa2, pa3); pv_one<1>(o[1], vb, pa0, pa1, pa2, pa3); pv_one<2>(o[2], vb, pa0, pa1, pa2, pa3); pv_one<3>(o[3], vb, pa0, pa1, pa2, pa3);
}
__device__ __forceinline__ void attn_body(const unsigned short* __restrict__ Qb, const unsigned short* __restrict__ Kh, const unsigned short* __restrict__ Vh,
                                          unsigned short* __restrict__ Ob, int seq, char* lds, int wave_in) {
  int tid_o; asm volatile("v_mbcnt_lo_u32_b32 %0, -1, 0\n\tv_mbcnt_hi_u32_b32 %0, -1, %0" : "=v"(tid_o)); tid_o += wave_in * 64;
  const int tid = tid_o, wid = wave_in, lane = tid & 63, r32 = lane & 31, hi = lane >> 5;
  char* V_lds = lds; char* K_lds = lds + 2 * SHM_V;
  float* wsx = (float*)(lds + 2 * SHM_V + 2 * SHM_K) + wid * 64; float* li_l = wsx; float* al_l = wsx + 32;
  float m_reg = -1e30f, l_reg = 0; f32x16 o[4] = {}; bf16x8 qr[6];
  char* qpark = lds + 2 * SHM_V + 2 * SHM_K + NW * 64 * 4 + (wid * QBLK + r32) * 208 + hi * 16;
  const unsigned short* Qw = Qb + (long)(wid * QBLK + r32) * LDQ + hi * 8;
#pragma unroll
  for (int d0 = 0; d0 < 6; ++d0) qr[d0] = *reinterpret_cast<const bf16x8*>(Qw + d0 * 16);
#pragma unroll
  for (int d0 = 6; d0 < 12; ++d0) *reinterpret_cast<bf16x8*>(qpark + (d0 - 6) * 32) = *reinterpret_cast<const bf16x8*>(Qw + d0 * 16);
  const int sr = tid >> 4, sc = (tid & 15) * 8, vst0 = v_st(sr, sc), vst1 = v_st(32 + sr, sc);
  const int kr0 = tid / 24, kc0 = (tid % 24) * 8, kr1 = (tid + 512) / 24, kc1 = ((tid + 512) % 24) * 8, kr2 = (tid + 1024) / 24, kc2 = ((tid + 1024) % 24) * 8;
  const int vb0 = (int)(uintptr_t)V_lds + v_rd_base(lane);
  const unsigned ko0 = (unsigned)(kr0 * LDKK + kc0) * 2u, ko1 = (unsigned)(kr1 * LDKK + kc1) * 2u, ko2 = (unsigned)(kr2 * LDKK + kc2) * 2u;
  const unsigned vo0 = (unsigned)(sr * LDVV + sc) * 2u, vo1 = (unsigned)((32 + sr) * LDVV + sc) * 2u;
  const int kl0 = KSWZ(kr0, kc0 * 2), kl1 = KSWZ(kr1, kc1 * 2), kl2 = KSWZ(kr2, kc2 * 2);
  bf16x8 vs0, vs1, ks0, ks1, ks2;
#define SLOAD(k0) do { const char* kb_ = (const char*)Kh + (size_t)(k0) * (LDKK * 2); const char* vb_ = (const char*)Vh + (size_t)(k0) * (LDVV * 2); \
    vs0 = *reinterpret_cast<const bf16x8*>(vb_ + vo0); vs1 = *reinterpret_cast<const bf16x8*>(vb_ + vo1); \
    ks0 = *reinterpret_cast<const bf16x8*>(kb_ + ko0); ks1 = *reinterpret_cast<const bf16x8*>(kb_ + ko1); ks2 = *reinterpret_cast<const bf16x8*>(kb_ + ko2); } while (0)
#define SWRITE(b) do { *(bf16x8*)(V_lds + (b) * SHM_V + vst0) = vs0; *(bf16x8*)(V_lds + (b) * SHM_V + vst1) = vs1; \
    *(bf16x8*)(K_lds + (b) * SHM_K + kl0) = ks0; *(bf16x8*)(K_lds + (b) * SHM_K + kl1) = ks1; *(bf16x8*)(K_lds + (b) * SHM_K + kl2) = ks2; } while (0)
#define SWAIT() asm volatile("s_waitcnt vmcnt(0)" ::: "memory")
#define RESC(a) do { if (__any((a) < 1.f)) { if (hi == 0) al_l[r32] = (a); asm volatile("s_waitcnt lgkmcnt(0)" ::: "memory"); \
    _Pragma("unroll") for (int d = 0; d < 4; ++d) _Pragma("unroll") for (int r = 0; r < 16; ++r) o[d][r] *= al_l[crow(r, hi)]; } } while (0)
  f32x16 pA0, pA1, pB0, pB1; float mnA, mnB, alA, alB; bf16x8 pa0, pa1, pa2, pa3; const int NT = seq / KVBLK;
  __syncthreads();
  SLOAD(0); SWAIT(); SWRITE(0); __syncthreads();
  qkt(pA0, pA1, K_lds, qr, qpark, r32, hi); partialSM(pA0, pA1, m_reg, mnA, alA);
  SLOAD(KVBLK);
  SWAIT(); SWRITE(1); __syncthreads();
  for (int j = 1; j + 1 < NT; j += 2) {
    SBAR(); qkt(pB0, pB1, K_lds + SHM_K, qr, qpark, r32, hi);
    finishSM(pA0, pA1, alA, l_reg, pa0, pa1, pa2, pa3); SBAR();
    SLOAD((j + 1) * KVBLK); SBAR();
    pv_d0(o, vb0, pa0, pa1, pa2, pa3); partialSM(pB0, pB1, m_reg, mnB, alB);
    __syncthreads(); SWAIT(); SWRITE(0);
    RESC(alB); __syncthreads();
    SBAR(); qkt(pA0, pA1, K_lds, qr, qpark, r32, hi);
    finishSM(pB0, pB1, alB, l_reg, pa0, pa1, pa2, pa3); SBAR();
    SLOAD((j + 2) * KVBLK); SBAR();
    pv_d0(o, vb0 + SHM_V, pa0, pa1, pa2, pa3); partialSM(pA0, pA1, m_reg, mnA, alA);
    __syncthreads(); SWAIT(); SWRITE(1);
    RESC(alA); __syncthreads();
  }
  SBAR(); qkt(pB0, pB1, K_lds + SHM_K, qr, qpark, r32, hi);
  finishSM(pA0, pA1, alA, l_reg, pa0, pa1, pa2, pa3); SBAR();
  pv_d0(o, vb0, pa0, pa1, pa2, pa3); partialSM(pB0, pB1, m_reg, mnB, alB);
  __syncthreads(); RESC(alB);
  finishSM(pB0, pB1, alB, l_reg, pa0, pa1, pa2, pa3); SBAR();
  pv_d0(o, vb0 + SHM_V, pa0, pa1, pa2, pa3);
  if (hi == 0) li_l[r32] = l_reg; asm volatile("s_waitcnt lgkmcnt(0)" ::: "memory");
  float rli[16];
#pragma unroll
  for (int r = 0; r < 16; ++r) rli[r] = __builtin_amdgcn_rcpf(li_l[crow(r, hi)]);
  unsigned short* Ow = Ob + (long)(wid * QBLK) * LDO;
#pragma unroll
  for (int r = 0; r < 16; ++r) { int orow = crow(r, hi);
#pragma unroll
    for (int d0 = 0; d0 < 4; ++d0) Ow[(long)orow * LDO + d0 * 32 + r32] = (unsigned short)f2bf(o[d0][r] * rli[r]); }
#undef SLOAD
#undef SWRITE
#undef SWAIT
#undef RESC
}
#undef KSWZ
#undef SBAR
}

#ifndef DBG_STOP
#define DBG_STOP 1000
#endif
constexpr int PH_PER_LAYER = 15, NPHASE = 1 + 2 * PH_PER_LAYER, PH_COPY = NPHASE;
struct Args { const float* in[N_IN]; float* out; unsigned char* ws; int ph_lo, ph_hi; };

template <class Epi> __device__ __forceinline__ void run_gemm(LAS unsigned char* lds, const bf16* A, const bf16* Bt, int M, int N, int K, int G, const Epi& E, int wave, int cshift = 0) {
    asm volatile("" : "+s"(K));
    pg8::Gemm g{A, Bt, M, N, K, K, (size_t)256 * K * 2, (size_t)0}; pg8::StaticOrder S; S.init(M, N, G, (int)((blockIdx.x + (unsigned)cshift) % (unsigned)G));
    pg8::gemm_phase<Epi, pg8::StaticOrder, true, true>(lds, g, S, E, wave);
}

#ifndef SK_MASK
#define SK_MASK 15
#endif
#ifndef SK_DRY
#define SK_DRY 0
#endif
#ifndef PH7_BAL
#define PH7_BAL 1
#endif
#define SK_F1 ((SK_MASK) & 1)
#define SK_IN (((SK_MASK) >> 3) & 1)
#define SK_OP (((SK_MASK) >> 1) & 1)
#define SK_F2 (((SK_MASK) >> 2) & 1)
template <class Epi> __device__ __forceinline__ void run_gemm_sk(LAS unsigned char* lds, const bf16* A, const bf16* Bt, int ld, int N, int G, const Epi& E, int wave, int ns = SK_NS) {
    asm volatile("" : "+s"(ld));
    asm volatile("" : "+s"(ns)); int Ks = ld / ns; asm volatile("" : "+s"(Ks));
    pg8::Gemm g{A, Bt, ns * 256, N, Ks, ld, (size_t)Ks * 2, (size_t)Ks * 2}; pg8::StaticOrder S; S.init(ns * 256, N, G, (int)blockIdx.x);
    pg8::gemm_phase<Epi, pg8::StaticOrder, true, true>(lds, g, S, E, wave);
}
#define WSP(T, off) ((T*)(ws + (off)))

template <int PHSEL> __global__ void __launch_bounds__(NTHR, 2) fwd_kernel(Args args) {
    extern __shared__ __attribute__((aligned(16))) unsigned char lds_raw[];
    LAS unsigned char* lds = (LAS unsigned char*)lds_raw;
    const int wave = __builtin_amdgcn_readfirstlane((int)(threadIdx.x >> 6));
    const int G = gridDim.x; const int bx = blockIdx.x; const int vcu = (G % 8 == 0) ? (bx % 8) * (G / 8) + bx / 8 : bx;
    const int gw = vcu * NWAVES + wave, NGW = G * NWAVES;
    const int lo = args.ph_lo, hi = args.ph_hi;
    volatile LAS unsigned* MISC = (volatile LAS unsigned*)(lds + MISC_OFF);
    if (threadIdx.x < 64) MISC[threadIdx.x] = 0u;
    if (threadIdx.x == 0) {
        LAS unsigned long long* PT = (LAS unsigned long long*)(lds + PT_OFF);
#pragma unroll
        for (int i = 0; i < N_IN; ++i) PT[i] = (unsigned long long)args.in[i];
        PT[N_IN] = (unsigned long long)args.out; PT[N_IN + 1] = (unsigned long long)args.ws;
    }
    __syncthreads();
    XcdBarrier bar; bar.bar = (unsigned*)(args.ws + WS_CTL) + CW_BAR; bar.x = 0; bar.st = nullptr;
    if (hi - lo > 1) bar = xcd_barrier_post((unsigned*)(args.ws + WS_CTL) + CW_BAR, MISC + 8);
    bar.wave = wave;
#ifndef PH_MASK
#define PH_MASK 0xFFFFF
#endif
#ifndef DBG_REP
#define DBG_REP -1
#endif
#define REPS(j) ((DBG_REP == (j)) ? 2 : 1)
#define EN(j) ((((PH_MASK) >> (j)) & 1) && (PHSEL < 0 || PHSEL == ((j) >= 16 ? 7 : (j))))
#define IN(k) (lo <= (k) && (k) < hi && (k) <= DBG_STOP)
#define SEAM(k) do { if (lo <= (k) && (k) + 1 < hi) { asm volatile("" ::: "memory"); XcdBarrier bb_ = bar; bb_.bar = (unsigned*)((GAS unsigned char*)ld_uptr(lds, N_IN + 1) + WS_CTL) + CW_BAR; xcd_barrier(bb_); if (bx == 0) TSW(k); } } while (0)
#ifdef DBG_TS_A
#define TSW(id) do { if (wave == 0 && lane_vol() == 0) __hip_atomic_store((gu32*)((GAS unsigned char*)ld_uptr(lds, N_IN + 1) + WS_CTL) + 16384 + (id), (unsigned)__builtin_amdgcn_s_memrealtime(), RLX_AGENT); } while (0)
#else
#define TSW(id) do {} while (0)
#endif
#define PHASE_PTRS() const Ptrs P = load_ptrs(lds); unsigned char* ws = P.ws; const float* MOD = WSP(const float, WS_MOD); \
        const float* modL = MOD + (size_t)(l * 2 + 0) * NMODC; const float* modC = MOD + (size_t)(l * 2 + 1) * NMODC; float* X = WSP(float, WS_X); float* XC = X + (size_t)SEQ * DM; \
        (void)modL; (void)modC; (void)X; (void)XC

    if (bx == 0) TSW(62);
    if (EN(0) && IN(0)) for (int rp = 0; rp < REPS(0); ++rp) prologue_phase(lds, vcu, G, wave);
    SEAM(0);

    for (int l = 0; l < 2; ++l) {
        const int pb = 1 + PH_PER_LAYER * l;
        const bool last = (l == 1);
        const int nrows2 = last ? SEQ : MROWS;
        if (EN(1) && IN(pb + 0)) for (int rp = 0; rp < REPS(1); ++rp) { PHASE_PTRS(); const float* x0L = (l == 0) ? P.in[I_X] : X; const float* x0C = (l == 0) ? P.in[I_CTX] : XC;
            prep_phase(lds, x0L, x0C, MROWS, P.in[I_NORMG] + (size_t)(l * 3 + 0) * DM, modL, modC, 0, WSP(bf16, WS_XN), gw, NGW, wave, SK_F2 && l == 1 ? WSP(const float, WS_ACC) : nullptr, XC); }
        SEAM(pb + 0);
        if (EN(2) && IN(pb + 1)) for (int rp = 0; rp < REPS(2); ++rp) { PHASE_PTRS(); EpiSwiGLU E{WSP(bf16, WS_H)}; run_gemm(lds, WSP(const bf16, WS_XN), WSP(const bf16, WS_WFI + (size_t)(l * 2 + 0) * SZ_WFI), MROWS, 16384, DM, G, E, wave); }
        SEAM(pb + 1);
        if (EN(3) && IN(pb + 2)) { PHASE_PTRS(); const float* x0L = (l == 0) ? P.in[I_X] : X; const float* x0C = (l == 0) ? P.in[I_CTX] : XC;
            EpiRes E{x0L, x0C, X, XC, modL + 2 * DM, modC + 2 * DM, 0.5f}; run_gemm(lds, WSP(const bf16, WS_H), WSP(const bf16, WS_WFO + (size_t)(l * 2 + 0) * SZ_WFO), (SK_F1 && !SK_DRY) ? SEQ : MROWS, DM, DFF, G, E, wave);
            if (SK_F1) { EpiSlab EA{WSP(float, WS_ACC), modC + 2 * DM, 0.5f};
#if SK_DRY == 2
            run_gemm(lds, WSP(const bf16, WS_H) + (size_t)SEQ * DFF, WSP(const bf16, WS_WFO + (size_t)(l * 2 + 0) * SZ_WFO), 256, DM, DFF, G, EA, wave); } }
#else
            run_gemm_sk(lds, WSP(const bf16, WS_H) + (size_t)SEQ * DFF, WSP(const bf16, WS_WFO + (size_t)(l * 2 + 0) * SZ_WFO), DFF, DM, G, EA, wave); } }
#endif
        SEAM(pb + 2);
        if (EN(4) && IN(pb + 3)) for (int rp = 0; rp < REPS(4); ++rp) { PHASE_PTRS(); prep_phase(lds, X, (SK_F1 && !SK_DRY && l == 0) ? P.in[I_CTX] : XC, MROWS, P.in[I_NORMG] + (size_t)(l * 3 + 1) * DM, modL, modC, 3, WSP(bf16, WS_XN), gw, NGW, wave, (SK_F1 && !SK_DRY) ? WSP(const float, WS_ACC) : nullptr, XC); }
        SEAM(pb + 3);
        if (EN(5) && IN(pb + 4)) for (int rp = 0; rp < REPS(5); ++rp) { PHASE_PTRS();
            EpiB16 E{WSP(bf16, WS_Z), ZC}; run_gemm(lds, WSP(const bf16, WS_XN), WSP(const bf16, WS_WIN + (size_t)l * SZ_WIN), SK_IN ? SEQ : MROWS, ZC, DM, G, E, wave);
            if (SK_IN) { EpiSlabP ES{WSP(float, WS_SLB), ZC}; run_gemm_sk(lds, WSP(const bf16, WS_XN) + (size_t)SEQ * DM, WSP(const bf16, WS_WIN + (size_t)l * SZ_WIN), DM, ZC, G, ES, wave, 4); } }
        SEAM(pb + 4);
        if (EN(6) && IN(pb + 5)) { if (SK_IN) { { PHASE_PTRS(); ctx_reduce_z(P, vcu, G, wave); } SEAM(pb + 4); } PHASE_PTRS(); streams_phase(P, l, gw, NGW); }
        SEAM(pb + 5);
        if (EN(7) && IN(pb + 6)) {
#if PH7_BAL
            if (EN(16)) { PHASE_PTRS(); EpiB16 E{WSP(bf16, WS_LW), 10240}; run_gemm(lds, WSP(const bf16, WS_LWA), WSP(const bf16, WS_WWA + (size_t)l * SZ_WWA), SEQ, 10240, 512, G, E, wave); }
            if (EN(19)) { PHASE_PTRS(); EpiB16 E{WSP(bf16, WS_KVF), 4096}; run_gemm(lds, WSP(const bf16, WS_KVL), WSP(const bf16, WS_WKV + (size_t)l * SZ_WKV), SEQ, 4096, 512, G, E, wave); }
            if (EN(18)) { PHASE_PTRS(); EpiB16 E{WSP(bf16, WS_QF), 3072}; run_gemm(lds, WSP(const bf16, WS_QL), WSP(const bf16, WS_WQ + (size_t)l * SZ_WQ), SEQ, 3072, 1024, G, E, wave); }
            if (EN(16)) { PHASE_PTRS(); EpiB16 E{WSP(bf16, WS_LW) + (size_t)SEQ * 10240, 10240}; run_gemm(lds, WSP(const bf16, WS_LWA) + (size_t)SEQ * 512, WSP(const bf16, WS_WWA + (size_t)l * SZ_WWA), CTXL, 10240, 512, G, E, wave, 128); }
            if (EN(18)) { PHASE_PTRS(); EpiB16 E{WSP(bf16, WS_QF) + (size_t)SEQ * 3072, 3072}; run_gemm(lds, WSP(const bf16, WS_QL) + (size_t)SEQ * 1024, WSP(const bf16, WS_WQ + (size_t)l * SZ_WQ), CTXL, 3072, 1024, G, E, wave, 88); }
            if (EN(19)) { PHASE_PTRS(); EpiB16 E{WSP(bf16, WS_KVF) + (size_t)SEQ * 4096, 4096}; run_gemm(lds, WSP(const bf16, WS_KVL) + (size_t)SEQ * 512, WSP(const bf16, WS_WKV + (size_t)l * SZ_WKV), CTXL, 4096, 512, G, E, wave, 72); }
#else
            if (EN(16)) { PHASE_PTRS(); EpiB16 E{WSP(bf16, WS_LW), 10240}; run_gemm(lds, WSP(const bf16, WS_LWA), WSP(const bf16, WS_WWA + (size_t)l * SZ_WWA), MROWS, 10240, 512, G, E, wave); }
            if (EN(18)) { PHASE_PTRS(); EpiB16 E{WSP(bf16, WS_QF), 3072}; run_gemm(lds, WSP(const bf16, WS_QL), WSP(const bf16, WS_WQ + (size_t)l * SZ_WQ), MROWS, 3072, 1024, G, E, wave); }
            if (EN(19)) { PHASE_PTRS(); EpiB16 E{WSP(bf16, WS_KVF), 4096}; run_gemm(lds, WSP(const bf16, WS_KVL), WSP(const bf16, WS_WKV + (size_t)l * SZ_WKV), MROWS, 4096, 512, G, E, wave); }
#endif
        }
        SEAM(pb + 6);
        if (EN(9) && IN(pb + 8)) {
            PHASE_PTRS();
            gu32* ctlw = (gu32*)(ws + WS_CTL);
            gu32* qk_done = ctlw + CW_MIX + 64 * l; gu32* q_head = ctlw + CW_MIX + 64 * (2 + l); gu32* tmo = ctlw + CW_MIX + 64 * 4;
            gu32* scan_done = ctlw + CW_MIX + 64 * (5 + l);
            if (vcu < 128) {
                scan_phase(P, l, lds, vcu, wave);
                if (bx == 0) TSW(40 + l);
                asm volatile("s_waitcnt vmcnt(0)" ::: "memory"); __syncthreads();
                if (wave == 0 && lane_vol() == 0) { __builtin_amdgcn_fence(__ATOMIC_RELEASE, "agent"); asm volatile("s_waitcnt vmcnt(0)" ::: "memory"); __hip_atomic_fetch_add(scan_done, 1u, RLX_AGENT); }
            } else {
                qknorm_phase(P, l, (vcu - 128) * NWAVES + wave, 128 * NWAVES);
                if (vcu == 200) TSW(46 + l);
                asm volatile("s_waitcnt vmcnt(0)" ::: "memory"); __syncthreads();
                if (wave == 0 && lane_vol() == 0) { __builtin_amdgcn_fence(__ATOMIC_RELEASE, "agent"); asm volatile("s_waitcnt vmcnt(0)" ::: "memory"); __hip_atomic_fetch_add(qk_done, 1u, RLX_AGENT); }
            }
            if (wave == 0 && lane_vol() == 0) {
                unsigned sp = 0;
                while (__hip_atomic_load(qk_done, RLX_AGENT) < 128u) { __builtin_amdgcn_s_sleep(2); if (++sp > (1u << 22)) { __hip_atomic_store(tmo, 1u, RLX_AGENT); break; } }
                __builtin_amdgcn_fence(__ATOMIC_ACQUIRE, "agent"); asm volatile("s_waitcnt vmcnt(0)" ::: "memory");
            }
            __syncthreads();
            if (bx == 0) TSW(50 + l);
            const int nun = 512 + (last ? 0 : 16);
            const bf16* QB = WSP(const bf16, WS_QB); const bf16* KB = WSP(const bf16, WS_KB); const bf16* VB = WSP(const bf16, WS_VB); bf16* OC = WSP(bf16, WS_OC);
            bool scan_ok = false;
            for (;;) {
                if (wave == 0 && lane_vol() == 0) MISC[16] = __hip_atomic_fetch_add(q_head, 1u, RLX_AGENT);
                __syncthreads();
                const int u = (int)MISC[16];
                if (u >= nun) {
                    const int v = u - nun; if (v * 32 >= nrows2) break;
                    if (!scan_ok) {
                        if (wave == 0 && lane_vol() == 0) { unsigned sp = 0;
                            while (__hip_atomic_load(scan_done, RLX_AGENT) < 128u) { __builtin_amdgcn_s_sleep(2); if (++sp > (1u << 22)) { __hip_atomic_store(tmo, 1u, RLX_AGENT); break; } }
                            __builtin_amdgcn_fence(__ATOMIC_ACQUIRE, "agent"); asm volatile("s_waitcnt vmcnt(0)" ::: "memory"); }
                        __syncthreads(); scan_ok = true;
                    }
                    rwkvout_phase(P, l, v * 32, v * 32 + 32, wave, NWAVES);
                    __syncthreads();
                    continue;
                }
                int h, q0, key0, nk;
                if (u < 512) { h = u >> 5; q0 = (u & 31) * 256; key0 = 0; nk = MROWS; } else { h = u - 512; q0 = SEQ; key0 = SEQ; nk = CTXL; }
                att::attn_body(QB + (size_t)q0 * 3072 + h * 192, KB + (size_t)key0 * 3072 + h * 192, VB + (size_t)key0 * 2048 + h * 128, OC + (size_t)q0 * DM + 2048 + h * 128, nk, (char*)lds_raw, wave);
                __syncthreads();
            }
            __syncthreads();
            if (bx == 0) TSW(44 + l); if (vcu == 200) TSW(48 + l);
        }
        SEAM(pb + 8);
        if (EN(12) && IN(pb + 11)) { PHASE_PTRS(); EpiRes E{X, XC, X, XC, modL + 5 * DM, modC + 5 * DM, 1.0f}; run_gemm(lds, WSP(const bf16, WS_OC), WSP(const bf16, WS_WOUT + (size_t)l * SZ_WOUT), SK_OP ? SEQ : nrows2, DM, DM, G, E, wave);
            if (SK_OP && !last) { EpiSlab EA{WSP(float, WS_ACC), modC + 5 * DM, 1.0f}; run_gemm_sk(lds, WSP(const bf16, WS_OC) + (size_t)SEQ * DM, WSP(const bf16, WS_WOUT + (size_t)l * SZ_WOUT), DM, DM, G, EA, wave); } }
        SEAM(pb + 11);
        if (EN(13) && IN(pb + 12)) for (int rp = 0; rp < REPS(13); ++rp) { PHASE_PTRS(); prep_phase(lds, X, XC, nrows2, P.in[I_NORMG] + (size_t)(l * 3 + 2) * DM, modL, modC, 6, WSP(bf16, WS_XN), gw, NGW, wave, (SK_OP && !last) ? WSP(const float, WS_ACC) : nullptr, XC); }
        SEAM(pb + 12);
        if (EN(14) && IN(pb + 13)) for (int rp = 0; rp < REPS(14); ++rp) { PHASE_PTRS(); EpiSwiGLU E{WSP(bf16, WS_H)}; run_gemm(lds, WSP(const bf16, WS_XN), WSP(const bf16, WS_WFI + (size_t)(l * 2 + 1) * SZ_WFI), nrows2, 16384, DM, G, E, wave); }
        SEAM(pb + 13);
        if (EN(15) && IN(pb + 14)) { PHASE_PTRS(); float* oL = last ? P.out : X;
            EpiRes E{X, XC, oL, XC, modL + 8 * DM, modC + 8 * DM, 0.5f}; run_gemm(lds, WSP(const bf16, WS_H), WSP(const bf16, WS_WFO + (size_t)(l * 2 + 1) * SZ_WFO), SK_F2 ? SEQ : nrows2, DM, DFF, G, E, wave);
            if (SK_F2 && !last) { EpiSlab EA{WSP(float, WS_ACC), modC + 8 * DM, 0.5f}; run_gemm_sk(lds, WSP(const bf16, WS_H) + (size_t)SEQ * DFF, WSP(const bf16, WS_WFO + (size_t)(l * 2 + 1) * SZ_WFO), DFF, DM, G, EA, wave); } }
        SEAM(pb + 14);
    }
    if ((PHSEL < 0 || PHSEL == 100) && DBG_STOP < NPHASE - 1 && lo <= PH_COPY && PH_COPY < hi) {
        const int l = 0; PHASE_PTRS();
        const int tid = wave * 64 + lane_vol();
#if 0
#else
        const float* src = (DBG_STOP >= 3) ? X : P.in[I_X];
        for (size_t i = (size_t)(bx * NTHR + tid); i < (size_t)SEQ * DM / 4; i += (size_t)G * NTHR) ((f32x4*)P.out)[i] = ((const f32x4*)src)[i];
#endif
    }
#ifdef DBG_TS_A
    if (bx == 0 && wave == 0 && lane_vol() == 0) {
        gu32* tsp = (gu32*)((GAS unsigned char*)ld_uptr(lds, N_IN + 1) + WS_CTL) + 16384;
        const unsigned tb = (DBG_TS_B == 99) ? (unsigned)__builtin_amdgcn_s_memrealtime() : __hip_atomic_load(tsp + DBG_TS_B, RLX_AGENT);
        const unsigned ta = __hip_atomic_load(tsp + DBG_TS_A, RLX_AGENT);
        const unsigned long long dt = (unsigned long long)(tb - ta) * (unsigned long long)(DBG_TS_MULT);
        const unsigned long long t0_ = __builtin_amdgcn_s_memrealtime();
        while (__builtin_amdgcn_s_memrealtime() - t0_ < dt) __builtin_amdgcn_s_sleep(64);
    }
#endif
#undef IN
#undef SEAM
}

extern "C" void kernel_launch(void* const* d_in, const int* in_sizes, int n_in, void* d_out, int out_size, void* d_ws, size_t ws_size, hipStream_t stream) {
    static int grid = 0;
    if (grid == 0) {
        if (n_in != N_IN || out_size != SEQ * DM || ws_size < WS_END) { fprintf(stderr, "kernel_launch: unexpected shapes: n_in %d out %d ws %zu (need %zu)\n", n_in, out_size, ws_size, (size_t)WS_END); grid = -1; return; }
        int dev = 0, cus = 0;
        if (hipGetDevice(&dev) != hipSuccess || hipDeviceGetAttribute(&cus, hipDeviceAttributeMultiprocessorCount, dev) != hipSuccess) { grid = -1; return; }
        {
            hipError_t e = hipSuccess;
#if MK_ONE_LAUNCH
            e = hipFuncSetAttribute((const void*)fwd_kernel<-1>, hipFuncAttributeMaxDynamicSharedMemorySize, LDS_BYTES);
#else
#define SETA(S) if (e == hipSuccess) e = hipFuncSetAttribute((const void*)fwd_kernel<S>, hipFuncAttributeMaxDynamicSharedMemorySize, LDS_BYTES)
            SETA(0); SETA(1); SETA(2); SETA(3); SETA(4); SETA(5); SETA(6); SETA(7); SETA(8); SETA(9); SETA(10); SETA(11); SETA(12); SETA(13); SETA(14); SETA(15); SETA(100);
#undef SETA
#endif
            if (e != hipSuccess) { fprintf(stderr, "kernel_launch: hipFuncSetAttribute failed\n"); grid = -1; return; }
        }
        (void)hipGetLastError();
        grid = cus;
    }
    if (grid < 0) return;
    (void)hipMemsetAsync((char*)d_ws + WS_CTL, 0, ZERO_BYTES, stream);
    Args a{};
    for (int i = 0; i < N_IN; ++i) a.in[i] = (const float*)d_in[i];
    a.out = (float*)d_out; a.ws = (unsigned char*)d_ws;
    const int last_phase = (DBG_STOP < NPHASE - 1) ? PH_COPY : NPHASE - 1;
#if MK_ONE_LAUNCH
    a.ph_lo = 0; a.ph_hi = last_phase + 1;
    hipLaunchKernelGGL(fwd_kernel<-1>, dim3(grid), dim3(NTHR), LDS_BYTES, stream, a);
#else
    for (int p = 0; p <= last_phase; ++p) {
        if (p > DBG_STOP && p != PH_COPY) continue;
#ifdef HOST_SKIP_FROM
        if (p >= HOST_SKIP_FROM && p != PH_COPY) continue;
#endif
        a.ph_lo = p; a.ph_hi = p + 1;
        const int slot = (p == 0) ? 0 : (p == PH_COPY ? 100 : 1 + (p - 1) % PH_PER_LAYER);
#define LCH(S) case S: hipLaunchKernelGGL(fwd_kernel<S>, dim3(grid), dim3(NTHR), LDS_BYTES, stream, a); break
        switch (slot) { LCH(0); LCH(1); LCH(2); LCH(3); LCH(4); LCH(5); LCH(6); LCH(7); LCH(8); LCH(9); LCH(10); LCH(11); LCH(12); LCH(13); LCH(14); LCH(15); LCH(100); default: break; }
#undef LCH
    }
#endif
    const hipError_t le = hipPeekAtLastError();
    if (le != hipSuccess) fprintf(stderr, "kernel_launch: launch failed: %s\n", hipGetErrorName(le));
}
```

```cpp
#include <hip/hip_runtime.h>
#include <cstdio>
#include <cstdint>
#define MK_ONE_LAUNCH 1
#define DBG_STOP 1000
#ifndef MK_ONE_LAUNCH
#define MK_ONE_LAUNCH 1
#endif
namespace pg8 {
#define PG8_LAS __attribute__((address_space(3)))
typedef unsigned short bf16_t;
typedef short bf16x8 __attribute__((ext_vector_type(8)));
typedef float f32x4 __attribute__((ext_vector_type(4)));
typedef unsigned u32x4 __attribute__((ext_vector_type(4)));
constexpr int BM = 256, BK = 64, HALF = 128, HTB = HALF * BK * 2  , STAGE_BYTES = 8 * HTB, NXCD = 8, WGM = 8;

__host__ __device__ __forceinline__ int lds_byte(int r, int c) { const int st = (r >> 4) * 2 + (c >> 5), rr = r & 15, cc = c & 31, ob = rr * 64 + cc * 2; return st * 1024 + (ob ^ (((ob >> 9) & 1) << 5)); }
__host__ __device__ __forceinline__ void stage_rc(int b, int& R, int& C) { const int st = b / 1024, sb = b % 1024, swz = sb ^ (((sb >> 9) & 1) << 5); R = (st >> 1) * 16 + swz / 64; C = (st & 1) * 32 + (swz % 64) / 2; }
__host__ __device__ __forceinline__ int perm32(int rho) { const int n = rho >> 4, i = rho & 15; return 8 * (i >> 2) + 4 * n + (i & 3); }

struct Unit { int pm, pn; };
struct Gemm { const bf16_t* A; const bf16_t* Bt; int M, N, K; int ld; size_t apm, bpm; };

struct StaticOrder {
    int nM, nN, nwg, G, c;
    __host__ __device__ void init(int M, int N, int G_, int c_) { nM = M / BM; nN = N / BM; nwg = nM * nN; G = G_; c = c_; }
    __host__ __device__ bool next(int i, Unit& u) const {
        const long L = (long)i * G + c; if (L >= nwg) return false;
        int wgid = (int)L; { const int q = nwg / NXCD, r = nwg % NXCD, xcd = wgid % NXCD, off = wgid / NXCD; wgid = (xcd < r ? xcd * (q + 1) : r * (q + 1) + (xcd - r) * q) + off; }
        const int nig = WGM * nN, gid = wgid / nig, fm = gid * WGM, gsz = (nM - fm) < WGM ? (nM - fm) : WGM;
        u.pm = fm + ((wgid % nig) % gsz); u.pn = (wgid % nig) / gsz; return true;
    }
    __device__ __forceinline__ void a_ready(const Unit&) const {}
    __device__ __forceinline__ void done(const Unit&) const {}
};

__device__ __forceinline__ unsigned cvt_pk_bf16(float lo, float hi) { unsigned r; asm volatile("s_nop 0\n\tv_cvt_pk_bf16_f32 %0, %1, %2" : "=v"(r) : "v"(lo), "v"(hi)); return r; }
template <class Epi, class Sched, bool ALIGN_EPI = false, bool SP2 = false>
__device__ __forceinline__ void gemm_phase(PG8_LAS unsigned char* lds, const Gemm g, const Sched& S, const Epi& E, int wave_in) {
    int tid_o; asm volatile("v_mbcnt_lo_u32_b32 %0, -1, 0\n\tv_mbcnt_hi_u32_b32 %0, -1, %0" : "=v"(tid_o)); tid_o += wave_in * 64;
    const int tid = tid_o, wid = wave_in, lane = tid & 63, wr = wid >> 2, wc = wid & 3, fr = lane & 15, fq = lane >> 4;
    const int K = g.K, nt = K / BK, LD = g.ld;
    unsigned voffA[2], voffB[2];
#pragma unroll
    for (int i = 0; i < 2; ++i) { int R, C; stage_rc(tid * 16 + i * 8192, R, C); const int Rb = Epi::PERM ? ((R & ~31) + perm32(R & 31)) : R;
        voffA[i] = (unsigned)(R * LD + C) * 2u; voffB[i] = (unsigned)(Rb * LD + C) * 2u; }
    const size_t kstep = (size_t)(BK * 2);
    const size_t hstep = (size_t)HALF * LD * 2;
    const size_t tstep = 2 * hstep;
    const unsigned ldsw = (unsigned)wid * 1024u;
    const int aoff = lds_byte(wr * 64 + fr, fq * 8), boff = lds_byte(wc * 32 + fr, fq * 8);
#define PG8_SA(b, h) (((b) * 2 + (h)) * HTB)
#define PG8_SB(b, h) ((4 + (b) * 2 + (h)) * HTB)
#define PG8_STAGE(bufoff, gbase, voff) do { _Pragma("unroll") for (int _i = 0; _i < 2; ++_i) \
        __builtin_amdgcn_global_load_lds((const unsigned*)((const char*)(gbase) + (voff)[_i]), (PG8_LAS unsigned*)(lds + (bufoff) + ldsw + _i * 8192), 16, 0, 0); } while (0)
#define PG8_LDA(dst, b, h) do { _Pragma("unroll") for (int m = 0; m < 4; ++m) _Pragma("unroll") for (int k = 0; k < 2; ++k) dst[m][k] = *(const PG8_LAS bf16x8*)(lds + PG8_SA(b, h) + aoff + m * 2048 + k * 1024); } while (0)
#define PG8_LDB(dst, b, h) do { _Pragma("unroll") for (int n = 0; n < 2; ++n) _Pragma("unroll") for (int k = 0; k < 2; ++k) dst[n][k] = *(const PG8_LAS bf16x8*)(lds + PG8_SB(b, h) + boff + n * 2048 + k * 1024); } while (0)
#define PG8_MMA(ai, bj, At, Bt) do { __builtin_amdgcn_s_setprio(1); _Pragma("unroll") for (int m = 0; m < 4; ++m) _Pragma("unroll") for (int n = 0; n < 2; ++n) _Pragma("unroll") for (int k = 0; k < 2; ++k) \
        acc[ai][bj][m][n] = __builtin_amdgcn_mfma_f32_16x16x32_bf16(Bt[n][k], At[m][k], acc[ai][bj][m][n], 0, 0, 0); __builtin_amdgcn_s_setprio(0); } while (0)
#define PG8_WAIT_V(n) asm volatile("s_waitcnt vmcnt(" #n ")" ::: "memory")
#define PG8_WAIT_L(n) asm volatile("s_waitcnt lgkmcnt(" #n ")" ::: "memory")
#define PG8_BAR __builtin_amdgcn_s_barrier()
#define PG8_SCHED __builtin_amdgcn_sched_barrier(0)
    Unit cur, nxt; int ui = 0;
    if (!S.next(0, cur)) return;
    f32x4 acc[2][2][4][2];
#pragma unroll
    for (int a = 0; a < 2; ++a)
#pragma unroll
        for (int b = 0; b < 2; ++b)
#pragma unroll
            for (int m = 0; m < 4; ++m)
#pragma unroll
                for (int n = 0; n < 2; ++n) acc[a][b][m][n] = (f32x4){0.f, 0.f, 0.f, 0.f};
    bf16x8 At[4][2], B0[2][2], B1[2][2];
    const char* cA = (const char*)g.A + (size_t)cur.pm * g.apm; const char* cB = (const char*)g.Bt + (size_t)cur.pn * tstep + (size_t)cur.pm * g.bpm;
    S.a_ready(cur);
    if constexpr (SP2) {
        PG8_STAGE(PG8_SB(0, 0), cB, voffB); PG8_STAGE(PG8_SB(0, 1), cB + hstep, voffB); PG8_STAGE(PG8_SA(0, 0), cA, voffA); PG8_STAGE(PG8_SA(0, 1), cA + hstep, voffA);
        if (wr == 1) PG8_BAR;
        PG8_WAIT_V(2); PG8_BAR;
        PG8_STAGE(PG8_SB(1, 0), cB + kstep, voffB); PG8_STAGE(PG8_SA(1, 0), cA + kstep, voffA); PG8_STAGE(PG8_SB(1, 1), cB + hstep + kstep, voffB);
        PG8_WAIT_V(6); PG8_BAR;
    } else {
        PG8_STAGE(PG8_SB(0, 0), cB, voffB); PG8_STAGE(PG8_SA(0, 0), cA, voffA); PG8_STAGE(PG8_SB(0, 1), cB + hstep, voffB); PG8_STAGE(PG8_SA(0, 1), cA + hstep, voffA);
        if (wr == 1) PG8_BAR;
        PG8_WAIT_V(4); PG8_BAR;
        PG8_STAGE(PG8_SB(1, 0), cB + kstep, voffB); PG8_STAGE(PG8_SA(1, 0), cA + kstep, voffA); PG8_STAGE(PG8_SB(1, 1), cB + hstep + kstep, voffB);
        PG8_WAIT_V(6); PG8_BAR;
    }
    for (;;) {
        const bool has_next = S.next(ui + 1, nxt);
        const char* nA = has_next ? (const char*)g.A + (size_t)nxt.pm * g.apm : cA; const char* nB = has_next ? (const char*)g.Bt + (size_t)nxt.pn * tstep + (size_t)nxt.pm * g.bpm : cB;
        for (int t = 0; t < nt; t += 2) {
            const bool last = (t == nt - 2);
            const char* a1 = cA + (size_t)(t + 1) * kstep;
            const char* a2 = last ? nA : cA + (size_t)(t + 2) * kstep; const char* b2 = last ? nB : cB + (size_t)(t + 2) * kstep;
            const char* a3 = a2 + kstep; const char* b3 = b2 + kstep;
            if (last && has_next) S.a_ready(nxt);
            if constexpr (SP2) {
            PG8_LDB(B0, 0, 0); PG8_LDB(B1, 0, 1); PG8_SCHED; PG8_LDA(At, 0, 0); PG8_STAGE(PG8_SA(1, 1), a1 + hstep, voffA);
            PG8_WAIT_V(8); PG8_WAIT_L(0); PG8_BAR; PG8_MMA(0, 0, At, B0); PG8_MMA(0, 1, At, B1); PG8_BAR; PG8_SCHED;
            PG8_LDA(At, 0, 1); PG8_STAGE(PG8_SB(0, 0), b2, voffB); PG8_STAGE(PG8_SB(0, 1), b2 + hstep, voffB); PG8_STAGE(PG8_SA(0, 0), a2, voffA);
            PG8_WAIT_V(8); PG8_WAIT_L(0); PG8_BAR; PG8_MMA(1, 0, At, B0); PG8_MMA(1, 1, At, B1); PG8_BAR; PG8_SCHED;
            PG8_LDB(B0, 1, 0); PG8_LDB(B1, 1, 1); PG8_SCHED; PG8_LDA(At, 1, 0); PG8_STAGE(PG8_SA(0, 1), a2 + hstep, voffA);
            PG8_WAIT_V(8); PG8_WAIT_L(0); PG8_BAR; PG8_MMA(0, 0, At, B0); PG8_MMA(0, 1, At, B1); PG8_BAR; PG8_SCHED;
            PG8_LDA(At, 1, 1); PG8_STAGE(PG8_SB(1, 0), b3, voffB); PG8_STAGE(PG8_SB(1, 1), b3 + hstep, voffB); PG8_STAGE(PG8_SA(1, 0), a3, voffA);
            PG8_WAIT_V(8); PG8_WAIT_L(0); PG8_BAR; PG8_MMA(1, 0, At, B0); PG8_MMA(1, 1, At, B1); PG8_BAR; PG8_SCHED;
            } else {
            PG8_LDB(B0, 0, 0); PG8_SCHED; PG8_LDA(At, 0, 0); PG8_STAGE(PG8_SA(1, 1), a1 + hstep, voffA);
            PG8_WAIT_L(8); PG8_BAR; PG8_WAIT_L(0); PG8_MMA(0, 0, At, B0); PG8_BAR; PG8_SCHED;
            PG8_LDB(B1, 0, 1); PG8_STAGE(PG8_SB(0, 0), b2, voffB);
            PG8_BAR; PG8_WAIT_L(0); PG8_MMA(0, 1, At, B1); PG8_BAR;
            PG8_LDA(At, 0, 1); PG8_STAGE(PG8_SA(0, 0), a2, voffA);
            PG8_BAR; PG8_WAIT_L(0); PG8_MMA(1, 0, At, B0); PG8_BAR; PG8_SCHED;
            PG8_STAGE(PG8_SB(0, 1), b2 + hstep, voffB);
            PG8_WAIT_V(6); PG8_BAR; PG8_MMA(1, 1, At, B1); PG8_BAR;
            PG8_LDB(B0, 1, 0); PG8_SCHED; PG8_LDA(At, 1, 0); PG8_STAGE(PG8_SA(0, 1), a2 + hstep, voffA);
            PG8_WAIT_L(8); PG8_BAR; PG8_WAIT_L(0); PG8_MMA(0, 0, At, B0); PG8_BAR; PG8_SCHED;
            PG8_LDB(B1, 1, 1); PG8_STAGE(PG8_SB(1, 0), b3, voffB);
            PG8_BAR; PG8_WAIT_L(0); PG8_MMA(0, 1, At, B1); PG8_BAR;
            PG8_LDA(At, 1, 1); PG8_STAGE(PG8_SA(1, 0), a3, voffA);
            PG8_BAR; PG8_WAIT_L(0); PG8_MMA(1, 0, At, B0); PG8_BAR; PG8_SCHED;
            PG8_STAGE(PG8_SB(1, 1), b3 + hstep, voffB);
            PG8_WAIT_V(6); PG8_BAR; PG8_MMA(1, 1, At, B1); PG8_BAR;
            }
        }
        if constexpr (ALIGN_EPI) { if (wr == 0) PG8_BAR; }
        if constexpr (!Epi::AFTER_DRAIN) { E(acc, cur, wr, wc, fr, fq); S.done(cur); }
        if (!has_next) break;
#pragma unroll
        for (int a = 0; a < 2; ++a)
#pragma unroll
            for (int b = 0; b < 2; ++b)
#pragma unroll
                for (int m = 0; m < 4; ++m)
#pragma unroll
                    for (int n = 0; n < 2; ++n) acc[a][b][m][n] = (f32x4){0.f, 0.f, 0.f, 0.f};
        cur = nxt; cA = nA; cB = nB; ++ui;
        if constexpr (ALIGN_EPI) { if (wr == 1) PG8_BAR; }
    }
    PG8_WAIT_V(0);
    if constexpr (!ALIGN_EPI) { if (wr == 0) PG8_BAR; }
    PG8_BAR;
    if constexpr (Epi::AFTER_DRAIN) { E.fused(acc, cur, wr, wc, fr, fq, lds, wid, lane); S.done(cur); }
#undef PG8_SA
#undef PG8_SB
#undef PG8_STAGE
#undef PG8_LDA
#undef PG8_LDB
#undef PG8_MMA
#undef PG8_WAIT_V
#undef PG8_WAIT_L
#undef PG8_BAR
#undef PG8_SCHED
}
}
#define GAS __attribute__((address_space(1)))
#define LAS __attribute__((address_space(3)))
typedef unsigned short bf16;
typedef unsigned v4u __attribute__((ext_vector_type(4)));
typedef float f32x4 __attribute__((ext_vector_type(4)));
typedef short bf16x8 __attribute__((ext_vector_type(8)));
typedef GAS unsigned gu32;
typedef GAS unsigned long long gu64;
#define RLX_AGENT __ATOMIC_RELAXED, __HIP_MEMORY_SCOPE_AGENT
#define LDS_WAIT() asm volatile("s_waitcnt lgkmcnt(0)" ::: "memory")
#define VM_WAIT() asm volatile("s_waitcnt vmcnt(0)" ::: "memory")
__device__ __forceinline__ unsigned long long rt() { return __builtin_amdgcn_s_memrealtime(); }
__device__ __forceinline__ unsigned f2bf(float f) { unsigned u = __builtin_bit_cast(unsigned, f); return (u + 0x7fffu + ((u >> 16) & 1u)) >> 16; }
__device__ __forceinline__ unsigned pk2(float lo, float hi) { return f2bf(lo) | (f2bf(hi) << 16); }

#define XB_TMO      128
#define XB_XCNT(j)  (256  + 64 * (j))
#define XB_XSUB(j)  (1280 + 64 * (j))
#define XB_XGEN(j)  (2304 + 64 * (j))
#define XB_TOP      3328
#define XB_TOPGEN   3392
#define XCD_BAR_WORDS 3456
#define XB_SPIN_CAP (1u << 18)

__device__ __forceinline__ unsigned xb_ld(unsigned* p)              { return __hip_atomic_load(p, __ATOMIC_RELAXED, __HIP_MEMORY_SCOPE_AGENT); }
__device__ __forceinline__ unsigned xb_add(unsigned* p, unsigned v) { return __hip_atomic_fetch_add(p, v, __ATOMIC_RELAXED, __HIP_MEMORY_SCOPE_AGENT); }
__device__ __forceinline__ unsigned xb_xcc_id() { return (unsigned)__builtin_amdgcn_s_getreg((3 << 11) | 20) & 0xFu; }
#define XB_SPIN(cond, bar) do { unsigned _sp = 0; while (cond) { __builtin_amdgcn_s_sleep(1); \
    if ((++_sp & 255u) == 0u) { if (xb_ld(&(bar)[XB_TMO])) break; if (_sp > XB_SPIN_CAP) { atomicAdd(&(bar)[XB_TMO], 1u); break; } } } } while (0)

struct XcdBarrier {
    unsigned* bar; unsigned x;
    volatile LAS unsigned* st;
    int wave;
};
__device__ __forceinline__ int xb_lane() { int l; asm volatile("v_mbcnt_lo_u32_b32 %0, -1, 0\n\tv_mbcnt_hi_u32_b32 %0, -1, %0" : "=v"(l)); return l; }

__device__ __forceinline__ XcdBarrier xcd_barrier_post(unsigned* bar, volatile LAS unsigned* st) {
    XcdBarrier b; b.bar = bar; b.x = xb_xcc_id(); b.st = st; b.wave = 0;
    if (threadIdx.x == 0) (void)xb_add(&bar[XB_XCNT(b.x)], 1u);
    return b;
}
__device__ __forceinline__ void xcd_barrier_complete(unsigned* bar, unsigned x, unsigned& nloc, unsigned& nx) {
    const unsigned G = gridDim.x * gridDim.y * gridDim.z;
    unsigned sum, cnt, mine, sp = 0u;
    for (;;) {
        sum = 0u; cnt = 0u; mine = 0u;
#pragma unroll
        for (unsigned j = 0; j < 16; ++j) { const unsigned c = xb_ld(&bar[XB_XCNT(j)]); sum += c; cnt += (c > 0u) ? 1u : 0u; mine = (j == x) ? c : mine; }
        if (sum == G) break;
        __builtin_amdgcn_s_sleep(1);
        if ((++sp & 255u) == 0u) { if (xb_ld(&bar[XB_TMO])) break; if (sp > XB_SPIN_CAP) { atomicAdd(&bar[XB_TMO], 1u); break; } }
    }
    nloc = mine > 0u ? mine : 1u; nx = cnt > 0u ? cnt : 1u;
}

__device__ __forceinline__ void xcd_barrier(const XcdBarrier& b) {
    asm volatile("s_waitcnt vmcnt(0)" ::: "memory");
    __syncthreads();
    if (b.wave == 0 && xb_lane() == 0) {
        unsigned* bar = b.bar;
        __builtin_amdgcn_s_waitcnt(0);
        unsigned nloc = b.st[0], nx = b.st[1];
        if (nloc == 0u) { xcd_barrier_complete(bar, b.x, nloc, nx); b.st[0] = nloc; b.st[1] = nx; }
        const unsigned old = xb_add(&bar[XB_XSUB(b.x)], 1u);
        const unsigned gen = old / nloc;
        if (old + 1u == (gen + 1u) * nloc) {
            __builtin_amdgcn_fence(__ATOMIC_RELEASE, "agent");
            asm volatile("s_waitcnt vmcnt(0)" ::: "memory");
            const unsigned og = xb_add(&bar[XB_TOP], 1u);
            const unsigned tg = og / nx;
            if (og + 1u == (tg + 1u) * nx) xb_add(&bar[XB_TOPGEN], 1u);
            else XB_SPIN(xb_ld(&bar[XB_TOPGEN]) == tg, bar);
            __builtin_amdgcn_fence(__ATOMIC_ACQUIRE, "agent");
            xb_add(&bar[XB_XGEN(b.x)], 1u);
            asm volatile("s_waitcnt vmcnt(0)" ::: "memory");
        } else {
            XB_SPIN(xb_ld(&bar[XB_XGEN(b.x)]) == gen, bar);
            __builtin_amdgcn_fence(__ATOMIC_ACQUIRE, "agent");
            asm volatile("s_waitcnt vmcnt(0)" ::: "memory");
        }
    }
    __syncthreads();
}

#ifndef BG_CONV
#define BG_CONV 1
#endif
constexpr int NWAVES = 8, NTHR = 512;
constexpr int DM = 4096, SEQ = 8192, CTXL = 256, MROWS = SEQ + CTXL, DFF = 8192, NMODC = 9 * DM;
constexpr int RWW = 2048, RWCOLS = 6592, ZC = 8192;
constexpr int LDS_BYTES = 155648;
constexpr int MISC_OFF = 151552;

constexpr size_t MiB = 1u << 20;
constexpr size_t al(size_t x) { return (x + MiB - 1) / MiB * MiB; }
constexpr size_t WS_CTL = 0, WS_MOD = 1 * MiB, ZERO_BYTES = 2 * MiB;
constexpr size_t SZ_WFI = (size_t)16384 * 4096 * 2, SZ_WFO = (size_t)4096 * 8192 * 2, SZ_WIN = (size_t)8192 * 4096 * 2, SZ_WOUT = (size_t)4096 * 4096 * 2;
constexpr size_t SZ_WQ = (size_t)3072 * 1024 * 2, SZ_WKV = (size_t)4096 * 512 * 2, SZ_WWA = (size_t)10240 * 512 * 2, SZ_WG = 0;
constexpr size_t WS_WFI = 2 * MiB, WS_WFO = WS_WFI + 4 * SZ_WFI, WS_WIN = WS_WFO + 4 * SZ_WFO, WS_WOUT = WS_WIN + 2 * SZ_WIN, WS_WQ = WS_WOUT + 2 * SZ_WOUT;
constexpr size_t WS_WKV = WS_WQ + 2 * SZ_WQ, WS_WWA = WS_WKV + 2 * SZ_WKV, WS_WG = WS_WWA + 2 * SZ_WWA, WS_ACT = WS_WG + 2 * SZ_WG;
constexpr size_t WS_X = WS_ACT;
constexpr size_t WS_XN = WS_X + al((size_t)MROWS * DM * 4);
constexpr size_t WS_H = WS_XN + al((size_t)MROWS * DM * 2);
constexpr size_t WS_Z = WS_H + al((size_t)MROWS * DFF * 2);
constexpr size_t WS_SS = WS_Z + al((size_t)MROWS * ZC * 4);
constexpr size_t WS_VV = WS_SS + al((size_t)MROWS * 4096 * 4);
constexpr size_t WS_KT = WS_VV + al((size_t)MROWS * 2048 * 4);
constexpr size_t WS_LW = WS_KT + al((size_t)MROWS * 2048 * 4);
constexpr size_t WS_LWA = WS_LW + al((size_t)MROWS * 10240 * 4);
constexpr size_t WS_LG = WS_LWA + al((size_t)MROWS * 512 * 2);
constexpr size_t WS_QL = WS_LG + al((size_t)MROWS * 256 * 2);
constexpr size_t WS_KVL = WS_QL + al((size_t)MROWS * 1024 * 2);
constexpr size_t WS_QF = WS_KVL + al((size_t)MROWS * 512 * 2);
constexpr size_t WS_KVF = WS_QF + al((size_t)MROWS * 3072 * 4);
#ifndef QB_GAP
#define QB_GAP 0
#endif
constexpr size_t WS_QB = WS_KVF + al((size_t)MROWS * 4096 * 4) + (size_t)QB_GAP * MiB;
constexpr size_t WS_KB = WS_QB + al((size_t)MROWS * 3072 * 2);
constexpr size_t WS_VB = WS_KB + al((size_t)MROWS * 3072 * 2);
constexpr size_t WS_Y = WS_VB + al((size_t)MROWS * 2048 * 2);
constexpr size_t WS_OC = WS_Y + al((size_t)2 * MROWS * 2048 * 4);
constexpr int SK_NS = 8;
constexpr size_t WS_ACC = WS_OC + al((size_t)MROWS * DM * 2);
constexpr size_t SZ_ACC = (size_t)CTXL * DM * 4;
constexpr size_t WS_SLB = WS_ACC + SK_NS * SZ_ACC;
constexpr size_t WS_END = WS_SLB + 32 * MiB;
constexpr int CW_BAR = 4096, CW_MIX = 8192;

enum { I_X = 0, I_C, I_CTX, I_CCTX, I_WMOD, I_BMOD, I_NORMG, I_FWI, I_FWO, I_WIN, I_WOUT, I_MU, I_W0, I_WUP, I_A0, I_AUP, I_GUP, I_KK, I_KA, I_RK, I_LNW, I_LNB,
       I_QNORM, I_QUP, I_KVNORM, I_KVUP, I_QGAIN, I_KGAIN, N_IN };

__device__ __forceinline__ int lane_vol() { int l; asm volatile("v_mbcnt_lo_u32_b32 %0, -1, 0\n\tv_mbcnt_hi_u32_b32 %0, -1, %0" : "=v"(l)); return l; }
__device__ __forceinline__ float wave_sum(float v) {
#pragma unroll
    for (int o = 1; o < 64; o <<= 1) v += __shfl_xor(v, o);
    return v;
}
__device__ __forceinline__ float sum16(float v) {
#pragma unroll
    for (int o = 1; o < 16; o <<= 1) v += __shfl_xor(v, o);
    return v;
}
__device__ __forceinline__ float sigm(float x) { return __builtin_amdgcn_rcpf(1.f + __builtin_amdgcn_exp2f(-1.4426950408889634f * x)); }
__device__ __forceinline__ float dot4(f32x4 a, f32x4 b) { return (a.x * b.x + a.y * b.y) + (a.z * b.z + a.w * b.w); }
typedef unsigned u32x2 __attribute__((ext_vector_type(2)));
__device__ __forceinline__ f32x4 ubf4(u32x2 w) { f32x4 r; r.x = __uint_as_float(w.x << 16); r.y = __uint_as_float(w.x & 0xffff0000u); r.z = __uint_as_float(w.y << 16); r.w = __uint_as_float(w.y & 0xffff0000u); return r; }
__device__ __forceinline__ u32x2 pk4(f32x4 v) { u32x2 r; r.x = pg8::cvt_pk_bf16(v.x, v.y); r.y = pg8::cvt_pk_bf16(v.z, v.w); return r; }

struct EpiSwiGLU {
    static constexpr bool PERM = true, AFTER_DRAIN = false;
    bf16* H;
    __device__ __forceinline__ void operator()(const pg8::f32x4 (&acc)[2][2][4][2], const pg8::Unit& u, int wr, int wc, int fr, int fq) const {
        const int row0 = u.pm * 256 + wr * 64 + fr, col0 = u.pn * 128 + wc * 32 + 8 * fq;
#pragma unroll
        for (int ai = 0; ai < 2; ++ai)
#pragma unroll
            for (int m = 0; m < 4; ++m) {
                bf16* rowp = H + (size_t)(row0 + ai * 128 + m * 16) * DFF + col0;
                const pg8::f32x4 g0 = acc[ai][0][m][0], g1 = acc[ai][0][m][1], u0 = acc[ai][1][m][0], u1 = acc[ai][1][m][1];
                pg8::u32x4 w;
                w.x = pg8::cvt_pk_bf16(g0[0] * sigm(g0[0]) * u0[0], g0[1] * sigm(g0[1]) * u0[1]);
                w.y = pg8::cvt_pk_bf16(g0[2] * sigm(g0[2]) * u0[2], g0[3] * sigm(g0[3]) * u0[3]);
                w.z = pg8::cvt_pk_bf16(g1[0] * sigm(g1[0]) * u1[0], g1[1] * sigm(g1[1]) * u1[1]);
                w.w = pg8::cvt_pk_bf16(g1[2] * sigm(g1[2]) * u1[2], g1[3] * sigm(g1[3]) * u1[3]);
                *(pg8::u32x4*)rowp = w;
            }
    }
};
struct EpiRes {
    static constexpr bool PERM = false, AFTER_DRAIN = false;
    const float* inL; const float* inC; float* outL; float* outC; const float* gateL; const float* gateC; float coef;
    __device__ __forceinline__ void operator()(const pg8::f32x4 (&acc)[2][2][4][2], const pg8::Unit& u, int wr, int wc, int fr, int fq) const {
        const bool lat = u.pm < 32;
        const int rl0 = (lat ? u.pm : u.pm - 32) * 256 + wr * 64 + fr, col0 = u.pn * 256 + wc * 32 + 4 * fq;
        const float* in = lat ? inL : inC; float* out = lat ? outL : outC; const float* gate = lat ? gateL : gateC;
        pg8::f32x4 gv[2][2];
#pragma unroll
        for (int bj = 0; bj < 2; ++bj)
#pragma unroll
            for (int n = 0; n < 2; ++n) gv[bj][n] = *(const pg8::f32x4*)(gate + col0 + bj * 128 + n * 16) * coef;
#pragma unroll
        for (int ai = 0; ai < 2; ++ai)
#pragma unroll
            for (int m = 0; m < 4; ++m) {
                const size_t off = (size_t)(rl0 + ai * 128 + m * 16) * DM + col0;
#pragma unroll
                for (int bj = 0; bj < 2; ++bj)
#pragma unroll
                    for (int n = 0; n < 2; ++n) { const pg8::f32x4 xi = *(const pg8::f32x4*)(in + off + bj * 128 + n * 16);
                        *(pg8::f32x4*)(out + off + bj * 128 + n * 16) = xi + gv[bj][n] * acc[ai][bj][m][n]; }
            }
    }
};
struct EpiSlab {
    static constexpr bool PERM = false, AFTER_DRAIN = false;
    float* out; const float* gate; float coef;
    __device__ __forceinline__ void operator()(const pg8::f32x4 (&acc)[2][2][4][2], const pg8::Unit& u, int wr, int wc, int fr, int fq) const {
        const int rl0 = wr * 64 + fr, col0 = u.pn * 256 + wc * 32 + 4 * fq;
        float* o = out + (size_t)u.pm * CTXL * DM;
        pg8::f32x4 gv[2][2];
#pragma unroll
        for (int bj = 0; bj < 2; ++bj)
#pragma unroll
            for (int n = 0; n < 2; ++n) gv[bj][n] = *(const pg8::f32x4*)(gate + col0 + bj * 128 + n * 16) * coef;
#pragma unroll
        for (int ai = 0; ai < 2; ++ai)
#pragma unroll
            for (int m = 0; m < 4; ++m) {
                const size_t off = (size_t)(rl0 + ai * 128 + m * 16) * DM + col0;
#pragma unroll
                for (int bj = 0; bj < 2; ++bj)
#pragma unroll
                    for (int n = 0; n < 2; ++n) *(pg8::f32x4*)(o + off + bj * 128 + n * 16) = gv[bj][n] * acc[ai][bj][m][n];
            }
    }
};
struct EpiB16 {
    static constexpr bool PERM = true, AFTER_DRAIN = false;
    bf16* C; int ldc;
    __device__ __forceinline__ void operator()(const pg8::f32x4 (&acc)[2][2][4][2], const pg8::Unit& u, int wr, int wc, int fr, int fq) const {
        const int row0 = u.pm * 256 + wr * 64 + fr, col0 = u.pn * 256 + wc * 32 + 8 * fq;
#pragma unroll
        for (int ai = 0; ai < 2; ++ai)
#pragma unroll
            for (int m = 0; m < 4; ++m) { bf16* rowp = C + (size_t)(row0 + ai * 128 + m * 16) * ldc + col0;
#pragma unroll
                for (int bj = 0; bj < 2; ++bj) { const pg8::f32x4 v0 = acc[ai][bj][m][0], v1 = acc[ai][bj][m][1]; pg8::u32x4 w;
                    w.x = pg8::cvt_pk_bf16(v0[0], v0[1]); w.y = pg8::cvt_pk_bf16(v0[2], v0[3]); w.z = pg8::cvt_pk_bf16(v1[0], v1[1]); w.w = pg8::cvt_pk_bf16(v1[2], v1[3]);
                    *(pg8::u32x4*)(rowp + bj * 128) = w; } }
    }
};
struct EpiSlabP {
    static constexpr bool PERM = true, AFTER_DRAIN = false;
    float* out; int ldo;
    __device__ __forceinline__ void operator()(const pg8::f32x4 (&acc)[2][2][4][2], const pg8::Unit& u, int wr, int wc, int fr, int fq) const {
        const int row0 = wr * 64 + fr, col0 = u.pn * 256 + wc * 32 + 8 * fq;
        float* o = out + (size_t)u.pm * CTXL * ldo;
#pragma unroll
        for (int ai = 0; ai < 2; ++ai)
#pragma unroll
            for (int m = 0; m < 4; ++m) { float* rowp = o + (size_t)(row0 + ai * 128 + m * 16) * ldo + col0;
#pragma unroll
                for (int bj = 0; bj < 2; ++bj) { *(pg8::f32x4*)(rowp + bj * 128) = acc[ai][bj][m][0]; *(pg8::f32x4*)(rowp + bj * 128 + 4) = acc[ai][bj][m][1]; } }
    }
};
struct EpiF32 {
    static constexpr bool PERM = false, AFTER_DRAIN = false;
    float* C; int ldc;
    __device__ __forceinline__ void operator()(const pg8::f32x4 (&acc)[2][2][4][2], const pg8::Unit& u, int wr, int wc, int fr, int fq) const {
        const int row0 = u.pm * 256 + wr * 64 + fr, col0 = u.pn * 256 + wc * 32 + 4 * fq;
#pragma unroll
        for (int ai = 0; ai < 2; ++ai)
#pragma unroll
            for (int m = 0; m < 4; ++m) { float* rowp = C + (size_t)(row0 + ai * 128 + m * 16) * ldc + col0;
#pragma unroll
                for (int bj = 0; bj < 2; ++bj)
#pragma unroll
                    for (int n = 0; n < 2; ++n) *(pg8::f32x4*)(rowp + bj * 128 + n * 16) = acc[ai][bj][m][n]; }
    }
};
template <int MAP> __device__ __forceinline__ int map_row(int n) {
    if (MAP == 1) { const int bj = n >> 13, r = n & 8191; return 256 * (r >> 7) + 128 * bj + (r & 127); }
    return n;
}
template <int MAP> __device__ __forceinline__ void transpose_item(const float* W, int K, int N, bf16* WT, LAS float* scr, int item, int lane) {
    const int nblk = N >> 6, kb = item / nblk, nb = item - kb * nblk, k0 = kb * 64, n0 = nb * 64;
    const int kr = lane >> 4, nq = lane & 15;
    f32x4 v[16];
#pragma unroll
    for (int i = 0; i < 16; ++i) v[i] = *(const f32x4*)(W + (size_t)(k0 + 4 * i + kr) * N + n0 + 4 * nq);
#pragma unroll
    for (int i = 0; i < 16; ++i) { const int k = 4 * i + kr;
        scr[(4 * nq + 0) * 65 + k] = v[i].x; scr[(4 * nq + 1) * 65 + k] = v[i].y; scr[(4 * nq + 2) * 65 + k] = v[i].z; scr[(4 * nq + 3) * 65 + k] = v[i].w; }
    LDS_WAIT(); asm volatile("" ::: "memory");
    const int c = lane & 7, nl = lane >> 3, r0 = map_row<MAP>(n0);
#pragma unroll
    for (int j = 0; j < 8; ++j) { const int n = nl + 8 * j; const LAS float* s = scr + n * 65 + 8 * c;
        v4u o; o.x = pk2(s[0], s[1]); o.y = pk2(s[2], s[3]); o.z = pk2(s[4], s[5]); o.w = pk2(s[6], s[7]);
        *(v4u*)(WT + (size_t)(r0 + n) * K + k0 + 8 * c) = o; }
    LDS_WAIT(); asm volatile("" ::: "memory");
}

struct Ptrs {
    const float* in[N_IN]; float* out; unsigned char* ws;
};
constexpr int PT_OFF = 151552 + 1024;
__device__ __forceinline__ unsigned long long ld_uptr(LAS unsigned char* lds, int i) {
    const unsigned long long v = *(const LAS unsigned long long*)(lds + PT_OFF + 8 * i);
    const unsigned lo = __builtin_amdgcn_readfirstlane((unsigned)v), hi = __builtin_amdgcn_readfirstlane((unsigned)(v >> 32));
    return ((unsigned long long)hi << 32) | lo;
}
__device__ __forceinline__ Ptrs load_ptrs(LAS unsigned char* lds) {
    asm volatile("" ::: "memory");
    Ptrs P;
#pragma unroll
    for (int i = 0; i < N_IN; ++i) P.in[i] = (const float*)(const GAS float*)ld_uptr(lds, i);
    P.out = (float*)(GAS float*)ld_uptr(lds, N_IN); P.ws = (unsigned char*)(GAS unsigned char*)ld_uptr(lds, N_IN + 1);
    return P;
}

__device__ __forceinline__ void prologue_phase(LAS unsigned char* lds, int vcu, int G, int wave) {
    const Ptrs P = load_ptrs(lds); const int lane = lane_vol(), tid = wave * 64 + lane;
    unsigned char* ws = P.ws;
    {
        LAS float* sil = (LAS float*)lds; LAS float* red = (LAS float*)(lds + 32768);
        for (int i = tid; i < DM; i += NTHR) { const float a = P.in[I_C][i], b = P.in[I_CCTX][i]; sil[i] = a * sigm(a); sil[DM + i] = b * sigm(b); }
        __syncthreads();
        float* MOD = (float*)(ws + WS_MOD);
        for (int u = vcu; u < (BG_CONV ? 2304 : 4608); u += G) {
            const int l = u / 2304, rem = u - l * 2304, nch = rem >> 4, ks = rem & 15;
            const float* W = P.in[I_WMOD] + (size_t)l * DM * NMODC + (size_t)(ks * 256 + wave * 32) * NMODC + nch * 256 + 4 * lane;
            f32x4 a0 = {0.f, 0.f, 0.f, 0.f}, a1 = {0.f, 0.f, 0.f, 0.f};
#pragma unroll
            for (int hb = 0; hb < 2; ++hb) {
                f32x4 wv[16];
#pragma unroll
                for (int kk = 0; kk < 16; ++kk) wv[kk] = *(const f32x4*)(W + (size_t)(hb * 16 + kk) * NMODC);
#pragma unroll
                for (int kk = 0; kk < 16; ++kk) { const int k = ks * 256 + wave * 32 + hb * 16 + kk; const float s0 = sil[k], s1 = sil[DM + k]; a0 += wv[kk] * s0; a1 += wv[kk] * s1; }
            }
            *(LAS f32x4*)(red + wave * 512 + 4 * lane) = a0; *(LAS f32x4*)(red + wave * 512 + 256 + 4 * lane) = a1;
            __syncthreads();
            { const int w = tid >> 8, col = tid & 255; float s = 0.f;
#pragma unroll
              for (int q = 0; q < 8; ++q) s += red[q * 512 + w * 256 + col];
              if (ks == 0) s += P.in[I_BMOD][l * NMODC + nch * 256 + col];
              atomicAdd(MOD + (size_t)(l * 2 + w) * NMODC + nch * 256 + col, s); }
            __syncthreads();
        }
    }
    {
        LAS float* scr = (LAS float*)(lds + wave * 16640);
        const int gw = vcu * NWAVES + wave, NGW = G * NWAVES;
        constexpr int I_FI = 64 * 256, I_FO = 128 * 64, I_IN = 64 * 128, I_OUT = 64 * 64, I_Q = 16 * 48, I_KV = 8 * 64;
        constexpr int PER_L = 2 * I_FI + 2 * I_FO + I_IN + I_OUT + I_Q + I_KV;
        for (int it = gw; it < (BG_CONV ? 1 : 2) * PER_L; it += NGW) {
            const int l = it / PER_L; int r = it - l * PER_L;
            if (r < 2 * I_FI) { const int f = r / I_FI; r -= f * I_FI;
                transpose_item<1>(P.in[I_FWI] + (size_t)(l * 2 + f) * DM * 16384, DM, 16384, (bf16*)(ws + WS_WFI + (size_t)(l * 2 + f) * SZ_WFI), scr, r, lane); continue; } r -= 2 * I_FI;
            if (r < 2 * I_FO) { const int f = r / I_FO; r -= f * I_FO;
                transpose_item<0>(P.in[I_FWO] + (size_t)(l * 2 + f) * DFF * DM, DFF, DM, (bf16*)(ws + WS_WFO + (size_t)(l * 2 + f) * SZ_WFO), scr, r, lane); continue; } r -= 2 * I_FO;
            if (r < I_IN) { transpose_item<0>(P.in[I_WIN] + (size_t)l * DM * ZC, DM, ZC, (bf16*)(ws + WS_WIN + (size_t)l * SZ_WIN), scr, r, lane); continue; } r -= I_IN;
            if (r < I_OUT) { transpose_item<0>(P.in[I_WOUT] + (size_t)l * DM * DM, DM, DM, (bf16*)(ws + WS_WOUT + (size_t)l * SZ_WOUT), scr, r, lane); continue; } r -= I_OUT;
            if (r < I_Q) { transpose_item<0>(P.in[I_QUP] + (size_t)l * 1024 * 3072, 1024, 3072, (bf16*)(ws + WS_WQ + (size_t)l * SZ_WQ), scr, r, lane); continue; } r -= I_Q;
            transpose_item<0>(P.in[I_KVUP] + (size_t)l * 512 * 4096, 512, 4096, (bf16*)(ws + WS_WKV + (size_t)l * SZ_WKV), scr, r, lane);
        }
        const int gt = vcu * NTHR + tid, NGT = G * NTHR;
        for (int it = gt; it < 2 * 10240 * 64; it += NGT) {
            const int l = it / (10240 * 64), r = it - l * (10240 * 64), k8 = r / 10240, n = r - k8 * 10240;
            float v[8];
            if (n < 8192) {
                const bool isA = n >= 4096; const int d = (n >> 11) & 1, ch = n & 2047;
                const float* src = (isA ? P.in[I_AUP] : P.in[I_WUP]) + (size_t)(l * 2 + d) * 96 * RWW + ch;
#pragma unroll
                for (int j = 0; j < 8; ++j) { const int k = 8 * k8 + j - (isA ? 96 : 0); const bool ok_ = (k >= 0 && k < 96); const float t_ = src[(size_t)(ok_ ? k : 0) * RWW]; v[j] = ok_ ? t_ : 0.f; }
            } else {
                const int ch = n - 8192; const float* src = P.in[I_GUP] + (size_t)l * 256 * RWW + ch;
#pragma unroll
                for (int j = 0; j < 8; ++j) { const int k = 8 * k8 + j - 256; const bool ok_ = (k >= 0); const float t_ = src[(size_t)(ok_ ? k : 0) * RWW]; v[j] = ok_ ? t_ : 0.f; }
            }
            v4u o; o.x = pk2(v[0], v[1]); o.y = pk2(v[2], v[3]); o.z = pk2(v[4], v[5]); o.w = pk2(v[6], v[7]);
            *(v4u*)((bf16*)(ws + WS_WWA + (size_t)l * SZ_WWA) + (size_t)n * 512 + 8 * k8) = o;
        }
    }
}

__device__ __forceinline__ void prep_phase(LAS unsigned char* lds, const float* srcL, const float* srcC, int nrows, const float* g, const float* modL, const float* modC, int jm,
                                           bf16* XN, int gw, int NGW, int wave, const float* accC = nullptr, float* wbC = nullptr) {
    int lane = lane_vol(); const int tid = wave * 64 + lane;
    LAS float* gsL = (LAS float*)lds; LAS float* shL = gsL + DM; LAS float* gsC = shL + DM; LAS float* shC = gsC + DM;
    for (int i = tid; i < DM; i += NTHR) { const float gg = g[i];
        gsL[i] = gg * (1.f + modL[(jm + 1) * DM + i]); shL[i] = modL[jm * DM + i]; gsC[i] = gg * (1.f + modC[(jm + 1) * DM + i]); shC[i] = modC[jm * DM + i]; }
    __syncthreads();
    for (int row = gw; row < (nrows < SEQ ? nrows : SEQ); row += NGW) {
        asm volatile("" : "+v"(lane));
        const bool lat = row < SEQ;
        const f32x4* xr = (const f32x4*)(lat ? srcL + (size_t)row * DM : srcC + (size_t)(row - SEQ) * DM) + lane;
        const LAS float* gs = lat ? gsL : gsC; const LAS float* sh = lat ? shL : shC;
        f32x4 v[16]; float ss = 0.f;
#pragma unroll
        for (int j = 0; j < 16; ++j) { v[j] = xr[64 * j]; ss += dot4(v[j], v[j]); }
        const float rstd = 1.0f / sqrtf(wave_sum(ss) * (1.f / DM) + 1e-6f);
        u32x2* o = (u32x2*)(XN + (size_t)row * DM) + lane;
#pragma unroll
        for (int j = 0; j < 16; ++j) { const int c = 4 * (lane + 64 * j); const f32x4 g4 = *(const LAS f32x4*)(gs + c), s4 = *(const LAS f32x4*)(sh + c);
            o[64 * j] = pk4(v[j] * rstd * g4 + s4); }
    }
    if (nrows > SEQ) {
        LAS float* red = (LAS float*)(lds + 65536);
        for (int s = gw >> 3; s < CTXL; s += NGW >> 3) {
            asm volatile("" : "+v"(lane));
            const int c0 = wave * 512 + 4 * lane;
            const float* xr = srcC + (size_t)s * DM + c0;
            f32x4 v0 = *(const f32x4*)xr, v1 = *(const f32x4*)(xr + 256);
            if (accC != nullptr) {
#pragma unroll
                for (int sl = 0; sl < SK_NS; ++sl) { const float* a = accC + ((size_t)sl * CTXL + s) * DM + c0; v0 += *(const f32x4*)a; v1 += *(const f32x4*)(a + 256); }
                *(f32x4*)(wbC + (size_t)s * DM + c0) = v0; *(f32x4*)(wbC + (size_t)s * DM + c0 + 256) = v1;
            }
            const float ssw = wave_sum(dot4(v0, v0) + dot4(v1, v1));
            __syncthreads();
            if (lane == 0) red[wave] = ssw;
            __syncthreads();
            float tot = 0.f;
#pragma unroll
            for (int w = 0; w < NWAVES; ++w) tot += red[w];
            const float rstd = 1.0f / sqrtf(tot * (1.f / DM) + 1e-6f);
            bf16* o = XN + (size_t)(SEQ + s) * DM + c0;
            *(u32x2*)o = pk4(v0 * rstd * *(const LAS f32x4*)(gsC + c0) + *(const LAS f32x4*)(shC + c0));
            *(u32x2*)(o + 256) = pk4(v1 * rstd * *(const LAS f32x4*)(gsC + c0 + 256) + *(const LAS f32x4*)(shC + c0 + 256));
        }
    }
    __syncthreads();
}

__device__ __forceinline__ void ctx_reduce_z(const Ptrs& P, int vcu, int G, int wave) {
    int lane = lane_vol(); unsigned char* ws = P.ws;
    const float* slab = (const float*)(ws + WS_SLB); bf16* Z = (bf16*)(ws + WS_Z);
    for (int s = vcu; s < CTXL; s += G) {
        asm volatile("" : "+v"(lane));
#pragma unroll
        for (int j = 0; j < 4; ++j) { const int c = wave * 1024 + 256 * j + 4 * lane; f32x4 a = {0.f, 0.f, 0.f, 0.f};
#pragma unroll
            for (int sl = 0; sl < 4; ++sl) a += *(const f32x4*)(slab + ((size_t)sl * CTXL + s) * ZC + c);
            *(u32x2*)(Z + (size_t)(SEQ + s) * ZC + c) = pk4(a); }
    }
}

__device__ __forceinline__ void streams_phase(const Ptrs& P, int l, int gw, int NGW) {
    int lane = lane_vol();
    unsigned char* ws = P.ws;
    const bf16* Z = (const bf16*)(ws + WS_Z); bf16* SS = (bf16*)(ws + WS_SS); bf16* VV = (bf16*)(ws + WS_VV); bf16* KT = (bf16*)(ws + WS_KT);
    bf16* LWA = (bf16*)(ws + WS_LWA); bf16* QL = (bf16*)(ws + WS_QL); bf16* KVL = (bf16*)(ws + WS_KVL);
    const float* mu = P.in[I_MU] + l * RWCOLS; const float* k_k = P.in[I_KK] + l * RWW; const float* qn = P.in[I_QNORM] + l * 1024; const float* kvn = P.in[I_KVNORM] + l * 512;
    for (int row = gw; row < MROWS; row += NGW) {
        asm volatile("" : "+v"(lane));
        int nb0, nb1, nb2, nb3; bool ok0, ok1, ok2, ok3;
        if (row < SEQ) { const int gr = row >> 6, gc = row & 63; nb0 = row - 1; ok0 = gc > 0; nb1 = row + 1; ok1 = gc < 63; nb2 = row - 64; ok2 = gr > 0; nb3 = row + 64; ok3 = gr < 127; }
        else { const int s = row - SEQ; nb0 = nb1 = row - 1; ok0 = ok1 = s > 0; nb2 = nb3 = row + 1; ok2 = ok3 = s < CTXL - 1; }
        const bf16* zr = Z + (size_t)row * ZC;
#define SEG_LOAD(sg, ZZ, ZN, MU) do { constexpr int i0_ = 8 * (sg), ni = ((sg) < 3) ? 8 : 2; \
            _Pragma("unroll") for (int ii = 0; ii < ni; ++ii) { const int i = i0_ + ii; const int c4 = lane + 64 * i; const bool act = (i < 25 || lane < 48); const int c = 4 * (act ? c4 : 0); \
                const int q = (c4 >= 412) + (c4 >= 824) + (c4 >= 1236); \
                const int nrow = q == 0 ? nb0 : q == 1 ? nb1 : q == 2 ? nb2 : nb3; const bool nok = q == 0 ? ok0 : q == 1 ? ok1 : q == 2 ? ok2 : ok3; \
                ZZ[ii] = *(const u32x2*)(zr + c); \
                u32x2 znr = *(const u32x2*)(Z + (size_t)(nok ? nrow : row) * ZC + c); if (!nok) { znr.x = 0u; znr.y = 0u; }     \
                ZN[ii] = znr; MU[ii] = *(const f32x4*)(mu + c); } } while (0)
#define SEG_PROC(sg, ZZ, ZN, MU) do { constexpr int i0_ = 8 * (sg), ni = ((sg) < 3) ? 8 : 2; \
            _Pragma("unroll") for (int ii = 0; ii < ni; ++ii) { const int i = i0_ + ii; const int c4 = lane + 64 * i, c = 4 * c4; \
              if (i < 25 || lane < 48) { \
                const f32x4 z = ubf4(ZZ[ii]); const f32x4 zn = ubf4(ZN[ii]); const f32x4 zs = z + (zn - z) * MU[ii]; \
                if (i < 8) { const int h = c >> 6, e = c & 63; *(u32x2*)(SS + ((size_t)(row * 32 + h) * 2) * 64 + e) = pk4(zs); } \
                else if (i < 16) { const int ch = c - 2048, h = ch >> 6, e = ch & 63; *(u32x2*)(KT + (size_t)row * RWW + ch) = pk4(zs); \
                    const f32x4 kr = zs * *(const f32x4*)(k_k + ch); const float ss = sum16(dot4(kr, kr)); const float inv = 1.f / fmaxf(sqrtf(ss), 1e-12f); \
                    *(u32x2*)(SS + ((size_t)(row * 32 + h) * 2 + 1) * 64 + e) = pk4(kr * inv); } \
                else if (i < 24) { *(u32x2*)(VV + (size_t)row * RWW + (c - 4096)) = pk4(zs); } \
                else if (i == 24) { \
                    if (lane < 24) { f32x4 t; _Pragma("unroll") for (int j = 0; j < 4; ++j) t[j] = 1.f - 2.f * __builtin_amdgcn_rcpf(1.f + __builtin_amdgcn_exp2f(2.885390081777927f * zs[j])); \
                        *(u32x2*)(LWA + (size_t)row * 512 + 4 * lane) = pk4(t); } \
                    else if (lane < 48) { *(u32x2*)(LWA + (size_t)row * 512 + 96 + 4 * (lane - 24)) = pk4(zs); } \
                    else { f32x4 t; _Pragma("unroll") for (int j = 0; j < 4; ++j) t[j] = sigm(zs[j]); \
                        *(u32x2*)(LWA + (size_t)row * 512 + 256 + 4 * (lane - 48)) = pk4(t); } \
                } else { f32x4 t; _Pragma("unroll") for (int j = 0; j < 4; ++j) t[j] = sigm(zs[j]); \
                    *(u32x2*)(LWA + (size_t)row * 512 + 256 + 64 + 4 * lane) = pk4(t); } \
              } } } while (0)
        u32x2 zzA[8], znA[8], zzB[8], znB[8]; f32x4 muA[8], muB[8]; f32x4 lq[4], lk[2];
        SEG_LOAD(0, zzA, znA, muA);
        SEG_LOAD(1, zzB, znB, muB); SEG_PROC(0, zzA, znA, muA);
        SEG_LOAD(2, zzA, znA, muA); SEG_PROC(1, zzB, znB, muB);
        SEG_LOAD(3, zzB, znB, muB); SEG_PROC(2, zzA, znA, muA);
#pragma unroll
        for (int j = 0; j < 4; ++j) lq[j] = ubf4(*(const u32x2*)(zr + RWCOLS + 4 * (lane + 64 * j)));
#pragma unroll
        for (int j = 0; j < 2; ++j) lk[j] = ubf4(*(const u32x2*)(zr + RWCOLS + 1024 + 4 * (lane + 64 * j)));
        SEG_PROC(3, zzB, znB, muB);
#undef SEG_LOAD
#undef SEG_PROC
        if (lane < 16) { unsigned z0 = 0u; asm volatile("" : "+v"(z0)); u32x2 zz; zz.x = z0; zz.y = z0; *(u32x2*)(LWA + (size_t)row * 512 + 192 + 4 * lane) = zz; }
        { f32x4 v[4]; float ss = 0.f;
#pragma unroll
          for (int j = 0; j < 4; ++j) { v[j] = lq[j]; ss += dot4(v[j], v[j]); }
          const float rstd = 1.0f / sqrtf(wave_sum(ss) * (1.f / 1024.f) + 1e-6f);
#pragma unroll
          for (int j = 0; j < 4; ++j) { const int c = 4 * (lane + 64 * j); *(u32x2*)(QL + (size_t)row * 1024 + c) = pk4(v[j] * rstd * *(const f32x4*)(qn + c)); } }
        { f32x4 v[2]; float ss = 0.f;
#pragma unroll
          for (int j = 0; j < 2; ++j) { v[j] = lk[j]; ss += dot4(v[j], v[j]); }
          const float rstd = 1.0f / sqrtf(wave_sum(ss) * (1.f / 512.f) + 1e-6f);
#pragma unroll
          for (int j = 0; j < 2; ++j) { const int c = 4 * (lane + 64 * j); *(u32x2*)(KVL + (size_t)row * 512 + c) = pk4(v[j] * rstd * *(const f32x4*)(kvn + c)); } }
    }
}

#ifndef QKN_ST
#define QKN_ST 1
#endif
#ifndef QKN_VST
#define QKN_VST 1
#endif
__device__ __forceinline__ void qknorm_phase(const Ptrs& P, int l, int gw, int NGW) {
    const int lane = lane_vol();
    unsigned char* ws = P.ws;
    const bf16* Z = (const bf16*)(ws + WS_Z); const bf16* QF = (const bf16*)(ws + WS_QF); const bf16* KVF = (const bf16*)(ws + WS_KVF);
    bf16* QB = (bf16*)(ws + WS_QB); bf16* KB = (bf16*)(ws + WS_KB); bf16* VB = (bf16*)(ws + WS_VB);
    const float* qg = P.in[I_QGAIN] + l * 192; const float* kg = P.in[I_KGAIN] + l * 192;
    const int lc = lane < 48 ? lane : 47, l32 = lane < 32 ? lane : 31;
    const f32x4 qg4 = *(const f32x4*)(qg + 4 * lc), kg4 = *(const f32x4*)(kg + 4 * lc);
    const int rl = lane - 32, ax = (rl >> 3) & 1, hf = (rl >> 2) & 1, f0 = 4 * (lane & 3);
    const bool rot = lane >= 32 && lane < 48;
    f32x4 invf;
#pragma unroll
    for (int j = 0; j < 4; ++j) invf[j] = exp2f(-(float)(f0 + j) * (13.287712379549449f / 16.f)) * 0.15915494309189535f;
    u32x2 nq_[4], nk_[4], nv_[4], nkr_;
#define QKN_LOAD(itx) do { const int row_ = (itx) >> 2, hq_ = ((itx) & 3) * 4; nkr_ = *(const u32x2*)(Z + (size_t)row_ * ZC + 8128 + 4 * (rot ? rl : 0)); \
        _Pragma("unroll") for (int hh = 0; hh < 4; ++hh) { const int h = hq_ + hh; nq_[hh] = *(const u32x2*)(QF + (size_t)row_ * 3072 + h * 192 + 4 * lc); \
            nk_[hh] = *(const u32x2*)(KVF + (size_t)row_ * 4096 + h * 256 + 4 * l32); nv_[hh] = *(const u32x2*)(KVF + (size_t)row_ * 4096 + h * 256 + 128 + 4 * l32); } } while (0)
    QKN_LOAD(gw < MROWS * 4 ? gw : 0);
    for (int it = gw; it < MROWS * 4; it += NGW) {
        const int row = it >> 2, h0 = (it & 3) * 4; const bool lat = row < SEQ;
        f32x4 cs = {1.f, 1.f, 1.f, 1.f}, sn = {0.f, 0.f, 0.f, 0.f};
        if (lat && rot) { const float pos = (float)(ax == 0 ? (row >> 6) : (row & 63));
#pragma unroll
            for (int j = 0; j < 4; ++j) { const float rev = pos * invf[j]; const float fr = rev - floorf(rev); cs[j] = __builtin_amdgcn_cosf(fr); sn[j] = __builtin_amdgcn_sinf(fr); } }
        u32x2 krr = nkr_; if (!rot) { krr.x = 0u; krr.y = 0u; }
        const f32x4 kr4 = ubf4(krr);
        const float ssr = wave_sum(rot ? dot4(kr4, kr4) : 0.f);
        u32x2 qq_[4], kq_[4], vv_[4];
#pragma unroll
        for (int hh = 0; hh < 4; ++hh) { qq_[hh] = nq_[hh]; kq_[hh] = nk_[hh]; vv_[hh] = nv_[hh]; }
        QKN_LOAD(it + NGW < MROWS * 4 ? it + NGW : it);
#pragma unroll
        for (int hh = 0; hh < 4; ++hh) {
            const int h = h0 + hh;
            u32x2 qq = qq_[hh]; if (lane >= 48) { qq.x = 0u; qq.y = 0u; }
            const f32x4 q4 = ubf4(qq);
            { const float ss = wave_sum(dot4(q4, q4)); const float rstd = 1.0f / sqrtf(ss * (1.f / 192.f) + 1e-6f);
              f32x4 x = q4 * rstd * qg4; f32x4 o;
#pragma unroll
              for (int j = 0; j < 4; ++j) o[j] = __shfl_xor(x[j], 4);
              if (lat && rot) { if (hf == 0) x = x * cs - o * sn; else x = o * sn + x * cs; }
              if (QKN_ST && lane < 48) *(u32x2*)(QB + (size_t)row * 3072 + h * 192 + 4 * lane) = pk4(x); }
            const u32x2 kq2 = kq_[hh];
            const f32x4 k4 = (lane < 32) ? ubf4(kq2) : kr4;
            { const float ss = wave_sum(lane < 32 ? dot4(k4, k4) : 0.f) + ssr; const float rstd = 1.0f / sqrtf(ss * (1.f / 192.f) + 1e-6f);
              f32x4 x = k4 * rstd * kg4; f32x4 o;
#pragma unroll
              for (int j = 0; j < 4; ++j) o[j] = __shfl_xor(x[j], 4);
              if (lat && rot) { if (hf == 0) x = x * cs - o * sn; else x = o * sn + x * cs; }
              if (QKN_ST && lane < 48) *(u32x2*)(KB + (size_t)row * 3072 + h * 192 + 4 * lane) = pk4(x); }
            { const u32x2 vv2 = vv_[hh]; if (QKN_VST && lane < 32) *(u32x2*)(VB + (size_t)row * 2048 + h * 128 + 4 * lane) = vv2; }
        }
    }
}

#undef QKN_LOAD
__device__ __forceinline__ void rwkvout_phase(const Ptrs& P, int l, int row0, int nrows, int gw, int NGW) {
    int lane = lane_vol();
    unsigned char* ws = P.ws;
    const float* Y = (const float*)(ws + WS_Y); const bf16* SS = (const bf16*)(ws + WS_SS); const bf16* LW = (const bf16*)(ws + WS_LW); const bf16* VV = (const bf16*)(ws + WS_VV);
    const bf16* KT = (const bf16*)(ws + WS_KT); bf16* OC = (bf16*)(ws + WS_OC);
    const float* lnw = P.in[I_LNW] + l * RWW; const float* lnb = P.in[I_LNB] + l * RWW; const float* rk = P.in[I_RK] + l * RWW;
    const float* a0 = P.in[I_A0] + (size_t)l * 2 * RWW; const float* k_a = P.in[I_KA] + (size_t)l * RWW;
    for (int row = row0 + gw; row < nrows; row += NGW) {
        asm volatile("" : "+v"(lane));
#define RO_LOAD(hb, YA, YB, R, A0, A1, KTv, VVv, Gv) do { _Pragma("unroll") for (int ii = 0; ii < 4; ++ii) { const int c = 4 * (lane + 64 * (4 * (hb) + ii)), h = c >> 6, e = c & 63; \
                YA[ii] = *(const f32x4*)(Y + (size_t)row * RWW + c); YB[ii] = *(const f32x4*)(Y + (size_t)(MROWS + row) * RWW + c); \
                R[ii] = *(const u32x2*)(SS + ((size_t)(row * 32 + h) * 2) * 64 + e); \
                A0[ii] = *(const u32x2*)(LW + (size_t)row * 10240 + 4096 + c); A1[ii] = *(const u32x2*)(LW + (size_t)row * 10240 + 6144 + c); \
                KTv[ii] = *(const u32x2*)(KT + (size_t)row * RWW + c); VVv[ii] = *(const u32x2*)(VV + (size_t)row * RWW + c); Gv[ii] = *(const u32x2*)(LW + (size_t)row * 10240 + 8192 + c); } } while (0)
#define RO_PROC(hb, YA, YB, R, A0, A1, KTv, VVv, Gv) do { _Pragma("unroll") for (int ii = 0; ii < 4; ++ii) { const int c = 4 * (lane + 64 * (4 * (hb) + ii)); \
                const f32x4 r4 = ubf4(R[ii]), v4 = ubf4(VVv[ii]); \
                  \
                const f32x4 al0 = ubf4(A0[ii]) + *(const f32x4*)(a0 + c), al1 = ubf4(A1[ii]) + *(const f32x4*)(a0 + RWW + c); \
                f32x4 am; _Pragma("unroll") for (int j = 0; j < 4; ++j) am[j] = 0.5f * (sigm(al0[j]) + sigm(al1[j])); \
                const f32x4 kdm = ubf4(KTv[ii]) * (1.f + (am - 1.f) * *(const f32x4*)(k_a + c)); \
                const float bs = sum16(dot4(r4 * kdm, *(const f32x4*)(rk + c))), c2s = 2.f * sum16(dot4(r4, kdm));     \
                const f32x4 y = YA[ii] + YB[ii] + v4 * c2s; \
                const float mean = sum16((y.x + y.y) + (y.z + y.w)) * (1.f / 64.f); \
                const f32x4 dlt = y - mean; const float var = sum16(dot4(dlt, dlt)) * (1.f / 64.f); \
                const float rstd = 1.0f / sqrtf(var + 64e-5f); \
                f32x4 o = dlt * rstd * *(const f32x4*)(lnw + c) + *(const f32x4*)(lnb + c); \
                o = (o + v4 * bs) * ubf4(Gv[ii]); \
                *(u32x2*)(OC + (size_t)row * DM + c) = pk4(o); } } while (0)
        f32x4 yaA[4], ybA[4], yaB[4], ybB[4]; u32x2 rA[4], a0A[4], a1A[4], ktA[4], vvA[4], gA[4], rB[4], a0B[4], a1B[4], ktB[4], vvB[4], gB[4];
        RO_LOAD(0, yaA, ybA, rA, a0A, a1A, ktA, vvA, gA);
        RO_LOAD(1, yaB, ybB, rB, a0B, a1B, ktB, vvB, gB);
        RO_PROC(0, yaA, ybA, rA, a0A, a1A, ktA, vvA, gA);
        RO_PROC(1, yaB, ybB, rB, a0B, a1B, ktB, vvB, gB);
#undef RO_LOAD
#undef RO_PROC
    }
}

constexpr int BGQ_FI = 512 * 256, BGQ_FO = 1024 * 64, BGQ_IN = 512 * 128, BGQ_OUT = 512 * 64, BGQ_Q = 128 * 48, BGQ_KV = 64 * 64;
constexpr int BGQ_TOTAL = 2 * BGQ_FI + 2 * BGQ_FO + BGQ_IN + BGQ_OUT + BGQ_Q + BGQ_KV;
constexpr int BGQ_PER_WAVE = BGQ_TOTAL / 512;
static_assert(BGQ_PER_WAVE * 512 == BGQ_TOTAL && BGQ_PER_WAVE % 4 == 0 && BGQ_PER_WAVE / 4 <= MROWS / 32, "background quanta per loader wave");
struct BgQ { const float* src; bf16* dst; int N; };
__device__ __forceinline__ BgQ bg_decode(const Ptrs& P, int t, int lane) {
    unsigned char* ws = P.ws; const float* W; bf16* WT; int K, N, map = 0; constexpr int l = 1;
    if (t < 2 * BGQ_FI) { const int f = t / BGQ_FI; t -= f * BGQ_FI; W = P.in[I_FWI] + (size_t)(l * 2 + f) * DM * 16384; WT = (bf16*)(ws + WS_WFI + (size_t)(l * 2 + f) * SZ_WFI); K = DM; N = 16384; map = 1; }
    else if ((t -= 2 * BGQ_FI) < 2 * BGQ_FO) { const int f = t / BGQ_FO; t -= f * BGQ_FO; W = P.in[I_FWO] + (size_t)(l * 2 + f) * DFF * DM; WT = (bf16*)(ws + WS_WFO + (size_t)(l * 2 + f) * SZ_WFO); K = DFF; N = DM; }
    else if ((t -= 2 * BGQ_FO) < BGQ_IN) { W = P.in[I_WIN] + (size_t)l * DM * ZC; WT = (bf16*)(ws + WS_WIN + (size_t)l * SZ_WIN); K = DM; N = ZC; }
    else if ((t -= BGQ_IN) < BGQ_OUT) { W = P.in[I_WOUT] + (size_t)l * DM * DM; WT = (bf16*)(ws + WS_WOUT + (size_t)l * SZ_WOUT); K = DM; N = DM; }
    else if ((t -= BGQ_OUT) < BGQ_Q) { W = P.in[I_QUP] + (size_t)l * 1024 * 3072; WT = (bf16*)(ws + WS_WQ + (size_t)l * SZ_WQ); K = 1024; N = 3072; }
    else { t -= BGQ_Q; W = P.in[I_KVUP] + (size_t)l * 512 * 4096; WT = (bf16*)(ws + WS_WKV + (size_t)l * SZ_WKV); K = 512; N = 4096; }
    const int nk8 = K >> 3, nq = t / nk8, kq = t - nq * nk8, n = 64 * nq + lane;
    const int row = map ? map_row<1>(n) : n;
    BgQ q; q.src = W + (size_t)(8 * kq) * N + n; q.dst = WT + (size_t)row * K + 8 * kq; q.N = N; return q;
}

template <int CTRL> __device__ __forceinline__ float dpp_add(float x) { return x + __int_as_float(__builtin_amdgcn_update_dpp(0, __float_as_int(x), CTRL, 0xf, 0xf, true)); }
__device__ __forceinline__ float red16(float x) { x = dpp_add<0xB1>(x); x = dpp_add<0x4E>(x); x = dpp_add<0x141>(x); x = dpp_add<0x140>(x); return x; }
constexpr int SCAN_TC = 32, SCAN_STEP_B = 1424, SCAN_BUF = SCAN_TC * SCAN_STEP_B;
__device__ __forceinline__ void scan_phase(const Ptrs& P, int l, LAS unsigned char* lds, int vcu, int wave) {
    const int lane = lane_vol();
    if (vcu >= 128) return;
    const int h = vcu >> 2, d = (vcu >> 1) & 1, half = vcu & 1;
    unsigned char* ws = P.ws;
    const bf16* LW = (const bf16*)(ws + WS_LW); const bf16* SS = (const bf16*)(ws + WS_SS); const bf16* VV = (const bf16*)(ws + WS_VV); const bf16* KT = (const bf16*)(ws + WS_KT); float* Y = (float*)(ws + WS_Y);
    LAS float* ybuf = (LAS float*)(lds + 2 * SCAN_BUF);
    constexpr int NCH = MROWS / SCAN_TC;
    typedef float f32x2s __attribute__((ext_vector_type(2)));
#define rowof(tau) (d == 0 ? ((tau) < CTXL ? SEQ + (tau) : (tau) - CTXL) : (MROWS - 1 - (tau)))
    if (wave >= 4) {
        const int tl = (wave - 4) * 64 + lane;
        const int le = 4 * (tl & 15);
        const float* cw = P.in[I_W0] + (size_t)(l * 2 + d) * RWW + h * 64 + le; const float* ca = P.in[I_A0] + (size_t)(l * 2 + d) * RWW + h * 64 + le; const float* ck = P.in[I_KA] + (size_t)l * RWW + h * 64 + le;
        const f32x4 bw = *(const f32x4*)cw, ba = *(const f32x4*)ca, ka = *(const f32x4*)ck;
        u32x2 sr[2][5]; u32x2 svr;
#define LD_CHUNK(ci) do { _Pragma("unroll") for (int j_ = 0; j_ < 2; ++j_) { const int ls_ = (tl >> 4) + 16 * j_; const int row_ = rowof((ci) * SCAN_TC + ls_); const bf16* lw_ = LW + (size_t)row_ * 10240 + d * RWW + h * 64 + le; \
            sr[j_][0] = *(const u32x2*)(lw_); sr[j_][1] = *(const u32x2*)(lw_ + 4096); sr[j_][2] = *(const u32x2*)(KT + (size_t)row_ * RWW + h * 64 + le); \
            sr[j_][3] = *(const u32x2*)(SS + ((size_t)(row_ * 32 + h) * 2 + 1) * 64 + le); sr[j_][4] = *(const u32x2*)(SS + ((size_t)(row_ * 32 + h) * 2) * 64 + le); } \
          { const int row2_ = rowof((ci) * SCAN_TC + (tl >> 3)); svr = *(const u32x2*)(VV + (size_t)row2_ * RWW + h * 64 + 32 * half + 4 * (tl & 7)); } } while (0)
#define ST_CHUNK(b) do { _Pragma("unroll") for (int j_ = 0; j_ < 2; ++j_) { const int ls_ = (tl >> 4) + 16 * j_; LAS unsigned char* rec_ = lds + (b) * SCAN_BUF + ls_ * SCAN_STEP_B + le * 4; f32x4 w_, kd_, kka_; \
            f32x4 st[5]; _Pragma("unroll") for (int v_ = 0; v_ < 5; ++v_) st[v_] = ubf4(sr[j_][v_]); \
            _Pragma("unroll") for (int q_ = 0; q_ < 4; ++q_) { w_[q_] = __builtin_amdgcn_exp2f(-0.60653065971263342f * 1.4426950408889634f * sigm(st[0][q_] + bw[q_])); \
                const float a_ = sigm(st[1][q_] + ba[q_]); kd_[q_] = st[2][q_] * (1.f + (a_ - 1.f) * ka[q_]); kka_[q_] = st[3][q_] * a_; } \
            const float c1_ = red16(dot4(kka_, st[4])); \
            *(LAS f32x4*)(rec_) = w_; *(LAS f32x4*)(rec_ + 256) = kd_; *(LAS f32x4*)(rec_ + 512) = kka_; *(LAS f32x4*)(rec_ + 768) = w_ * st[4] - st[3] * c1_; *(LAS f32x4*)(rec_ + 1024) = st[3]; } \
          *(LAS f32x4*)(lds + (b) * SCAN_BUF + (tl >> 3) * SCAN_STEP_B + 1280 + 16 * (tl & 7)) = ubf4(svr); } while (0)
#define Y_OUT(ci) do { const int s_ = tl >> 3, j_ = tl & 7; const int row_ = rowof((ci) * SCAN_TC + s_); \
            *(f32x4*)(Y + (size_t)(d * MROWS + row_) * RWW + h * 64 + 32 * half + 4 * j_) = *(const LAS f32x4*)(ybuf + ((ci) & 1) * 1024 + s_ * 32 + 4 * j_); } while (0)
        const bool bg_on = BG_CONV && (l == 0);
        const int bq0 = (vcu * 4 + (wave - 4)) * BGQ_PER_WAVE;
        float bgr[4][8]; bf16* bg_dst = nullptr;
#define BG_ISSUE(g) do { if (bg_on && (g) < BGQ_PER_WAVE / 4) { const BgQ b_ = bg_decode(P, bq0 + 4 * (g), lane); bg_dst = b_.dst; \
            _Pragma("unroll") for (int q_ = 0; q_ < 4; ++q_) _Pragma("unroll") for (int j_ = 0; j_ < 8; ++j_) bgr[q_][j_] = b_.src[(size_t)(8 * q_ + j_) * b_.N]; } } while (0)
#define BG_FLUSH(g) do { if (bg_on && (g) >= 0 && (g) < BGQ_PER_WAVE / 4) { _Pragma("unroll") for (int q_ = 0; q_ < 4; ++q_) { \
            v4u o_; o_.x = pg8::cvt_pk_bf16(bgr[q_][0], bgr[q_][1]); o_.y = pg8::cvt_pk_bf16(bgr[q_][2], bgr[q_][3]); o_.z = pg8::cvt_pk_bf16(bgr[q_][4], bgr[q_][5]); o_.w = pg8::cvt_pk_bf16(bgr[q_][6], bgr[q_][7]); \
            *(v4u*)(bg_dst + 8 * q_) = o_; } } } while (0)
        const int gv_lw = vcu * 4 + (wave - 4);
        f32x4 gvr[8]; f32x4 gva0 = {0.f, 0.f, 0.f, 0.f}, gva1 = {0.f, 0.f, 0.f, 0.f};
#define GV_ISSUE(g) do { if (bg_on && (g) < 144) { const int u_ = gv_lw + 512 * ((g) >> 4), nch_ = u_ >> 5, ks_ = u_ & 31; \
            const float* w_ = P.in[I_WMOD] + (size_t)DM * NMODC + (size_t)(128 * ks_ + 8 * ((g) & 15)) * NMODC + 256 * nch_ + 4 * lane; \
            _Pragma("unroll") for (int j_ = 0; j_ < 8; ++j_) gvr[j_] = *(const f32x4*)(w_ + (size_t)j_ * NMODC); } } while (0)
#define GV_ACC(g) do { if (bg_on && (g) >= 0 && (g) < 144) { const int u_ = gv_lw + 512 * ((g) >> 4), nch_ = u_ >> 5, ks_ = u_ & 31; const int k0_ = 128 * ks_ + 8 * ((g) & 15); \
            _Pragma("unroll") for (int j_ = 0; j_ < 8; ++j_) { const float a_ = P.in[I_C][k0_ + j_], b_ = P.in[I_CCTX][k0_ + j_]; gva0 += gvr[j_] * (a_ * sigm(a_)); gva1 += gvr[j_] * (b_ * sigm(b_)); } \
            if (((g) & 15) == 15) { float* mo_ = (float*)(ws + WS_MOD) + (size_t)2 * NMODC + 256 * nch_ + 4 * lane; \
                if (ks_ == 0) { const f32x4 bb_ = *(const f32x4*)(P.in[I_BMOD] + NMODC + 256 * nch_ + 4 * lane); gva0 += bb_; gva1 += bb_; } \
                _Pragma("unroll") for (int j_ = 0; j_ < 4; ++j_) { atomicAdd(mo_ + j_, gva0[j_]); atomicAdd(mo_ + NMODC + j_, gva1[j_]); } \
                gva0 = (f32x4){0.f, 0.f, 0.f, 0.f}; gva1 = (f32x4){0.f, 0.f, 0.f, 0.f}; } } } while (0)
        LD_CHUNK(0); ST_CHUNK(0); LD_CHUNK(1);
        __syncthreads();
        for (int ci = 0; ci < NCH; ++ci) {
            if (ci > 0) Y_OUT(ci - 1);
            if (ci + 1 < NCH) ST_CHUNK((ci + 1) & 1);
            BG_FLUSH(ci - 1); GV_ACC(ci - 1);
            if (ci + 2 < NCH) LD_CHUNK(ci + 2);
            BG_ISSUE(ci); GV_ISSUE(ci);
            __syncthreads();
        }
        Y_OUT(NCH - 1);
        BG_FLUSH(NCH - 1);
#undef GV_ISSUE
#undef GV_ACC
#undef BG_ISSUE
#undef BG_FLUSH
#undef LD_CHUNK
#undef ST_CHUNK
#undef Y_OUT
    } else {
        const int kc = lane & 7, rl = wave * 8 + (lane >> 3);
        f32x2s Sa = {0.f, 0.f}, Sb = {0.f, 0.f}, Sc = {0.f, 0.f}, Sd = {0.f, 0.f};
        __syncthreads();
        for (int ci = 0; ci < NCH; ++ci) {
            const LAS unsigned char* buf = lds + (ci & 1) * SCAN_BUF + kc * 32;
            const LAS unsigned char* vbuf = lds + (ci & 1) * SCAN_BUF + 1280 + rl * 4;
            float ys0 = 0.f, ys1 = 0.f, ys2 = 0.f, ys3 = 0.f;
#define LDV(dst0, dst1, off, sb_) dst0 = *(const LAS f32x4*)((sb_) + (off)); dst1 = *(const LAS f32x4*)((sb_) + (off) + 16)
            f32x4 w0, w1, d0, d1, a0, a1, r0, r1, k0, k1; float vv;
            LDV(w0, w1, 0, buf); LDV(d0, d1, 256, buf); LDV(a0, a1, 512, buf); LDV(r0, r1, 768, buf); LDV(k0, k1, 1024, buf); vv = *(const LAS float*)(vbuf);
#pragma unroll
            for (int s = 0; s < SCAN_TC; ++s) {
                f32x4 w0n = w0, w1n = w1, d0n = d0, d1n = d1, a0n = a0, a1n = a1, r0n = r0, r1n = r1, k0n = k0, k1n = k1; float vvn = vv;
                if (s + 1 < SCAN_TC) { const LAS unsigned char* sb = buf + (s + 1) * SCAN_STEP_B;
                    LDV(w0n, w1n, 0, sb); LDV(d0n, d1n, 256, sb); LDV(a0n, a1n, 512, sb); LDV(r0n, r1n, 768, sb); LDV(k0n, k1n, 1024, sb);
                    vvn = *(const LAS float*)(vbuf + (s + 1) * SCAN_STEP_B); }
#define LO(v) ((f32x2s){(v).x, (v).y})
#define HI(v) ((f32x2s){(v).z, (v).w})
                const f32x2s pa = (Sa * LO(k0) + Sb * HI(k0)) + (Sc * LO(k1) + Sd * HI(k1)), pb = (Sa * LO(r0) + Sb * HI(r0)) + (Sc * LO(r1) + Sd * HI(r1));
                float p1 = pa.x + pa.y, p2 = pb.x + pb.y;
                p1 = dpp_add<0xB1>(p1); p2 = dpp_add<0xB1>(p2); p1 = dpp_add<0x4E>(p1); p2 = dpp_add<0x4E>(p2); p1 = dpp_add<0x141>(p1); p2 = dpp_add<0x141>(p2);
                const float sk = p1, yv = p2;
                Sa = Sa * LO(w0) + (LO(d0) * vv - LO(a0) * sk); Sb = Sb * HI(w0) + (HI(d0) * vv - HI(a0) * sk);
                Sc = Sc * LO(w1) + (LO(d1) * vv - LO(a1) * sk); Sd = Sd * HI(w1) + (HI(d1) * vv - HI(a1) * sk);
                if ((s >> 3) == 0) ys0 = (kc == (s & 7)) ? yv : ys0; else if ((s >> 3) == 1) ys1 = (kc == (s & 7)) ? yv : ys1; else if ((s >> 3) == 2) ys2 = (kc == (s & 7)) ? yv : ys2; else ys3 = (kc == (s & 7)) ? yv : ys3;
                w0 = w0n; w1 = w1n; d0 = d0n; d1 = d1n; a0 = a0n; a1 = a1n; r0 = r0n; r1 = r1n; k0 = k0n; k1 = k1n; vv = vvn;
#undef LO
#undef HI
            }
#undef LDV
            LAS float* yb = ybuf + (ci & 1) * 1024;
            yb[kc * 32 + rl] = ys0; yb[(kc + 8) * 32 + rl] = ys1; yb[(kc + 16) * 32 + rl] = ys2; yb[(kc + 24) * 32 + rl] = ys3;
            __syncthreads();
        }
    }
#undef rowof
}

namespace att {
constexpr int NW = 8, QBLK = 32, KVBLK = 64;
constexpr float SCALE = 0.07216878364870322f;
constexpr float THR = 8.f;
constexpr int LDQ = 3072, LDKK = 3072, LDVV = 2048, LDO = 4096;
constexpr int SHM_V = KVBLK * 128 * 2, SHM_K = KVBLK * 400, SHM_QP = 256 * 208, SHM_ATTN = 2 * SHM_V + 2 * SHM_K + NW * 64 * 4 + SHM_QP;
using bf16x8 = __attribute__((ext_vector_type(8))) short;
using s16x4  = __attribute__((ext_vector_type(4))) short;
using f32x16 = __attribute__((ext_vector_type(16))) float;
using u32x4  = __attribute__((ext_vector_type(4))) unsigned;
#define KSWZ(row, colB) ((row) * 400 + (colB))
#define SBAR() __builtin_amdgcn_sched_barrier(0)
__device__ __forceinline__ int crow(int r, int hi) { return (r & 3) + 8 * (r >> 2) + 4 * hi; }
__device__ __forceinline__ unsigned cvtpk(float lo, float hi) { unsigned r; asm volatile("s_nop 0\n\tv_cvt_pk_bf16_f32 %0, %1, %2" : "=v"(r) : "v"(lo), "v"(hi)); return r; }
__device__ __forceinline__ void partialSM(f32x16& p0, f32x16& p1, float& m_reg, float& mn, float& alpha) {
  constexpr float C = SCALE * 1.4426950408889634f;
  float pmax = p0[0];
#pragma unroll
  for (int r = 1; r < 16; ++r) pmax = fmaxf(pmax, p0[r]);
#pragma unroll
  for (int r = 0; r < 16; ++r) pmax = fmaxf(pmax, p1[r]);
  { auto rr = __builtin_amdgcn_permlane32_swap(__float_as_uint(pmax), __float_as_uint(pmax), false, false);
    pmax = fmaxf(__uint_as_float(rr[0]), __uint_as_float(rr[1])); }
  if (__builtin_expect(__all(pmax - m_reg <= THR / SCALE), 1)) { mn = m_reg; alpha = 1.f; }
  else { mn = fmaxf(m_reg, pmax); alpha = __builtin_amdgcn_exp2f((m_reg - mn) * C); m_reg = mn; }
  float mnC = -mn * C;
#pragma unroll
  for (int r = 0; r < 16; ++r) p0[r] = fmaf(p0[r], C, mnC);
#pragma unroll
  for (int r = 0; r < 16; ++r) p1[r] = fmaf(p1[r], C, mnC);
#pragma unroll
  for (int r = 0; r < 16; ++r) p0[r] = __builtin_amdgcn_exp2f(p0[r]);
}
__device__ __forceinline__ void finishSM(f32x16& p0, f32x16& p1, float alpha, float& l_reg, bf16x8& pa0, bf16x8& pa1, bf16x8& pa2, bf16x8& pa3) {
#pragma unroll
  for (int r = 0; r < 16; ++r) p1[r] = __builtin_amdgcn_exp2f(p1[r]);
  float ps = 0;
#pragma unroll
  for (int r = 0; r < 16; ++r) ps += p0[r];
#pragma unroll
  for (int r = 0; r < 16; ++r) ps += p1[r];
  { auto rr = __builtin_amdgcn_permlane32_swap(__float_as_uint(ps), __float_as_uint(ps), false, false);
    ps = __uint_as_float(rr[0]) + __uint_as_float(rr[1]); }
  l_reg = l_reg * alpha + ps;
#define PK4(P, BASE, OUT) do { unsigned a0 = cvtpk(P[BASE + 0], P[BASE + 1]), a1 = cvtpk(P[BASE + 2], P[BASE + 3]);   \
    unsigned b0 = cvtpk(P[BASE + 4], P[BASE + 5]), b1 = cvtpk(P[BASE + 6], P[BASE + 7]);                              \
    auto r0 = __builtin_amdgcn_permlane32_swap(a0, b0, false, false); auto r1 = __builtin_amdgcn_permlane32_swap(a1, b1, false, false); \
    u32x4 w = {r0[0], r1[0], r0[1], r1[1]}; OUT = *reinterpret_cast<bf16x8*>(&w); } while (0)
  PK4(p0, 0, pa0); PK4(p0, 8, pa1); PK4(p1, 0, pa2); PK4(p1, 8, pa3);
#undef PK4
}
__device__ __forceinline__ void qkt(f32x16& p0, f32x16& p1, const char* Ks, const bf16x8* qr, const char* qpark, int r32, int hi) {
  p0 = f32x16{}; p1 = f32x16{};
#pragma unroll
  for (int d0 = 0; d0 < 12; ++d0) { int cb = (d0 * 16 + hi * 8) * 2;
    bf16x8 b0 = *reinterpret_cast<const bf16x8*>(Ks + KSWZ(r32, cb));
    bf16x8 b1 = *reinterpret_cast<const bf16x8*>(Ks + KSWZ(32 + r32, cb));
    const bf16x8 q = d0 < 6 ? qr[d0 < 6 ? d0 : 0] : *reinterpret_cast<const bf16x8*>(qpark + (d0 - 6) * 32);
    p0 = __builtin_amdgcn_mfma_f32_32x32x16_bf16(b0, q, p0, 0, 0, 0);
    p1 = __builtin_amdgcn_mfma_f32_32x32x16_bf16(b1, q, p1, 0, 0, 0); }
}
__device__ __forceinline__ int v_st(int k, int c) { const int kk = (k & ~0xC) | ((k & 4) << 1) | ((k & 8) >> 1); return ((kk >> 3) * 4 + (c >> 5)) * 512 + ((kk & 7) * 32 + (c & 31)) * 2; }
__device__ __forceinline__ int v_rd_base(int lane) { return ((lane & 3) << 3) | (((lane >> 2) & 3) << 6) | (((lane >> 4) & 1) << 5) | (((lane >> 5) & 1) << 8); }
constexpr int v_rd_off(int d0, int ks, int half) { return d0 * 512 + ks * 4096 + half * 2048; }
template <int OFF> __device__ __forceinline__ s16x4 tr_read(int vb) {
  s16x4 r; asm volatile("ds_read_b64_tr_b16 %0, %1 offset:%2" : "=&v"(r) : "v"(vb), "i"(OFF) : "memory"); return r;
}
template <int D0> __device__ __forceinline__ void pv_one(f32x16& od, int vb, bf16x8 pa0, bf16x8 pa1, bf16x8 pa2, bf16x8 pa3) {
  const s16x4 l0 = tr_read<v_rd_off(D0, 0, 0)>(vb), h0 = tr_read<v_rd_off(D0, 0, 1)>(vb), l1 = tr_read<v_rd_off(D0, 1, 0)>(vb), h1 = tr_read<v_rd_off(D0, 1, 1)>(vb);
  const s16x4 l2 = tr_read<v_rd_off(D0, 2, 0)>(vb), h2 = tr_read<v_rd_off(D0, 2, 1)>(vb), l3 = tr_read<v_rd_off(D0, 3, 0)>(vb), h3 = tr_read<v_rd_off(D0, 3, 1)>(vb);
  asm volatile("s_waitcnt lgkmcnt(0)" ::: "memory"); SBAR();
#define PK(L, H) (bf16x8){L[0], L[1], L[2], L[3], H[0], H[1], H[2], H[3]}
  od = __builtin_amdgcn_mfma_f32_32x32x16_bf16(pa0, PK(l0, h0), od, 0, 0, 0);
  od = __builtin_amdgcn_mfma_f32_32x32x16_bf16(pa1, PK(l1, h1), od, 0, 0, 0);
  od = __builtin_amdgcn_mfma_f32_32x32x16_bf16(pa2, PK(l2, h2), od, 0, 0, 0);
  od = __builtin_amdgcn_mfma_f32_32x32x16_bf16(pa3, PK(l3, h3), od, 0, 0, 0);
#undef PK
}
__device__ __forceinline__ void pv_d0(f32x16* o, int vb, bf16x8 pa0, bf16x8 pa1, bf16x8 pa2, bf16x8 pa3) {
  pv_one<0>(o[0], vb, pa0, pa1, pa2, pa3); pv_one<1>(o[1], vb, pa0, pa1, pa2, pa3); pv_one<2>(o[2], vb, pa0, pa1, pa2, pa3); pv_one<3>(o[3], vb, pa0, pa1, pa2, pa3);
}
__device__ __forceinline__ void attn_body(const unsigned short* __restrict__ Qb, const unsigned short* __restrict__ Kh, const unsigned short* __restrict__ Vh,
                                          unsigned short* __restrict__ Ob, int seq, char* lds, int wave_in) {
  int tid_o; asm volatile("v_mbcnt_lo_u32_b32 %0, -1, 0\n\tv_mbcnt_hi_u32_b32 %0, -1, %0" : "=v"(tid_o)); tid_o += wave_in * 64;
  const int tid = tid_o, wid = wave_in, lane = tid & 63, r32 = lane & 31, hi = lane >> 5;
  char* V_lds = lds; char* K_lds = lds + 2 * SHM_V;
  float* wsx = (float*)(lds + 2 * SHM_V + 2 * SHM_K) + wid * 64; float* li_l = wsx; float* al_l = wsx + 32;
  float m_reg = -1e30f, l_reg = 0; f32x16 o[4] = {}; bf16x8 qr[6];
  char* qpark = lds + 2 * SHM_V + 2 * SHM_K + NW * 64 * 4 + (wid * QBLK + r32) * 208 + hi * 16;
  const unsigned short* Qw = Qb + (long)(wid * QBLK + r32) * LDQ + hi * 8;
#pragma unroll
  for (int d0 = 0; d0 < 6; ++d0) qr[d0] = *reinterpret_cast<const bf16x8*>(Qw + d0 * 16);
#pragma unroll
  for (int d0 = 6; d0 < 12; ++d0) *reinterpret_cast<bf16x8*>(qpark + (d0 - 6) * 32) = *reinterpret_cast<const bf16x8*>(Qw + d0 * 16);
  const int sr = tid >> 4, sc = (tid & 15) * 8, vst0 = v_st(sr, sc), vst1 = v_st(32 + sr, sc);
  const int kr0 = tid / 24, kc0 = (tid % 24) * 8, kr1 = (tid + 512) / 24, kc1 = ((tid + 512) % 24) * 8, kr2 = (tid + 1024) / 24, kc2 = ((tid + 1024) % 24) * 8;
  const int vb0 = (int)(uintptr_t)V_lds + v_rd_base(lane);
  const unsigned ko0 = (unsigned)(kr0 * LDKK + kc0) * 2u, ko1 = (unsigned)(kr1 * LDKK + kc1) * 2u, ko2 = (unsigned)(kr2 * LDKK + kc2) * 2u;
  const unsigned vo0 = (unsigned)(sr * LDVV + sc) * 2u, vo1 = (unsigned)((32 + sr) * LDVV + sc) * 2u;
  const int kl0 = KSWZ(kr0, kc0 * 2), kl1 = KSWZ(kr1, kc1 * 2), kl2 = KSWZ(kr2, kc2 * 2);
  bf16x8 vs0, vs1, ks0, ks1, ks2;
#define SLOAD(k0) do { const char* kb_ = (const char*)Kh + (size_t)(k0) * (LDKK * 2); const char* vb_ = (const char*)Vh + (size_t)(k0) * (LDVV * 2); \
    vs0 = *reinterpret_cast<const bf16x8*>(vb_ + vo0); vs1 = *reinterpret_cast<const bf16x8*>(vb_ + vo1); \
    ks0 = *reinterpret_cast<const bf16x8*>(kb_ + ko0); ks1 = *reinterpret_cast<const bf16x8*>(kb_ + ko1); ks2 = *reinterpret_cast<const bf16x8*>(kb_ + ko2); } while (0)
#define SWRITE(b) do { *(bf16x8*)(V_lds + (b) * SHM_V + vst0) = vs0; *(bf16x8*)(V_lds + (b) * SHM_V + vst1) = vs1; \
    *(bf16x8*)(K_lds + (b) * SHM_K + kl0) = ks0; *(bf16x8*)(K_lds + (b) * SHM_K + kl1) = ks1; *(bf16x8*)(K_lds + (b) * SHM_K + kl2) = ks2; } while (0)
#define SWAIT() asm volatile("s_waitcnt vmcnt(0)" ::: "memory")
#define RESC(a) do { if (__any((a) < 1.f)) { if (hi == 0) al_l[r32] = (a); asm volatile("s_waitcnt lgkmcnt(0)" ::: "memory"); \
    _Pragma("unroll") for (int d = 0; d < 4; ++d) _Pragma("unroll") for (int r = 0; r < 16; ++r) o[d][r] *= al_l[crow(r, hi)]; } } while (0)
  f32x16 pA0, pA1, pB0, pB1; float mnA, mnB, alA, alB; bf16x8 pa0, pa1, pa2, pa3; const int NT = seq / KVBLK;
  __syncthreads();
  SLOAD(0); SWAIT(); SWRITE(0); __syncthreads();
  qkt(pA0, pA1, K_lds, qr, qpark, r32, hi); partialSM(pA0, pA1, m_reg, mnA, alA);
  SLOAD(KVBLK);
  SWAIT(); SWRITE(1); __syncthreads();
  for (int j = 1; j + 1 < NT; j += 2) {
    SBAR(); qkt(pB0, pB1, K_lds + SHM_K, qr, qpark, r32, hi);
    finishSM(pA0, pA1, alA, l_reg, pa0, pa1, pa2, pa3); SBAR();
    SLOAD((j + 1) * KVBLK); SBAR();
    pv_d0(o, vb0, pa0, pa1, pa2, pa3); partialSM(pB0, pB1, m_reg, mnB, alB);
    __syncthreads(); SWAIT(); SWRITE(0);
    RESC(alB); __syncthreads();
    SBAR(); qkt(pA0, pA1, K_lds, qr, qpark, r32, hi);
    finishSM(pB0, pB1, alB, l_reg, pa0, pa1, pa2, pa3); SBAR();
    SLOAD((j + 2) * KVBLK); SBAR();
    pv_d0(o, vb0 + SHM_V, pa0, pa1, pa2, pa3); partialSM(pA0, pA1, m_reg, mnA, alA);
    __syncthreads(); SWAIT(); SWRITE(1);
    RESC(alA); __syncthreads();
  }
  SBAR(); qkt(pB0, pB1, K_lds + SHM_K, qr, qpark, r32, hi);
  finishSM(pA0, pA1, alA, l_reg, pa0, pa1, pa2, pa3); SBAR();
  pv_d0(o, vb0, pa0, pa1, pa2, pa3); partialSM(pB0, pB1, m_reg, mnB, alB);
  __syncthreads(); RESC(alB);
  finishSM(pB0, pB1, alB, l_reg, pa0, pa1, pa2, pa3); SBAR();
  pv_d0(o, vb0 + SHM_V, pa0, pa1, pa2, pa3);
  if (hi == 0) li_l[r32] = l_reg; asm volatile("s_waitcnt lgkmcnt(0)" ::: "memory");
  float rli[16];
#pragma unroll
  for (int r = 0; r < 16; ++r) rli[r] = __builtin_amdgcn_rcpf(li_l[crow(r, hi)]);
  unsigned short* Ow = Ob + (long)(wid * QBLK) * LDO;
#pragma unroll
  for (int r = 0; r < 16; ++r) { int orow = crow(r, hi);
#pragma unroll
    for (int d0 = 0; d0 < 4; ++d0) Ow[(long)orow * LDO + d0 * 32 + r32] = (unsigned short)f2bf(o[d0][r] * rli[r]); }
#undef SLOAD
#undef SWRITE
#undef SWAIT
#undef RESC
}
#undef KSWZ
#undef SBAR
}

#ifndef DBG_STOP
#define DBG_STOP 1000
#endif
constexpr int PH_PER_LAYER = 15, NPHASE = 1 + 2 * PH_PER_LAYER, PH_COPY = NPHASE;
struct Args { const float* in[N_IN]; float* out; unsigned char* ws; int ph_lo, ph_hi; };

template <class Epi> __device__ __forceinline__ void run_gemm(LAS unsigned char* lds, const bf16* A, const bf16* Bt, int M, int N, int K, int G, const Epi& E, int wave, int cshift = 0) {
    asm volatile("" : "+s"(K));
    pg8::Gemm g{A, Bt, M, N, K, K, (size_t)256 * K * 2, (size_t)0}; pg8::StaticOrder S; S.init(M, N, G, (int)((blockIdx.x + (unsigned)cshift) % (unsigned)G));
    pg8::gemm_phase<Epi, pg8::StaticOrder, true, true>(lds, g, S, E, wave);
}

#ifndef SK_MASK
#define SK_MASK 15
#endif
#ifndef SK_DRY
#define SK_DRY 0
#endif
#ifndef PH7_BAL
#define PH7_BAL 1
#endif
#define SK_F1 ((SK_MASK) & 1)
#define SK_IN (((SK_MASK) >> 3) & 1)
#define SK_OP (((SK_MASK) >> 1) & 1)
#define SK_F2 (((SK_MASK) >> 2) & 1)
template <class Epi> __device__ __forceinline__ void run_gemm_sk(LAS unsigned char* lds, const bf16* A, const bf16* Bt, int ld, int N, int G, const Epi& E, int wave, int ns = SK_NS) {
    asm volatile("" : "+s"(ld));
    asm volatile("" : "+s"(ns)); int Ks = ld / ns; asm volatile("" : "+s"(Ks));
    pg8::Gemm g{A, Bt, ns * 256, N, Ks, ld, (size_t)Ks * 2, (size_t)Ks * 2}; pg8::StaticOrder S; S.init(ns * 256, N, G, (int)blockIdx.x);
    pg8::gemm_phase<Epi, pg8::StaticOrder, true, true>(lds, g, S, E, wave);
}
#define WSP(T, off) ((T*)(ws + (off)))

template <int PHSEL> __global__ void __launch_bounds__(NTHR, 2) fwd_kernel(Args args) {
    extern __shared__ __attribute__((aligned(16))) unsigned char lds_raw[];
    LAS unsigned char* lds = (LAS unsigned char*)lds_raw;
    const int wave = __builtin_amdgcn_readfirstlane((int)(threadIdx.x >> 6));
    const int G = gridDim.x; const int bx = blockIdx.x; const int vcu = (G % 8 == 0) ? (bx % 8) * (G / 8) + bx / 8 : bx;
    const int gw = vcu * NWAVES + wave, NGW = G * NWAVES;
    const int lo = args.ph_lo, hi = args.ph_hi;
    volatile LAS unsigned* MISC = (volatile LAS unsigned*)(lds + MISC_OFF);
    if (threadIdx.x < 64) MISC[threadIdx.x] = 0u;
    if (threadIdx.x == 0) {
        LAS unsigned long long* PT = (LAS unsigned long long*)(lds + PT_OFF);
#pragma unroll
        for (int i = 0; i < N_IN; ++i) PT[i] = (unsigned long long)args.in[i];
        PT[N_IN] = (unsigned long long)args.out; PT[N_IN + 1] = (unsigned long long)args.ws;
    }
    __syncthreads();
    XcdBarrier bar; bar.bar = (unsigned*)(args.ws + WS_CTL) + CW_BAR; bar.x = 0; bar.st = nullptr;
    if (hi - lo > 1) bar = xcd_barrier_post((unsigned*)(args.ws + WS_CTL) + CW_BAR, MISC + 8);
    bar.wave = wave;
#ifndef PH_MASK
#define PH_MASK 0xFFFFF
#endif
#ifndef DBG_REP
#define DBG_REP -1
#endif
#define REPS(j) ((DBG_REP == (j)) ? 2 : 1)
#define EN(j) ((((PH_MASK) >> (j)) & 1) && (PHSEL < 0 || PHSEL == ((j) >= 16 ? 7 : (j))))
#define IN(k) (lo <= (k) && (k) < hi && (k) <= DBG_STOP)
#define SEAM(k) do { if (lo <= (k) && (k) + 1 < hi) { asm volatile("" ::: "memory"); XcdBarrier bb_ = bar; bb_.bar = (unsigned*)((GAS unsigned char*)ld_uptr(lds, N_IN + 1) + WS_CTL) + CW_BAR; xcd_barrier(bb_); if (bx == 0) TSW(k); } } while (0)
#ifdef DBG_TS_A
#define TSW(id) do { if (wave == 0 && lane_vol() == 0) __hip_atomic_store((gu32*)((GAS unsigned char*)ld_uptr(lds, N_IN + 1) + WS_CTL) + 16384 + (id), (unsigned)__builtin_amdgcn_s_memrealtime(), RLX_AGENT); } while (0)
#else
#define TSW(id) do {} while (0)
#endif
#define PHASE_PTRS() const Ptrs P = load_ptrs(lds); unsigned char* ws = P.ws; const float* MOD = WSP(const float, WS_MOD); \
        const float* modL = MOD + (size_t)(l * 2 + 0) * NMODC; const float* modC = MOD + (size_t)(l * 2 + 1) * NMODC; float* X = WSP(float, WS_X); float* XC = X + (size_t)SEQ * DM; \
        (void)modL; (void)modC; (void)X; (void)XC

    if (bx == 0) TSW(62);
    if (EN(0) && IN(0)) for (int rp = 0; rp < REPS(0); ++rp) prologue_phase(lds, vcu, G, wave);
    SEAM(0);

    for (int l = 0; l < 2; ++l) {
        const int pb = 1 + PH_PER_LAYER * l;
        const bool last = (l == 1);
        const int nrows2 = last ? SEQ : MROWS;
        if (EN(1) && IN(pb + 0)) for (int rp = 0; rp < REPS(1); ++rp) { PHASE_PTRS(); const float* x0L = (l == 0) ? P.in[I_X] : X; const float* x0C = (l == 0) ? P.in[I_CTX] : XC;
            prep_phase(lds, x0L, x0C, MROWS, P.in[I_NORMG] + (size_t)(l * 3 + 0) * DM, modL, modC, 0, WSP(bf16, WS_XN), gw, NGW, wave, SK_F2 && l == 1 ? WSP(const float, WS_ACC) : nullptr, XC); }
        SEAM(pb + 0);
        if (EN(2) && IN(pb + 1)) for (int rp = 0; rp < REPS(2); ++rp) { PHASE_PTRS(); EpiSwiGLU E{WSP(bf16, WS_H)}; run_gemm(lds, WSP(const bf16, WS_XN), WSP(const bf16, WS_WFI + (size_t)(l * 2 + 0) * SZ_WFI), MROWS, 16384, DM, G, E, wave); }
        SEAM(pb + 1);
        if (EN(3) && IN(pb + 2)) { PHASE_PTRS(); const float* x0L = (l == 0) ? P.in[I_X] : X; const float* x0C = (l == 0) ? P.in[I_CTX] : XC;
            EpiRes E{x0L, x0C, X, XC, modL + 2 * DM, modC + 2 * DM, 0.5f}; run_gemm(lds, WSP(const bf16, WS_H), WSP(const bf16, WS_WFO + (size_t)(l * 2 + 0) * SZ_WFO), (SK_F1 && !SK_DRY) ? SEQ : MROWS, DM, DFF, G, E, wave);
            if (SK_F1) { EpiSlab EA{WSP(float, WS_ACC), modC + 2 * DM, 0.5f};
#if SK_DRY == 2
            run_gemm(lds, WSP(const bf16, WS_H) + (size_t)SEQ * DFF, WSP(const bf16, WS_WFO + (size_t)(l * 2 + 0) * SZ_WFO), 256, DM, DFF, G, EA, wave); } }
#else
            run_gemm_sk(lds, WSP(const bf16, WS_H) + (size_t)SEQ * DFF, WSP(const bf16, WS_WFO + (size_t)(l * 2 + 0) * SZ_WFO), DFF, DM, G, EA, wave); } }
#endif
        SEAM(pb + 2);
        if (EN(4) && IN(pb + 3)) for (int rp = 0; rp < REPS(4); ++rp) { PHASE_PTRS(); prep_phase(lds, X, (SK_F1 && !SK_DRY && l == 0) ? P.in[I_CTX] : XC, MROWS, P.in[I_NORMG] + (size_t)(l * 3 + 1) * DM, modL, modC, 3, WSP(bf16, WS_XN), gw, NGW, wave, (SK_F1 && !SK_DRY) ? WSP(const float, WS_ACC) : nullptr, XC); }
        SEAM(pb + 3);
        if (EN(5) && IN(pb + 4)) for (int rp = 0; rp < REPS(5); ++rp) { PHASE_PTRS();
            EpiB16 E{WSP(bf16, WS_Z), ZC}; run_gemm(lds, WSP(const bf16, WS_XN), WSP(const bf16, WS_WIN + (size_t)l * SZ_WIN), SK_IN ? SEQ : MROWS, ZC, DM, G, E, wave);
            if (SK_IN) { EpiSlabP ES{WSP(float, WS_SLB), ZC}; run_gemm_sk(lds, WSP(const bf16, WS_XN) + (size_t)SEQ * DM, WSP(const bf16, WS_WIN + (size_t)l * SZ_WIN), DM, ZC, G, ES, wave, 4); } }
        SEAM(pb + 4);
        if (EN(6) && IN(pb + 5)) { if (SK_IN) { { PHASE_PTRS(); ctx_reduce_z(P, vcu, G, wave); } SEAM(pb + 4); } PHASE_PTRS(); streams_phase(P, l, gw, NGW); }
        SEAM(pb + 5);
        if (EN(7) && IN(pb + 6)) {
#if PH7_BAL
            if (EN(16)) { PHASE_PTRS(); EpiB16 E{WSP(bf16, WS_LW), 10240}; run_gemm(lds, WSP(const bf16, WS_LWA), WSP(const bf16, WS_WWA + (size_t)l * SZ_WWA), SEQ, 10240, 512, G, E, wave); }
            if (EN(19)) { PHASE_PTRS(); EpiB16 E{WSP(bf16, WS_KVF), 4096}; run_gemm(lds, WSP(const bf16, WS_KVL), WSP(const bf16, WS_WKV + (size_t)l * SZ_WKV), SEQ, 4096, 512, G, E, wave); }
            if (EN(18)) { PHASE_PTRS(); EpiB16 E{WSP(bf16, WS_QF), 3072}; run_gemm(lds, WSP(const bf16, WS_QL), WSP(const bf16, WS_WQ + (size_t)l * SZ_WQ), SEQ, 3072, 1024, G, E, wave); }
            if (EN(16)) { PHASE_PTRS(); EpiB16 E{WSP(bf16, WS_LW) + (size_t)SEQ * 10240, 10240}; run_gemm(lds, WSP(const bf16, WS_LWA) + (size_t)SEQ * 512, WSP(const bf16, WS_WWA + (size_t)l * SZ_WWA), CTXL, 10240, 512, G, E, wave, 128); }
            if (EN(18)) { PHASE_PTRS(); EpiB16 E{WSP(bf16, WS_QF) + (size_t)SEQ * 3072, 3072}; run_gemm(lds, WSP(const bf16, WS_QL) + (size_t)SEQ * 1024, WSP(const bf16, WS_WQ + (size_t)l * SZ_WQ), CTXL, 3072, 1024, G, E, wave, 88); }
            if (EN(19)) { PHASE_PTRS(); EpiB16 E{WSP(bf16, WS_KVF) + (size_t)SEQ * 4096, 4096}; run_gemm(lds, WSP(const bf16, WS_KVL) + (size_t)SEQ * 512, WSP(const bf16, WS_WKV + (size_t)l * SZ_WKV), CTXL, 4096, 512, G, E, wave, 72); }
#else
            if (EN(16)) { PHASE_PTRS(); EpiB16 E{WSP(bf16, WS_LW), 10240}; run_gemm(lds, WSP(const bf16, WS_LWA), WSP(const bf16, WS_WWA + (size_t)l * SZ_WWA), MROWS, 10240, 512, G, E, wave); }
            if (EN(18)) { PHASE_PTRS(); EpiB16 E{WSP(bf16, WS_QF), 3072}; run_gemm(lds, WSP(const bf16, WS_QL), WSP(const bf16, WS_WQ + (size_t)l * SZ_WQ), MROWS, 3072, 1024, G, E, wave); }
            if (EN(19)) { PHASE_PTRS(); EpiB16 E{WSP(bf16, WS_KVF), 4096}; run_gemm(lds, WSP(const bf16, WS_KVL), WSP(const bf16, WS_WKV + (size_t)l * SZ_WKV), MROWS, 4096, 512, G, E, wave); }
#endif
        }
        SEAM(pb + 6);
        if (EN(9) && IN(pb + 8)) {
            PHASE_PTRS();
            gu32* ctlw = (gu32*)(ws + WS_CTL);
            gu32* qk_done = ctlw + CW_MIX + 64 * l; gu32* q_head = ctlw + CW_MIX + 64 * (2 + l); gu32* tmo = ctlw + CW_MIX + 64 * 4;
            gu32* scan_done = ctlw + CW_MIX + 64 * (5 + l);
            if (vcu < 128) {
                scan_phase(P, l, lds, vcu, wave);
                if (bx == 0) TSW(40 + l);
                asm volatile("s_waitcnt vmcnt(0)" ::: "memory"); __syncthreads();
                if (wave == 0 && lane_vol() == 0) { __builtin_amdgcn_fence(__ATOMIC_RELEASE, "agent"); asm volatile("s_waitcnt vmcnt(0)" ::: "memory"); __hip_atomic_fetch_add(scan_done, 1u, RLX_AGENT); }
            } else {
                qknorm_phase(P, l, (vcu - 128) * NWAVES + wave, 128 * NWAVES);
                if (vcu == 200) TSW(46 + l);
                asm volatile("s_waitcnt vmcnt(0)" ::: "memory"); __syncthreads();
                if (wave == 0 && lane_vol() == 0) { __builtin_amdgcn_fence(__ATOMIC_RELEASE, "agent"); asm volatile("s_waitcnt vmcnt(0)" ::: "memory"); __hip_atomic_fetch_add(qk_done, 1u, RLX_AGENT); }
            }
            if (wave == 0 && lane_vol() == 0) {
                unsigned sp = 0;
                while (__hip_atomic_load(qk_done, RLX_AGENT) < 128u) { __builtin_amdgcn_s_sleep(2); if (++sp > (1u << 22)) { __hip_atomic_store(tmo, 1u, RLX_AGENT); break; } }
                __builtin_amdgcn_fence(__ATOMIC_ACQUIRE, "agent"); asm volatile("s_waitcnt vmcnt(0)" ::: "memory");
            }
            __syncthreads();
            if (bx == 0) TSW(50 + l);
            const int nun = 512 + (last ? 0 : 16);
            const bf16* QB = WSP(const bf16, WS_QB); const bf16* KB = WSP(const bf16, WS_KB); const bf16* VB = WSP(const bf16, WS_VB); bf16* OC = WSP(bf16, WS_OC);
            bool scan_ok = false;
            for (;;) {
                if (wave == 0 && lane_vol() == 0) MISC[16] = __hip_atomic_fetch_add(q_head, 1u, RLX_AGENT);
                __syncthreads();
                const int u = (int)MISC[16];
                if (u >= nun) {
                    const int v = u - nun; if (v * 32 >= nrows2) break;
                    if (!scan_ok) {
                        if (wave == 0 && lane_vol() == 0) { unsigned sp = 0;
                            while (__hip_atomic_load(scan_done, RLX_AGENT) < 128u) { __builtin_amdgcn_s_sleep(2); if (++sp > (1u << 22)) { __hip_atomic_store(tmo, 1u, RLX_AGENT); break; } }
                            __builtin_amdgcn_fence(__ATOMIC_ACQUIRE, "agent"); asm volatile("s_waitcnt vmcnt(0)" ::: "memory"); }
                        __syncthreads(); scan_ok = true;
                    }
                    rwkvout_phase(P, l, v * 32, v * 32 + 32, wave, NWAVES);
                    __syncthreads();
                    continue;
                }
                int h, q0, key0, nk;
                if (u < 512) { h = u >> 5; q0 = (u & 31) * 256; key0 = 0; nk = MROWS; } else { h = u - 512; q0 = SEQ; key0 = SEQ; nk = CTXL; }
                att::attn_body(QB + (size_t)q0 * 3072 + h * 192, KB + (size_t)key0 * 3072 + h * 192, VB + (size_t)key0 * 2048 + h * 128, OC + (size_t)q0 * DM + 2048 + h * 128, nk, (char*)lds_raw, wave);
                __syncthreads();
            }
            __syncthreads();
            if (bx == 0) TSW(44 + l); if (vcu == 200) TSW(48 + l);
        }
        SEAM(pb + 8);
        if (EN(12) && IN(pb + 11)) { PHASE_PTRS(); EpiRes E{X, XC, X, XC, modL + 5 * DM, modC + 5 * DM, 1.0f}; run_gemm(lds, WSP(const bf16, WS_OC), WSP(const bf16, WS_WOUT + (size_t)l * SZ_WOUT), SK_OP ? SEQ : nrows2, DM, DM, G, E, wave);
            if (SK_OP && !last) { EpiSlab EA{WSP(float, WS_ACC), modC + 5 * DM, 1.0f}; run_gemm_sk(lds, WSP(const bf16, WS_OC) + (size_t)SEQ * DM, WSP(const bf16, WS_WOUT + (size_t)l * SZ_WOUT), DM, DM, G, EA, wave); } }
        SEAM(pb + 11);
        if (EN(13) && IN(pb + 12)) for (int rp = 0; rp < REPS(13); ++rp) { PHASE_PTRS(); prep_phase(lds, X, XC, nrows2, P.in[I_NORMG] + (size_t)(l * 3 + 2) * DM, modL, modC, 6, WSP(bf16, WS_XN), gw, NGW, wave, (SK_OP && !last) ? WSP(const float, WS_ACC) : nullptr, XC); }
        SEAM(pb + 12);
        if (EN(14) && IN(pb + 13)) for (int rp = 0; rp < REPS(14); ++rp) { PHASE_PTRS(); EpiSwiGLU E{WSP(bf16, WS_H)}; run_gemm(lds, WSP(const bf16, WS_XN), WSP(const bf16, WS_WFI + (size_t)(l * 2 + 1) * SZ_WFI), nrows2, 16384, DM, G, E, wave); }
        SEAM(pb + 13);
        if (EN(15) && IN(pb + 14)) { PHASE_PTRS(); float* oL = last ? P.out : X;
            EpiRes E{X, XC, oL, XC, modL + 8 * DM, modC + 8 * DM, 0.5f}; run_gemm(lds, WSP(const bf16, WS_H), WSP(const bf16, WS_WFO + (size_t)(l * 2 + 1) * SZ_WFO), SK_F2 ? SEQ : nrows2, DM, DFF, G, E, wave);
            if (SK_F2 && !last) { EpiSlab EA{WSP(float, WS_ACC), modC + 8 * DM, 0.5f}; run_gemm_sk(lds, WSP(const bf16, WS_H) + (size_t)SEQ * DFF, WSP(const bf16, WS_WFO + (size_t)(l * 2 + 1) * SZ_WFO), DFF, DM, G, EA, wave); } }
        SEAM(pb + 14);
    }
    if ((PHSEL < 0 || PHSEL == 100) && DBG_STOP < NPHASE - 1 && lo <= PH_COPY && PH_COPY < hi) {
        const int l = 0; PHASE_PTRS();
        const int tid = wave * 64 + lane_vol();
#if 0
#else
        const float* src = (DBG_STOP >= 3) ? X : P.in[I_X];
        for (size_t i = (size_t)(bx * NTHR + tid); i < (size_t)SEQ * DM / 4; i += (size_t)G * NTHR) ((f32x4*)P.out)[i] = ((const f32x4*)src)[i];
#endif
    }
#ifdef DBG_TS_A
    if (bx == 0 && wave == 0 && lane_vol() == 0) {
        gu32* tsp = (gu32*)((GAS unsigned char*)ld_uptr(lds, N_IN + 1) + WS_CTL) + 16384;
        const unsigned tb = (DBG_TS_B == 99) ? (unsigned)__builtin_amdgcn_s_memrealtime() : __hip_atomic_load(tsp + DBG_TS_B, RLX_AGENT);
        const unsigned ta = __hip_atomic_load(tsp + DBG_TS_A, RLX_AGENT);
        const unsigned long long dt = (unsigned long long)(tb - ta) * (unsigned long long)(DBG_TS_MULT);
        const unsigned long long t0_ = __builtin_amdgcn_s_memrealtime();
        while (__builtin_amdgcn_s_memrealtime() - t0_ < dt) __builtin_amdgcn_s_sleep(64);
    }
#endif
#undef IN
#undef SEAM
}

extern "C" void kernel_launch(void* const* d_in, const int* in_sizes, int n_in, void* d_out, int out_size, void* d_ws, size_t ws_size, hipStream_t stream) {
    static int grid = 0;
    if (grid == 0) {
        if (n_in != N_IN || out_size != SEQ * DM || ws_size < WS_END) { fprintf(stderr, "kernel_launch: unexpected shapes: n_in %d out %d ws %zu (need %zu)\n", n_in, out_size, ws_size, (size_t)WS_END); grid = -1; return; }
        int dev = 0, cus = 0;
        if (hipGetDevice(&dev) != hipSuccess || hipDeviceGetAttribute(&cus, hipDeviceAttributeMultiprocessorCount, dev) != hipSuccess) { grid = -1; return; }
        {
            hipError_t e = hipSuccess;
#if MK_ONE_LAUNCH
            e = hipFuncSetAttribute((const void*)fwd_kernel<-1>, hipFuncAttributeMaxDynamicSharedMemorySize, LDS_BYTES);
#else
#define SETA(S) if (e == hipSuccess) e = hipFuncSetAttribute((const void*)fwd_kernel<S>, hipFuncAttributeMaxDynamicSharedMemorySize, LDS_BYTES)
            SETA(0); SETA(1); SETA(2); SETA(3); SETA(4); SETA(5); SETA(6); SETA(7); SETA(8); SETA(9); SETA(10); SETA(11); SETA(12); SETA(13); SETA(14); SETA(15); SETA(100);
#undef SETA
#endif
            if (e != hipSuccess) { fprintf(stderr, "kernel_launch: hipFuncSetAttribute failed\n"); grid = -1; return; }
        }
        (void)hipGetLastError();
        grid = cus;
    }
    if (grid < 0) return;
    (void)hipMemsetAsync((char*)d_ws + WS_CTL, 0, ZERO_BYTES, stream);
    Args a{};
    for (int i = 0; i < N_IN; ++i) a.in[i] = (const float*)d_in[i];
    a.out = (float*)d_out; a.ws = (unsigned char*)d_ws;
    const int last_phase = (DBG_STOP < NPHASE - 1) ? PH_COPY : NPHASE - 1;
#if MK_ONE_LAUNCH
    a.ph_lo = 0; a.ph_hi = last_phase + 1;
    hipLaunchKernelGGL(fwd_kernel<-1>, dim3(grid), dim3(NTHR), LDS_BYTES, stream, a);
#else
    for (int p = 0; p <= last_phase; ++p) {
        if (p > DBG_STOP && p != PH_COPY) continue;
#ifdef HOST_SKIP_FROM
        if (p >= HOST_SKIP_FROM && p != PH_COPY) continue;
#endif
        a.ph_lo = p; a.ph_hi = p + 1;
        const int slot = (p == 0) ? 0 : (p == PH_COPY ? 100 : 1 + (p - 1) % PH_PER_LAYER);
#define LCH(S) case S: hipLaunchKernelGGL(fwd_kernel<S>, dim3(grid), dim3(NTHR), LDS_BYTES, stream, a); break
        switch (slot) { LCH(0); LCH(1); LCH(2); LCH(3); LCH(4); LCH(5); LCH(6); LCH(7); LCH(8); LCH(9); LCH(10); LCH(11); LCH(12); LCH(13); LCH(14); LCH(15); LCH(100); default: break; }
#undef LCH
    }
#endif
    const hipError_t le = hipPeekAtLastError();
    if (le != hipSuccess) fprintf(stderr, "kernel_launch: launch failed: %s\n", hipGetErrorName(le));
}
```
